# Optimizing an MI355X kernel written in HIP

```python
import math
import jax, jax.numpy as jnp
from jax import lax
import numpy as np

D_MODEL = 1024
BATCH = 1
SEQ = 16384
DEPTH = 1

EPS = 1e-6
HY_WIDTH = 512
SHORT_CONV = 3
FILTER_BANDS = 16
FILTER_EMB = 1 + 2 * FILTER_BANDS
FILTER_HIDDEN = 64
FILTER_DECAY_TARGET = 1e-2
FAST_DECAY_PCT = 0.3
SLOW_DECAY_PCT = 1.5
FILTER_SHIFT = 0.05
MIN_DECAY = math.log(FILTER_DECAY_TARGET) / SLOW_DECAY_PCT
MAX_DECAY = math.log(FILTER_DECAY_TARGET) / FAST_DECAY_PCT
N_HEADS = 8
QK_NOPE = 64
QK_ROPE = 32
V_HEAD = 64
Q_LORA = 384
KV_LORA = 256
ROPE_THETA = 10000.0
Q_BLOCK = 128
MLA_WIDTH = N_HEADS * V_HEAD
N_BRANCH = 2
OFF_Q = 3 * HY_WIDTH
OFF_KV = OFF_Q + Q_LORA
OFF_KR = OFF_KV + KV_LORA
OFF_GATE = OFF_KR + QK_ROPE
IN_COLS = OFF_GATE + N_BRANCH * D_MODEL
N_GROUPS = 4
EXPERTS_PER_GROUP = 8
N_EXPERTS = N_GROUPS * EXPERTS_PER_GROUP
TOP_K = 2
D_EXPERT = 256

kernel_name = "hybrid_hyena_mla_hiermoe_adaln_block"


def _rmsnorm(x, g):
    xf = x.astype(jnp.float32)
    y = xf * lax.rsqrt(jnp.mean(xf * xf, axis=-1, keepdims=True) + EPS)
    return (y * g.astype(jnp.float32)).astype(x.dtype)


def _centred_short_conv(u, w, b):
    up = jnp.pad(u, ((0, 0), (1, 1), (0, 0)))
    return up[:, :-2] * w[0] + up[:, 1:-1] * w[1] + up[:, 2:] * w[2] + b


def _hyena_filter(L, w1, b1, f1, w2, b2, f2, w3):
    f32 = jnp.float32
    t = jnp.linspace(0.0, 1.0, L, dtype=f32)[:, None]
    t_r = jnp.arange(L, dtype=f32)[:, None]
    bands = jnp.linspace(1e-4, FILTER_BANDS - 1, FILTER_BANDS, dtype=f32)[None, :]
    ang = 2.0 * math.pi * bands * t_r / L
    z = jnp.concatenate([t, jnp.cos(ang), -jnp.sin(ang)], axis=-1)
    h = jnp.sin(f1.astype(f32) * (z @ w1.astype(f32) + b1.astype(f32)))
    h = jnp.sin(f2.astype(f32) * (h @ w2.astype(f32) + b2.astype(f32)))
    h = (h @ w3.astype(f32)).reshape(L, 2, HY_WIDTH)
    deltas = jnp.linspace(MIN_DECAY, MAX_DECAY, HY_WIDTH, dtype=f32)
    window = jnp.exp(-t * jnp.abs(deltas)[None, :]) + FILTER_SHIFT
    h = h * window[:, None, :]
    h_fwd, h_bwd = h[:, 0], h[:, 1]
    g = jnp.concatenate([h_fwd, jnp.zeros((1, HY_WIDTH), f32), h_bwd[:0:-1]], axis=0)
    return g / jnp.sum(jnp.abs(g), axis=0, keepdims=True)


def _bidir_long_conv(u, g, bias):
    L = u.shape[1]
    uf32 = u.astype(jnp.float32)
    uf = jnp.fft.rfft(uf32, n=2 * L, axis=1)
    gf = jnp.fft.rfft(g, axis=0)
    y = jnp.fft.irfft(uf * gf[None], n=2 * L, axis=1)[:, :L]
    return (y + bias.astype(jnp.float32) * uf32).astype(u.dtype)


def _rope_tables(L):
    pos = jnp.arange(L, dtype=jnp.float32)
    inv = ROPE_THETA ** (-jnp.arange(0, QK_ROPE, 2, dtype=jnp.float32) / QK_ROPE)
    ang = pos[:, None] * inv[None, :]
    return jnp.cos(ang), jnp.sin(ang)


def _rope(x, cos, sin):
    half = x.shape[-1] // 2
    x1 = x[..., :half].astype(jnp.float32)
    x2 = x[..., half:].astype(jnp.float32)
    return jnp.concatenate([x1 * cos - x2 * sin, x1 * sin + x2 * cos], axis=-1).astype(x.dtype)


def _mla(cq_raw, ckv_raw, kr_raw, g_q, g_kv, w_uq, w_uk, w_uv, cos, sin):
    B, L, _ = cq_raw.shape
    q = (_rmsnorm(cq_raw, g_q) @ w_uq).reshape(B, L, N_HEADS, QK_NOPE + QK_ROPE)
    q_nope = q[..., :QK_NOPE]
    q_rope = _rope(q[..., QK_NOPE:], cos[:, None, :], sin[:, None, :])
    c_kv = _rmsnorm(ckv_raw, g_kv)
    k_nope = jnp.einsum('blc,chd->blhd', c_kv, w_uk)
    v = jnp.einsum('blc,chd->blhd', c_kv, w_uv)
    k_rope = _rope(kr_raw, cos, sin)
    nb = L // Q_BLOCK
    qn = q_nope.reshape(B, nb, Q_BLOCK, N_HEADS, QK_NOPE).swapaxes(0, 1)
    qr = q_rope.reshape(B, nb, Q_BLOCK, N_HEADS, QK_ROPE).swapaxes(0, 1)
    scale = (QK_NOPE + QK_ROPE) ** -0.5

    def block(args):
        qn_b, qr_b = args
        s = (jnp.einsum('bqhd,bkhd->bhqk', qn_b, k_nope)
             + jnp.einsum('bqhr,bkr->bhqk', qr_b, k_rope))
        p = jax.nn.softmax(s.astype(jnp.float32) * scale, axis=-1).astype(v.dtype)
        return jnp.einsum('bhqk,bkhd->bqhd', p, v)

    o = lax.map(block, (qn, qr))
    return o.swapaxes(0, 1).reshape(B, L, MLA_WIDTH)


def _token_mixer(h, w_in, hy_conv_w, hy_conv_b, filt_w1, filt_b1, filt_freq1, filt_w2,
                 filt_b2, filt_freq2, filt_w3, hy_bias, q_norm_g, kv_norm_g, w_uq, w_uk,
                 w_uv, w_hy_out, w_mla_out, w_mix_out, cos, sin):
    B, L, _ = h.shape
    proj = h @ w_in
    hy = _centred_short_conv(proj[..., :OFF_Q], hy_conv_w, hy_conv_b)
    x0, x1, v = hy[..., :HY_WIDTH], hy[..., HY_WIDTH:2 * HY_WIDTH], hy[..., 2 * HY_WIDTH:]
    g = _hyena_filter(L, filt_w1, filt_b1, filt_freq1, filt_w2, filt_b2, filt_freq2, filt_w3)
    y_hy = x0 * _bidir_long_conv(v * x1, g, hy_bias)
    y_mla = _mla(proj[..., OFF_Q:OFF_KV], proj[..., OFF_KV:OFF_KR], proj[..., OFF_KR:OFF_GATE],
                 q_norm_g, kv_norm_g, w_uq, w_uk, w_uv, cos, sin)
    gates = jax.nn.sigmoid(proj[..., OFF_GATE:].reshape(B, L, N_BRANCH, D_MODEL))
    mix = gates[..., 0, :] * (y_hy @ w_hy_out) + gates[..., 1, :] * (y_mla @ w_mla_out)
    return mix @ w_mix_out


def _hier_moe(h, w_group, b_group, w_router, b_router, w_gate, w_up, w_down):
    B, L, D = h.shape
    t = h.reshape(B * L, D)
    n = t.shape[0]
    g_logits = (t @ w_group + b_group).astype(jnp.float32)
    p_group = jax.nn.softmax(g_logits, axis=-1)
    g_idx = jnp.argmax(g_logits, axis=-1)
    p_sel = jnp.max(p_group, axis=-1)
    e_logits = (t @ w_router + b_router).astype(jnp.float32).reshape(n, N_GROUPS, EXPERTS_PER_GROUP)
    e_in_group = e_logits[jnp.arange(n), g_idx]
    top_v, top_i = lax.top_k(e_in_group, TOP_K)
    w = jax.nn.softmax(top_v, axis=-1) * p_sel[:, None]
    e_idx = g_idx[:, None] * EXPERTS_PER_GROUP + top_i
    combine = jnp.einsum('nk,nke->ne', w, jax.nn.one_hot(e_idx, N_EXPERTS, dtype=jnp.float32))
    out = jnp.zeros((n, D), jnp.float32)
    for e in range(N_EXPERTS):
        a = jax.nn.silu(t @ w_gate[e]) * (t @ w_up[e])
        out = out + combine[:, e:e + 1] * (a @ w_down[e])
    return out.astype(h.dtype).reshape(B, L, D)


def setup_inputs(seed: int = 0) -> dict:
    key = jax.random.key(seed)
    keys = jax.random.split(key, 40)
    ctr = [0]

    def nk():
        k = keys[ctr[0]]
        ctr[0] += 1
        return k

    def nrm(shape, fan_in, s=1.0):
        return s * jax.random.normal(nk(), shape, jnp.float32) * fan_in ** -0.5

    def gain(shape):
        return 1.0 + 0.05 * jax.random.normal(nk(), shape, jnp.float32)

    def small(shape, s=0.02):
        return s * jax.random.normal(nk(), shape, jnp.float32)

    Dp, D = DEPTH, D_MODEL
    return {
        "x": jax.random.normal(nk(), (BATCH, SEQ, D), jnp.float32),
        "c": jax.random.normal(nk(), (BATCH, D), jnp.float32),
        "ada_w": nrm((Dp, D, 6 * D), D, 0.5),
        "ada_b": small((Dp, 6 * D)),
        "norm_mix_g": gain((Dp, D)),
        "w_in": nrm((Dp, D, IN_COLS), D),
        "hy_conv_w": nrm((Dp, SHORT_CONV, 3 * HY_WIDTH), SHORT_CONV),
        "hy_conv_b": small((Dp, 3 * HY_WIDTH)),
        "filt_w1": nrm((Dp, FILTER_EMB, FILTER_HIDDEN), FILTER_EMB),
        "filt_b1": small((Dp, FILTER_HIDDEN), 0.1),
        "filt_freq1": gain((Dp, FILTER_HIDDEN)),
        "filt_w2": nrm((Dp, FILTER_HIDDEN, FILTER_HIDDEN), FILTER_HIDDEN),
        "filt_b2": small((Dp, FILTER_HIDDEN), 0.1),
        "filt_freq2": gain((Dp, FILTER_HIDDEN)),
        "filt_w3": nrm((Dp, FILTER_HIDDEN, 2 * HY_WIDTH), FILTER_HIDDEN),
        "hy_bias": small((Dp, HY_WIDTH), 0.1),
        "q_norm_g": gain((Dp, Q_LORA)),
        "kv_norm_g": gain((Dp, KV_LORA)),
        "w_uq": nrm((Dp, Q_LORA, N_HEADS * (QK_NOPE + QK_ROPE)), Q_LORA),
        "w_uk": nrm((Dp, KV_LORA, N_HEADS, QK_NOPE), KV_LORA),
        "w_uv": nrm((Dp, KV_LORA, N_HEADS, V_HEAD), KV_LORA),
        "w_hy_out": nrm((Dp, HY_WIDTH, D), HY_WIDTH),
        "w_mla_out": nrm((Dp, MLA_WIDTH, D), MLA_WIDTH),
        "w_mix_out": nrm((Dp, D, D), D),
        "norm_ffn_g": gain((Dp, D)),
        "w_group": nrm((Dp, D, N_GROUPS), D),
        "b_group": small((Dp, N_GROUPS), 0.01),
        "w_router": nrm((Dp, D, N_EXPERTS), D),
        "b_router": small((Dp, N_EXPERTS), 0.01),
        "w_gate": nrm((Dp, N_EXPERTS, D, D_EXPERT), D),
        "w_up": nrm((Dp, N_EXPERTS, D, D_EXPERT), D),
        "w_down": nrm((Dp, N_EXPERTS, D_EXPERT, D), D_EXPERT),
        "final_norm_g": gain((D,)),
    }


def reference(x, c, ada_w, ada_b, norm_mix_g, w_in, hy_conv_w, hy_conv_b, filt_w1, filt_b1,
              filt_freq1, filt_w2, filt_b2, filt_freq2, filt_w3, hy_bias, q_norm_g, kv_norm_g,
              w_uq, w_uk, w_uv, w_hy_out, w_mla_out, w_mix_out, norm_ffn_g, w_group, b_group,
              w_router, b_router, w_gate, w_up, w_down, final_norm_g):
    L = x.shape[1]
    cos, sin = _rope_tables(L)
    c_act = jax.nn.silu(c)
    for l in range(DEPTH):
        mod = (c_act @ ada_w[l] + ada_b[l])[:, None, :]
        sh1, sc1, gt1, sh2, sc2, gt2 = jnp.split(mod, 6, axis=-1)
        h = _rmsnorm(x, norm_mix_g[l]) * (1.0 + sc1) + sh1
        x = x + gt1 * _token_mixer(h, w_in[l], hy_conv_w[l], hy_conv_b[l], filt_w1[l], filt_b1[l],
                                   filt_freq1[l], filt_w2[l], filt_b2[l], filt_freq2[l], filt_w3[l],
                                   hy_bias[l], q_norm_g[l], kv_norm_g[l], w_uq[l], w_uk[l], w_uv[l],
                                   w_hy_out[l], w_mla_out[l], w_mix_out[l], cos, sin)
        h = _rmsnorm(x, norm_ffn_g[l]) * (1.0 + sc2) + sh2
        x = x + gt2 * _hier_moe(h, w_group[l], b_group[l], w_router[l], b_router[l],
                                w_gate[l], w_up[l], w_down[l])
    return _rmsnorm(x, final_norm_g)
```

```cpp
#include <hip/hip_runtime.h>
#include <cstdint>
#include <cstdio>
#include <cmath>

constexpr int D = 1024, L = 16384, M = L;
constexpr int HY = 512, NH = 8, QKD = 96, VH = 64, QL = 384, KVL = 256;
constexpr int NIN = 4352;
constexpr int PL = 768;
constexpr int NEXP = 32, DEXP = 256, NGRP = 4, EPG = 8;
constexpr float EPS = 1e-6f;
constexpr float C2 = 0.10206207261596575f * 1.4426950408889634f;
constexpr int LAGMAX = L + 1023;
constexpr int NG = 2 * L + 3072;
constexpr int MAXSLOT = 40960;

constexpr size_t MiB = 1u << 20;
constexpr size_t WS_CTL = 0;
constexpr size_t WS_MOD = 64 * 1024;
constexpr size_t WS_BCCNT = 57856;
constexpr size_t WS_MODCNT = 57600;
constexpr size_t WS_RSQ = 128 * 1024, WS_RSKV = 192 * 1024;
constexpr size_t WS_FSUM = 256 * 1024;
constexpr size_t WS_ROPE = 1280 * 1024;
constexpr size_t WS_WRT = 3328 * 1024;
constexpr size_t WS_TWA = 96 * 1024;
constexpr size_t WS_FSCR = 160 * MiB;
constexpr size_t WS_TOKE = 3584 * 1024;
constexpr size_t WS_TOKW = WS_TOKE + 128 * 1024;
constexpr size_t WS_TOKR = WS_TOKW + 128 * 1024;
constexpr size_t WS_TOKS = WS_TOKR + 128 * 1024;
constexpr size_t WS_BCNT = WS_TOKS + 128 * 1024;
constexpr size_t WS_STOK = WS_BCNT + 32 * 1024;
constexpr size_t WS_SW = WS_STOK + 160 * 1024;
static_assert(WS_SW + 160 * 1024 <= 6 * MiB, "misc region");
constexpr size_t WS_WB = 6 * MiB;
constexpr size_t WS_WIN = WS_WB;
constexpr size_t WS_WUQ = WS_WIN + (size_t)NIN * D * 2;
constexpr size_t WS_WUKV = WS_WUQ + 768 * 384 * 2;
constexpr size_t WS_WCAT = WS_WUKV + 1024 * 256 * 2;
constexpr size_t WS_WMIX = WS_WCAT + 1024 * 1024 * 2;
static_assert(WS_WMIX + 1024 * 1024 * 2 <= 20 * MiB, "WB region");
constexpr size_t WS_R1 = 20 * MiB;
constexpr size_t WS_R2 = 52 * MiB;
constexpr size_t WS_R3 = 88 * MiB;
constexpr size_t WS_R4 = 136 * MiB;
constexpr size_t WS_R5 = 192 * MiB;
constexpr size_t WS_H1 = WS_R1, WS_K = WS_R1, WS_H2 = WS_R1;
constexpr size_t WS_GR = WS_R2, WS_MIX = WS_R2;
constexpr size_t WS_PROJH = WS_R3, WS_V = WS_R3, WS_YCAT = WS_R3 + 16 * MiB;
constexpr size_t WS_PROJL = WS_R4, WS_ZT = WS_R4, WS_ACT = WS_R4;
constexpr size_t WS_GATES = WS_R5, WS_WE = WS_R5;
constexpr size_t WS_X1B = 104 * MiB;
constexpr size_t WS_Y = 20 * MiB;
static_assert((size_t)512 * NG * 2 <= 36 * MiB, "Gr fits");
constexpr size_t DO_X0 = 0, DO_UT = 16 * MiB, DO_Q = 32 * MiB;

typedef unsigned short bf16;
typedef unsigned v4u __attribute__((ext_vector_type(4)));
typedef unsigned v2u __attribute__((ext_vector_type(2)));
typedef float f32x4 __attribute__((ext_vector_type(4)));
#define LAS __attribute__((address_space(3)))

__device__ __forceinline__ unsigned f2bf(float f) { unsigned u = __builtin_bit_cast(unsigned, f); return (u + 0x7fffu + ((u >> 16) & 1u)) >> 16; }
__device__ __forceinline__ float bf2f(unsigned b) { return __builtin_bit_cast(float, (b & 0xffffu) << 16); }
__device__ __forceinline__ unsigned pk2(float lo, float hi) { return f2bf(lo) | (f2bf(hi) << 16); }
__device__ __forceinline__ float bflo(unsigned w) { return __builtin_bit_cast(float, w << 16); }
__device__ __forceinline__ float bfhi(unsigned w) { return __builtin_bit_cast(float, w & 0xffff0000u); }
__device__ __forceinline__ float wave_sum(float v) {
#pragma unroll
    for (int o = 1; o < 64; o <<= 1) v += __shfl_xor(v, o);
    return v;
}
__device__ __forceinline__ float sigmoidf_(float v) { return 1.f / (1.f + __expf(-v)); }
__device__ __forceinline__ float siluf_(float v) { return v / (1.f + __expf(-v)); }

__device__ __forceinline__ int fresh_lane() { int l; asm volatile("v_mbcnt_lo_u32_b32 %0, -1, 0\n\tv_mbcnt_hi_u32_b32 %0, -1, %0" : "=v"(l)); return l; }
struct Args { const float* in[33]; float* out; unsigned char* ws; int ph_lo, ph_hi, li, pad; };
enum { I_X = 0, I_C, I_ADAW, I_ADAB, I_NMG, I_WIN, I_HCW, I_HCB, I_FW1, I_FB1, I_FF1, I_FW2, I_FB2, I_FF2, I_FW3, I_HBIAS, I_QNG, I_KVNG, I_WUQ, I_WUK, I_WUV,
       I_WHY, I_WMLA, I_WMIX, I_NFG, I_WGRP, I_BGRP, I_WRT, I_BRT, I_WGATE, I_WUP, I_WDOWN, I_FNG };

struct Frame {
    unsigned char* ws; LAS unsigned char* lds;
    int tid, lane, wave, vcu, G, gw, NGW;
};

__device__ __forceinline__ void transpose_item(const float* srcA, const float* srcB, int ldw, const float* kscale, bf16* dst, int ldk, bool zero, LAS float* scr, int lane) {
    const float* s = (lane & 16) ? srcB + ((lane & 31) - 16) : srcA + (lane & 31);
    float tv[32];
#pragma unroll
    for (int i = 0; i < 32; ++i) { const int kk = 2 * i + (lane >> 5); tv[i] = zero ? 0.f : s[(size_t)kk * ldw]; }
#pragma unroll
    for (int i = 0; i < 32; ++i) { const int kk = 2 * i + (lane >> 5); float v = tv[i]; if (kscale) v *= kscale[kk]; scr[kk * 33 + (lane & 31)] = v; }
    asm volatile("s_waitcnt lgkmcnt(0)" ::: "memory");
    const int c = lane & 7;
#pragma unroll
    for (int j = 0; j < 4; ++j) { const int n = (lane >> 3) + 8 * j; const LAS float* p = scr + (8 * c) * 33 + n;
        v4u o; o.x = pk2(p[0 * 33], p[1 * 33]); o.y = pk2(p[2 * 33], p[3 * 33]); o.z = pk2(p[4 * 33], p[5 * 33]); o.w = pk2(p[6 * 33], p[7 * 33]);
        *(v4u*)(dst + (size_t)n * ldk + 8 * c) = o; }
    asm volatile("s_waitcnt lgkmcnt(0)" ::: "memory");
}

constexpr int P0W_IN = (NIN / 32) * (D / 64), P0W_ALL = P0W_IN + (768 / 32) * (QL / 64) + (1024 / 32) * (KVL / 64) + 32 * 16 + 32 * 16;
__device__ __forceinline__ void p0_weights(Frame& F, const Args& A, int it_lo, int it_hi, int gw, int ngw, bool tables) {
    LAS float* scr = (LAS float*)(F.lds + F.wave * 8704);
    constexpr int I_IN = (NIN / 32) * (D / 64), I_UQ = (768 / 32) * (QL / 64), I_UKV = (1024 / 32) * (KVL / 64), I_CAT = 32 * 16, I_MIX = 32 * 16;
    for (int it = it_lo + gw; it < it_hi; it += ngw) {
        int r = it; const float* s; int ldw; const float* ksc = nullptr; bf16* dst; int ldk; bool pad = false;
        if (r < I_IN) { const int nb = r % (NIN / 32), kb = r / (NIN / 32), n0 = nb * 32, k0 = kb * 64; pad = (n0 >= 2208 && n0 < 2304); const int sc = n0 < 2208 ? n0 : n0 - 96;
            s = A.in[I_WIN] + (size_t)k0 * 4256 + (pad ? 0 : sc); ldw = 4256; dst = (bf16*)(F.ws + WS_WIN) + (size_t)n0 * D + k0; ldk = D; }
        else if ((r -= I_IN) < I_UQ) { const int nb = r % 24, kb = r / 24, n0 = nb * 32, k0 = kb * 64; s = A.in[I_WUQ] + (size_t)k0 * 768 + n0; ldw = 768; ksc = A.in[I_QNG] + k0;
            dst = (bf16*)(F.ws + WS_WUQ) + (size_t)n0 * QL + k0; ldk = QL; }
        else if ((r -= I_UQ) < I_UKV) { const int nb = r % 32, kb = r / 32, n0 = nb * 32, k0 = kb * 64; s = (n0 < 512 ? A.in[I_WUK] + n0 : A.in[I_WUV] + (n0 - 512)) + (size_t)k0 * 512; ldw = 512; ksc = A.in[I_KVNG] + k0;
            dst = (bf16*)(F.ws + WS_WUKV) + (size_t)n0 * KVL + k0; ldk = KVL; }
        else if ((r -= I_UKV) < I_CAT) { const int nb = r % 32, kb = r / 32, n0 = nb * 32, k0 = kb * 64; s = (kb < 8 ? A.in[I_WHY] + (size_t)k0 * D : A.in[I_WMLA] + (size_t)(k0 - 512) * D) + n0; ldw = D;
            dst = (bf16*)(F.ws + WS_WCAT) + (size_t)n0 * D + k0; ldk = D; }
        else { r -= I_CAT; const int nb = r % 32, kb = r / 32, n0 = nb * 32, k0 = kb * 64; s = A.in[I_WMIX] + (size_t)k0 * D + n0; ldw = D; dst = (bf16*)(F.ws + WS_WMIX) + (size_t)n0 * D + k0; ldk = D; }
        transpose_item(s, s + 16, ldw, ksc, dst, ldk, pad, scr, F.lane);
    }
    if (!tables) return;
    float* wrt = (float*)(F.ws + WS_WRT);
    for (int i = gw * 64 + F.lane; i < 36 * 1024; i += ngw * 64) { const int o = i >> 10, k = i & 1023; wrt[i] = o < 4 ? A.in[I_WGRP][k * 4 + o] : A.in[I_WRT][k * 32 + (o - 4)]; }
    { float* tw = (float*)(F.ws + WS_TWA); for (int i = gw * 64 + F.lane; i < 512; i += ngw * 64) { const float xr = -(float)i * (1.0f / 16384.0f); tw[2 * i] = cospif(xr); tw[2 * i + 1] = sinpif(xr); } }
    float* ct = (float*)(F.ws + WS_ROPE); float* st = ct + L * 16;
    const double inv = pow(10000.0, -(double)(F.lane & 15) / 16.0);
    for (int i = gw * 64 + F.lane; i < L * 16; i += ngw * 64) { const int pos = i >> 4; const double ang = (double)pos * inv;
        const double q = rint(ang * 0.15915494309189535); double r = fma(-q, 6.283185307179586232, ang); r = fma(-q, 2.4492935982947064e-16, r); const float rf = (float)r;
        ct[i] = cosf(rf); st[i] = sinf(rf); }
}

__device__ __forceinline__ void p0_mod(Frame& F, const Args& A) {
    LAS float* red = (LAS float*)(F.lds + 70000);
    for (int ob = blockIdx.x; ob < 256; ob += F.G) {
        const int j = F.tid & 31, kq = F.tid >> 5; float acc = 0.f;
        if (j < 24) { float cv[64], wv[64];
#pragma unroll
            for (int i = 0; i < 64; ++i) { const int k = kq + 16 * i; cv[i] = A.in[I_C][k]; wv[i] = A.in[I_ADAW][(size_t)k * 6144 + ob * 24 + j]; }
#pragma unroll
            for (int i = 0; i < 64; ++i) acc += siluf_(cv[i]) * wv[i]; }
        red[kq * 32 + j] = acc; __syncthreads();
        if (F.tid < 64) { if (F.tid < 24) { float s = A.in[I_ADAB][ob * 24 + F.tid]; for (int q = 0; q < 16; ++q) s += red[q * 32 + F.tid]; __hip_atomic_store((float*)(F.ws + WS_MOD) + ob * 24 + F.tid, s, __ATOMIC_RELAXED, __HIP_MEMORY_SCOPE_AGENT); }
            asm volatile("s_waitcnt vmcnt(0)" ::: "memory");
            if (F.tid == 0) __hip_atomic_fetch_add((unsigned*)(F.ws + WS_CTL + WS_MODCNT), 1u, __ATOMIC_RELAXED, __HIP_MEMORY_SCOPE_AGENT); }
        __syncthreads();
    }
}

__device__ __forceinline__ void p0_filter(Frame& F, const Args& A, int pb0, int npb) {
    typedef short bf16x8_ __attribute__((ext_vector_type(8))); typedef float f32x16_ __attribute__((ext_vector_type(16)));
    LAS float* Z = (LAS float*)(F.lds + 72192);
    LAS float* H1 = Z + 65 * 36;
    LAS bf16* H2B = (LAS bf16*)(H1 + 65 * 64);
    bf16* Gr = (bf16*)(F.ws + WS_GR);
    const int lane = F.lane, c32 = lane & 31, h = lane >> 5;
    LAS float* WL = (LAS float*)(F.lds);
    __syncthreads();
    for (int i = F.tid; i < 2112; i += 512) WL[i] = A.in[I_FW1][i];
    for (int i = F.tid; i < 4096; i += 512) WL[2112 + i] = A.in[I_FW2][i];
    if (F.tid < 64) { WL[6208 + F.tid] = A.in[I_FB1][F.tid]; WL[6272 + F.tid] = A.in[I_FB2][F.tid]; WL[6336 + F.tid] = A.in[I_FF1][F.tid]; WL[6400 + F.tid] = A.in[I_FF2][F.tid]; }
    __syncthreads();
    if (pb0 >= 256) return;
    bf16x8_ bfr[4][4];
#pragma unroll
    for (int dc = 0; dc < 4; ++dc) { const int dir = dc >> 1, c = 32 * (2 * F.wave + (dc & 1)) + c32;
#pragma unroll
        for (int ks = 0; ks < 4; ++ks) { const float* wp = A.in[I_FW3] + (size_t)(16 * ks + 8 * h) * 1024 + dir * 512 + c; float w[8];
#pragma unroll
            for (int jj = 0; jj < 8; ++jj) w[jj] = wp[jj * 1024];
            const v4u pk = (v4u){pk2(w[0], w[1]), pk2(w[2], w[3]), pk2(w[4], w[5]), pk2(w[6], w[7])}; bfr[dc][ks] = __builtin_bit_cast(bf16x8_, pk); } }
    for (int pb = pb0; pb < 256; pb += npb) {
        const int k0 = pb * 64;
        for (int i = F.tid; i < 65 * 33; i += 512) { const int kk = i / 33, f = i % 33, k = k0 + kk; float v;
            if (f == 0) v = (float)k / (float)(L - 1);
            else { const int bi = (f - 1) & 15; const float band = 1e-4f + (float)bi * ((15.0f - 1e-4f) / 15.0f); const float ang = 6.283185307179586f * band * (float)k / (float)L;
                   v = (f <= 16) ? cosf(ang) : -sinf(ang); }
            Z[kk * 36 + f] = v; }
        __syncthreads();
        { const int o = F.tid & 63, kq = F.tid >> 6; float w[33];
#pragma unroll
          for (int f = 0; f < 33; ++f) w[f] = WL[f * 64 + o];
          const float b = WL[6208 + o], fq = WL[6336 + o];
          for (int kk = kq; kk < 65; kk += 8) { float acc = b; const LAS f32x4* zr = (const LAS f32x4*)(Z + kk * 36);
#pragma unroll
              for (int f4 = 0; f4 < 8; ++f4) { const f32x4 zv = zr[f4]; acc += zv.x * w[4 * f4]; acc += zv.y * w[4 * f4 + 1]; acc += zv.z * w[4 * f4 + 2]; acc += zv.w * w[4 * f4 + 3]; }
              acc += Z[kk * 36 + 32] * w[32];
              H1[kk * 64 + o] = sinf(fq * acc); } }
        __syncthreads();
        { const int o = F.tid & 63, kq = F.tid >> 6; float w[64];
#pragma unroll
          for (int m = 0; m < 64; ++m) w[m] = WL[2112 + m * 64 + o];
          const float b = WL[6272 + o], fq = WL[6400 + o];
          for (int kk = kq; kk < 65; kk += 8) { float acc = b; const LAS f32x4* hr = (const LAS f32x4*)(H1 + kk * 64);
#pragma unroll
              for (int m4 = 0; m4 < 16; ++m4) { const f32x4 hv = hr[m4]; acc += hv.x * w[4 * m4]; acc += hv.y * w[4 * m4 + 1]; acc += hv.z * w[4 * m4 + 2]; acc += hv.w * w[4 * m4 + 3]; }
              H2B[kk * 72 + o] = (bf16)f2bf(sinf(fq * acc)); } }
        __syncthreads();
#pragma unroll
        for (int dc = 0; dc < 4; ++dc) { const int dir = dc >> 1, ct = 2 * F.wave + (dc & 1), c = 32 * ct + c32;
            const float adel = 3.0701134573253945f + (float)c * ((15.350567286626973f - 3.0701134573253945f) / 511.0f);
            float asum = 0.f; bf16* row = Gr + (size_t)c * NG;
#pragma unroll
            for (int rt = 0; rt < 2; ++rt) { f32x16_ acc = f32x16_{};
#pragma unroll
                for (int ks = 0; ks < 4; ++ks) { const bf16x8_ af = *(const LAS bf16x8_*)((LAS const char*)H2B + (32 * rt + c32 + dir) * 144 + 32 * ks + 16 * h);
                    acc = __builtin_amdgcn_mfma_f32_32x32x16_bf16(af, bfr[dc][ks], acc, 0, 0, 0); }
#pragma unroll
                for (int g4 = 0; g4 < 4; ++g4) { const int p = 32 * rt + 8 * g4 + 4 * h; float v[4];
#pragma unroll
                    for (int e = 0; e < 4; ++e) { const int k = k0 + p + e + dir; const float t = (float)k / (float)(L - 1); float x = acc[4 * g4 + e] * (__expf(-t * adel) + 0.05f); if (k >= L) x = 0.f; v[e] = x; asum += fabsf(x); }
                    if (dir == 0) *(v2u*)(row + (LAGMAX - k0 - p - 3)) = (v2u){pk2(v[3], v[2]), pk2(v[1], v[0])};
                    else *(v2u*)(row + (LAGMAX + 1 + k0 + p)) = (v2u){pk2(v[0], v[1]), pk2(v[2], v[3])}; } }
            asum += __shfl_xor(asum, 32);
            if (h == 0) ((float*)(F.ws + WS_FSUM))[pb * 1024 + dir * 512 + c] = asum;
        }
        { bf16* row = Gr + (size_t)F.tid * NG; *(v2u*)(row + 4 * pb) = (v2u){0u, 0u}; *(v4u*)(row + 2 * L + 1024 + 8 * pb) = (v4u){0u, 0u, 0u, 0u}; }
        __syncthreads();
    }
}

__device__ __forceinline__ void p0b_h1(Frame& F, const Args& A) {
    const float* mod = (const float*)(F.ws + WS_MOD); bf16* h1 = (bf16*)(F.ws + WS_H1);
    if (F.tid == 0) { unsigned* p = (unsigned*)(F.ws + WS_CTL + WS_MODCNT); unsigned sp = 0; while (__hip_atomic_load(p, __ATOMIC_RELAXED, __HIP_MEMORY_SCOPE_AGENT) < 256u) { __builtin_amdgcn_s_sleep(2); if (++sp > (1u << 22)) break; } }
    __syncthreads();
    f32x4 gm[4], sh[4];
#pragma unroll
    for (int j = 0; j < 4; ++j) { const int c0 = 4 * F.lane + 256 * j; const f32x4 g = *(const f32x4*)(A.in[I_NMG] + c0), sc = *(const f32x4*)(mod + 1024 + c0); gm[j] = g * (sc + 1.0f); sh[j] = *(const f32x4*)(mod + c0); }
    for (int m = F.gw; m < M; m += F.NGW) {
        const f32x4* xr = (const f32x4*)(A.in[I_X] + (size_t)m * D) + F.lane; f32x4 v[4]; float s = 0.f;
#pragma unroll
        for (int j = 0; j < 4; ++j) { v[j] = xr[64 * j]; s += (v[j].x * v[j].x + v[j].y * v[j].y) + (v[j].z * v[j].z + v[j].w * v[j].w); }
        const float rstd = 1.0f / sqrtf(wave_sum(s) * (1.f / D) + EPS);
        v2u* o = (v2u*)(h1 + (size_t)m * D) + F.lane;
#pragma unroll
        for (int j = 0; j < 4; ++j) { const f32x4 y = v[j] * rstd * gm[j] + sh[j]; o[64 * j] = (v2u){pk2(y.x, y.y), pk2(y.z, y.w)}; }
    }
}

__device__ __forceinline__ void p2_prep(Frame& F, const Args& A, unsigned char* dout) {
    const bf16* pH = (const bf16*)(F.ws + WS_PROJH); const bf16* pL = (const bf16*)(F.ws + WS_PROJL);
    bf16* x0 = (bf16*)(dout + DO_X0); bf16* uT = (bf16*)(dout + DO_UT); bf16* Kb = (bf16*)(F.ws + WS_K);
    {
        const int cp = F.tid & 255, th = F.tid >> 8, c = 2 * cp; const float* cw = A.in[I_HCW]; const float* cb = A.in[I_HCB];
        float w0[3][2], w1[3][2], w2[3][2], bb[3][2];
#pragma unroll
        for (int p = 0; p < 3; ++p)
#pragma unroll
            for (int e = 0; e < 2; ++e) { const int col = p * 512 + c + e; w0[p][e] = cw[col]; w1[p][e] = cw[1536 + col]; w2[p][e] = cw[3072 + col]; bb[p][e] = cb[col]; }
        for (int tb = blockIdx.x; tb < L / 64; tb += F.G) {
            const int t0 = tb * 64 + th * 32; unsigned pv[3], cu[3];
#pragma unroll
            for (int p = 0; p < 3; ++p) { pv[p] = t0 > 0 ? *(const unsigned*)(pH + (size_t)(t0 - 1) * 1536 + p * 512 + c) : 0u; cu[p] = *(const unsigned*)(pH + (size_t)t0 * 1536 + p * 512 + c); }
#pragma unroll 1
            for (int g8 = 0; g8 < 4; ++g8) { unsigned nx[8][3]; float ua[8], ub[8];
#pragma unroll
                for (int i = 0; i < 8; ++i) { const int t = t0 + g8 * 8 + i;
#pragma unroll
                    for (int p = 0; p < 3; ++p) nx[i][p] = (t + 1 < L) ? *(const unsigned*)(pH + (size_t)(t + 1) * 1536 + p * 512 + c) : 0u; }
#pragma unroll
                for (int i = 0; i < 8; ++i) { const int t = t0 + g8 * 8 + i; float ha[3], hb[3];
#pragma unroll
                    for (int p = 0; p < 3; ++p) { ha[p] = w0[p][0] * bflo(pv[p]) + w1[p][0] * bflo(cu[p]) + w2[p][0] * bflo(nx[i][p]) + bb[p][0]; hb[p] = w0[p][1] * bfhi(pv[p]) + w1[p][1] * bfhi(cu[p]) + w2[p][1] * bfhi(nx[i][p]) + bb[p][1];
                        pv[p] = cu[p]; cu[p] = nx[i][p]; }
                    *(unsigned*)(x0 + (size_t)t * 512 + c) = pk2(ha[0], hb[0]); ua[i] = ha[2] * ha[1]; ub[i] = hb[2] * hb[1]; }
                *(v4u*)(uT + (size_t)c * L + t0 + g8 * 8) = (v4u){pk2(ua[0], ua[1]), pk2(ua[2], ua[3]), pk2(ua[4], ua[5]), pk2(ua[6], ua[7])};
                *(v4u*)(uT + (size_t)(c + 1) * L + t0 + g8 * 8) = (v4u){pk2(ub[0], ub[1]), pk2(ub[2], ub[3]), pk2(ub[4], ub[5]), pk2(ub[6], ub[7])}; }
        }
    }
    {
        float* rsq = (float*)(F.ws + WS_RSQ); float* rskv = (float*)(F.ws + WS_RSKV); const float* ct = (const float*)(F.ws + WS_ROPE); const float* st = ct + L * 16;
        constexpr int RB = 4; const int l2 = F.lane < 2 ? F.lane : 1;
        for (int m0 = F.gw; m0 < M; m0 += F.NGW * RB) {
            v4u a[RB], b[RB], xa[RB], xb[RB]; f32x4 c0[RB], c1[RB], n0[RB], n1[RB];
#pragma unroll
            for (int q = 0; q < RB; ++q) { const int m = (m0 + q * F.NGW < M) ? m0 + q * F.NGW : m0; const bf16* r = pL + (size_t)m * PL;
                a[q] = *(const v4u*)(r + 8 * F.lane); b[q] = *(const v4u*)(r + 512 + 8 * (F.lane & 15));
                xa[q] = *(const v4u*)(r + 640 + 8 * l2); xb[q] = *(const v4u*)(r + 656 + 8 * l2);
                c0[q] = *(const f32x4*)(ct + m * 16 + 8 * l2); c1[q] = *(const f32x4*)(ct + m * 16 + 8 * l2 + 4); n0[q] = *(const f32x4*)(st + m * 16 + 8 * l2); n1[q] = *(const f32x4*)(st + m * 16 + 8 * l2 + 4); }
            float s1[RB], s2[RB];
#pragma unroll
            for (int q = 0; q < RB; ++q) { float sa = 0.f, sb = 0.f;
                { const unsigned w[4] = {a[q].x, a[q].y, a[q].z, a[q].w};
#pragma unroll
                  for (int i = 0; i < 4; ++i) { const float lo = bflo(w[i]), hi = bfhi(w[i]); sa += lo * lo + hi * hi; } }
                { const unsigned w[4] = {b[q].x, b[q].y, b[q].z, b[q].w};
#pragma unroll
                  for (int i = 0; i < 4; ++i) { const float lo = bflo(w[i]), hi = bfhi(w[i]); sb += lo * lo + hi * hi; } }
                if (F.lane >= 16) sb = 0.f;
                s1[q] = F.lane < 48 ? sa : 0.f; s2[q] = (F.lane < 48 ? 0.f : sa) + sb; }
#pragma unroll
            for (int q = 0; q < RB; ++q) { s1[q] = wave_sum(s1[q]); s2[q] = wave_sum(s2[q]); }
#pragma unroll
            for (int q = 0; q < RB; ++q) { const int m = m0 + q * F.NGW; if (m < M) {
                if (F.lane == 0) { rsq[m] = 1.0f / sqrtf(s1[q] * (1.f / QL) + EPS); rskv[m] = 1.0f / sqrtf(s2[q] * (1.f / KVL) + EPS); }
                if (F.lane < 2) {
                    const float cs[8] = {c0[q].x, c0[q].y, c0[q].z, c0[q].w, c1[q].x, c1[q].y, c1[q].z, c1[q].w}, sn[8] = {n0[q].x, n0[q].y, n0[q].z, n0[q].w, n1[q].x, n1[q].y, n1[q].z, n1[q].w};
                    const unsigned wa[4] = {xa[q].x, xa[q].y, xa[q].z, xa[q].w}, wb[4] = {xb[q].x, xb[q].y, xb[q].z, xb[q].w}; unsigned o1[4], o2[4];
#pragma unroll
                    for (int i = 0; i < 4; ++i) { const float a0 = bflo(wa[i]), a1 = bfhi(wa[i]), b0 = bflo(wb[i]), b1 = bfhi(wb[i]);
                        o1[i] = pk2(a0 * cs[2 * i] - b0 * sn[2 * i], a1 * cs[2 * i + 1] - b1 * sn[2 * i + 1]); o2[i] = pk2(a0 * sn[2 * i] + b0 * cs[2 * i], a1 * sn[2 * i + 1] + b1 * cs[2 * i + 1]); }
#pragma unroll
                    for (int h = 0; h < NH; ++h) { *(v4u*)(Kb + (size_t)m * 768 + h * 96 + 64 + 8 * F.lane) = (v4u){o1[0], o1[1], o1[2], o1[3]}; *(v4u*)(Kb + (size_t)m * 768 + h * 96 + 80 + 8 * F.lane) = (v4u){o2[0], o2[1], o2[2], o2[3]}; } } } }
        }
    }
}

__device__ __forceinline__ void p5_post(Frame& F, unsigned char* dout) {
    const bf16* x0 = (const bf16*)(dout + DO_X0); const bf16* zT = (const bf16*)(F.ws + WS_ZT); bf16* yc = (bf16*)(F.ws + WS_YCAT);
    const int cp = F.tid & 255, th = F.tid >> 8, c = 2 * cp;
    for (int tb = blockIdx.x; tb < L / 64; tb += F.G) {
        const int t0 = tb * 64 + th * 32; const v4u* za = (const v4u*)(zT + (size_t)c * L + t0); const v4u* zb = (const v4u*)(zT + (size_t)(c + 1) * L + t0);
        v4u qa[4], qb[4]; unsigned xv[32];
#pragma unroll
        for (int g = 0; g < 4; ++g) { qa[g] = za[g]; qb[g] = zb[g]; }
#pragma unroll
        for (int i = 0; i < 32; ++i) xv[i] = *(const unsigned*)(x0 + (size_t)(t0 + i) * 512 + c);
#pragma unroll
        for (int g = 0; g < 4; ++g) { const unsigned wa[4] = {qa[g].x, qa[g].y, qa[g].z, qa[g].w}, wb[4] = {qb[g].x, qb[g].y, qb[g].z, qb[g].w};
#pragma unroll
            for (int i = 0; i < 8; ++i) { const int k = g * 8 + i; const float zva = (i & 1) ? bfhi(wa[i >> 1]) : bflo(wa[i >> 1]), zvb = (i & 1) ? bfhi(wb[i >> 1]) : bflo(wb[i >> 1]);
                *(unsigned*)(yc + (size_t)(t0 + k) * D + c) = pk2(bflo(xv[k]) * zva, bfhi(xv[k]) * zvb); } }
    }
}

__device__ __forceinline__ void p8_route(Frame& F, const Args& A, const bf16* x1) {
    const float* mod = (const float*)(F.ws + WS_MOD); bf16* h2 = (bf16*)(F.ws + WS_H2); const float* wrt = (const float*)(F.ws + WS_WRT);
    int* toke = (int*)(F.ws + WS_TOKE); float* tokw = (float*)(F.ws + WS_TOKW); int* tokr = (int*)(F.ws + WS_TOKR); int* bcnt = (int*)(F.ws + WS_BCNT);
    LAS int* le = (LAS int*)(F.lds + 70000);
    LAS int* lr = le + 128;
    f32x4 gm[4], sh[4];
#pragma unroll
    for (int j = 0; j < 4; ++j) { const int c0 = 4 * F.lane + 256 * j; const f32x4 g = *(const f32x4*)(A.in[I_NFG] + c0), sc = *(const f32x4*)(mod + 4096 + c0); gm[j] = g * (sc + 1.0f); sh[j] = *(const f32x4*)(mod + 3072 + c0); }
    for (int rb = blockIdx.x; rb < M / 64; rb += F.G) {
        constexpr int RQ = 2;
        for (int rr0 = F.wave; rr0 < 64; rr0 += 8 * RQ) {
            f32x4 v[RQ][4]; float s[RQ]; int mrow[RQ];
#pragma unroll
            for (int q = 0; q < RQ; ++q) { const int rr = rr0 + 8 * q; const int m = rb * 64 + rr; mrow[q] = m; const v2u* xr = (const v2u*)(x1 + (size_t)m * D) + F.lane; s[q] = 0.f;
#pragma unroll
                for (int j = 0; j < 4; ++j) { const v2u xw = xr[64 * j]; v[q][j] = (f32x4){bflo(xw.x), bfhi(xw.x), bflo(xw.y), bfhi(xw.y)}; } }
#pragma unroll
            for (int q = 0; q < RQ; ++q)
#pragma unroll
                for (int j = 0; j < 4; ++j) s[q] += (v[q][j].x * v[q][j].x + v[q][j].y * v[q][j].y) + (v[q][j].z * v[q][j].z + v[q][j].w * v[q][j].w);
#pragma unroll
            for (int q = 0; q < RQ; ++q) s[q] = wave_sum(s[q]);
#pragma unroll
            for (int q = 0; q < RQ; ++q) { const float rstd = 1.0f / sqrtf(s[q] * (1.f / D) + EPS); v2u* o = (v2u*)(h2 + (size_t)mrow[q] * D) + F.lane;
#pragma unroll
                for (int j = 0; j < 4; ++j) { v[q][j] = v[q][j] * rstd * gm[j] + sh[j]; o[64 * j] = (v2u){pk2(v[q][j].x, v[q][j].y), pk2(v[q][j].z, v[q][j].w)}; } }
            float gl[RQ][4];
#pragma unroll
            for (int g = 0; g < 4; ++g) { const f32x4* wr = (const f32x4*)(wrt + g * 1024) + F.lane; float p[RQ];
#pragma unroll
                for (int q = 0; q < RQ; ++q) p[q] = 0.f;
#pragma unroll
                for (int j = 0; j < 4; ++j) { const f32x4 w = wr[64 * j];
#pragma unroll
                    for (int q = 0; q < RQ; ++q) p[q] += (v[q][j].x * w.x + v[q][j].y * w.y) + (v[q][j].z * w.z + v[q][j].w * w.w); }
#pragma unroll
                for (int q = 0; q < RQ; ++q) gl[q][g] = p[q]; }
#pragma unroll
            for (int g = 0; g < 4; ++g)
#pragma unroll
                for (int q = 0; q < RQ; ++q) gl[q][g] = wave_sum(gl[q][g]) + A.in[I_BGRP][g];
            int gi[RQ]; float gmx[RQ];
#pragma unroll
            for (int q = 0; q < RQ; ++q) { int gq = 0; float mx = -INFINITY;
#pragma unroll
                for (int g = 0; g < 4; ++g) if (gl[q][g] > mx) { mx = gl[q][g]; gq = g; }
                gi[q] = __builtin_amdgcn_readfirstlane(gq); gmx[q] = mx; }
            float ev[RQ][8];
#pragma unroll
            for (int q = 0; q < RQ; ++q)
#pragma unroll
                for (int e = 0; e < 8; ++e) { const f32x4* wr = (const f32x4*)(wrt + (4 + gi[q] * 8 + e) * 1024) + F.lane; float p = 0.f;
#pragma unroll
                    for (int j = 0; j < 4; ++j) { const f32x4 w = wr[64 * j]; p += (v[q][j].x * w.x + v[q][j].y * w.y) + (v[q][j].z * w.z + v[q][j].w * w.w); }
                    ev[q][e] = p; }
#pragma unroll
            for (int e = 0; e < 8; ++e)
#pragma unroll
                for (int q = 0; q < RQ; ++q) ev[q][e] = wave_sum(ev[q][e]) + A.in[I_BRT][gi[q] * 8 + e];
            if (F.lane == 0) {
#pragma unroll
              for (int q = 0; q < RQ; ++q) { const int m = mrow[q], rr = rr0 + 8 * q;
                float gs = 0.f;
#pragma unroll
                for (int g = 0; g < 4; ++g) gs += __expf(gl[q][g] - gmx[q]);
                const float psel = 1.0f / gs;
                int i0 = 0; float v0 = ev[q][0];
#pragma unroll
                for (int e = 1; e < 8; ++e) if (ev[q][e] > v0) { v0 = ev[q][e]; i0 = e; }
                int i1 = -1; float v1 = -INFINITY;
#pragma unroll
                for (int e = 0; e < 8; ++e) if (e != i0 && ev[q][e] > v1) { v1 = ev[q][e]; i1 = e; }
                const float e1 = __expf(v1 - v0), w0 = psel / (1.f + e1), w1 = psel * e1 / (1.f + e1);
                toke[m * 2] = gi[q] * 8 + i0; toke[m * 2 + 1] = gi[q] * 8 + i1; tokw[m * 2] = w0; tokw[m * 2 + 1] = w1;
                le[rr * 2] = gi[q] * 8 + i0; le[rr * 2 + 1] = gi[q] * 8 + i1; }
            }
        }
        __syncthreads();
        if (F.tid < 160) { const bool rk = F.tid < 128; const int me = rk ? le[F.tid] : F.tid - 128, lim = rk ? F.tid : 128; int r = 0;
#pragma unroll 8
            for (int j4 = 0; j4 < 32; ++j4) { const v4u o = *(const LAS v4u*)(le + 4 * j4);
                r += (4 * j4 < lim && (int)o.x == me) + (4 * j4 + 1 < lim && (int)o.y == me) + (4 * j4 + 2 < lim && (int)o.z == me) + (4 * j4 + 3 < lim && (int)o.w == me); }
            if (rk) lr[F.tid] = r; else __hip_atomic_store(bcnt + rb * 32 + (F.tid - 128), r, __ATOMIC_RELAXED, __HIP_MEMORY_SCOPE_AGENT); }
        if (F.tid >= 128 && F.tid < 192) { asm volatile("s_waitcnt vmcnt(0)" ::: "memory");
            if (F.tid == 128) __hip_atomic_fetch_add((unsigned*)(F.ws + WS_CTL + WS_BCCNT), 1u, __ATOMIC_RELAXED, __HIP_MEMORY_SCOPE_AGENT); }
        __syncthreads();
        if (F.tid < 128) tokr[rb * 128 + F.tid] = lr[F.tid];
        __syncthreads();
    }
    LAS float* scr = (LAS float*)(F.lds + F.wave * 8704);
    bf16* WE = (bf16*)(F.ws + WS_WE);
    constexpr int I1 = 16 * 16;
    for (int it = F.gw; it < NEXP * I1; it += F.NGW) {
        const int e = it / I1, r = it % I1; bf16* w1t = WE + (size_t)e * (512 * 1024 + 1024 * 256);
        const int g = r % 16, kb = r / 16, k0 = kb * 64; const float* sa = A.in[I_WGATE] + ((size_t)e * D + k0) * DEXP + 16 * g; const float* sb = A.in[I_WUP] + ((size_t)e * D + k0) * DEXP + 16 * g;
        transpose_item(sa, sb, DEXP, nullptr, w1t + (size_t)(32 * g) * D + k0, D, false, scr, F.lane);
    }
}
__device__ __forceinline__ void p8_wconv2(Frame& F, const Args& A, int gw, int ngw) {
    LAS float* scr = (LAS float*)(F.lds + F.wave * 8704);
    bf16* WE = (bf16*)(F.ws + WS_WE);
    constexpr int I2 = 32 * 4;
    for (int it = gw; it < NEXP * I2; it += ngw) {
        const int e = it / I2, r = it % I2; bf16* w2t = WE + (size_t)e * (512 * 1024 + 1024 * 256) + 512 * 1024;
        const int nb = r % 32, kb = r / 32, n0 = nb * 32, k0 = kb * 64; const float* sa = A.in[I_WDOWN] + ((size_t)e * DEXP + k0) * D + n0;
        transpose_item(sa, sa + 16, D, nullptr, w2t + (size_t)n0 * DEXP + k0, DEXP, false, scr, F.lane);
    }
}

__device__ __forceinline__ void moe_offsets(Frame& F, LAS int* lo, int blk) {
    const int* bcnt = (const int*)(F.ws + WS_BCNT);
    if (F.tid < 256) { const int e = F.tid & 31, ch = F.tid >> 5; int tot = 0, base = 0;
#pragma unroll 8
        for (int i = 0; i < 32; ++i) { const int b = ch * 32 + i; const int c = bcnt[b * 32 + e]; tot += c; base += (b < blk) ? c : 0; }
        tot += __shfl_xor(tot, 32); base += __shfl_xor(base, 32);
        if ((F.tid & 32) == 0) { lo[128 + (F.tid >> 6) * 32 + e] = tot; lo[(F.tid >> 6) * 32 + e] = base; } }
    __syncthreads();
    { int tot = 0, base = 0;
      if (F.tid < 32) { for (int w = 0; w < 4; ++w) { tot += lo[128 + w * 32 + F.tid]; base += lo[w * 32 + F.tid]; } }
      __syncthreads();
      if (F.tid < 32) { lo[80 + F.tid] = tot; lo[40 + F.tid] = base; } }
    __syncthreads();
    if (F.tid < 64) { const int e = F.tid & 31; const int val = (lo[80 + e] + 255) & ~255; int sc = val;
#pragma unroll
        for (int o = 1; o < 32; o <<= 1) { const int t = __shfl_up(sc, o); if (e >= o) sc += t; }
        if (F.tid < 32) { lo[e] = sc - val; if (e == 31) lo[32] = sc; } }
    __syncthreads();
}
__device__ __forceinline__ void p8b_slots(Frame& F) {
    LAS int* lo = (LAS int*)(F.lds + 70000);
    const int* toke = (const int*)(F.ws + WS_TOKE); const float* tokw = (const float*)(F.ws + WS_TOKW); const int* tokr = (const int*)(F.ws + WS_TOKR);
    int* toks = (int*)(F.ws + WS_TOKS); int* stok = (int*)(F.ws + WS_STOK); float* sw = (float*)(F.ws + WS_SW);
    if (F.tid == 0) { unsigned* p = (unsigned*)(F.ws + WS_CTL + WS_BCCNT); unsigned sp = 0; while (__hip_atomic_load(p, __ATOMIC_RELAXED, __HIP_MEMORY_SCOPE_AGENT) < (unsigned)(M / 64)) { __builtin_amdgcn_s_sleep(2); if (++sp > (1u << 22)) break; } }
    __syncthreads();
    for (int rb = blockIdx.x; rb < 256; rb += F.G) {
        moe_offsets(F, lo, rb);
        if (F.tid < 128) { const int i = rb * 128 + F.tid, e = toke[i], slot = lo[e] + lo[40 + e] + tokr[i]; toks[i] = slot; stok[slot] = i >> 1; sw[slot] = tokw[i]; }
        if (rb < 32) { const int e = rb, beg = lo[e] + lo[80 + e], end = lo[e + 1]; for (int s = beg + F.tid; s < end; s += 512) { stok[s] = 0; sw[s] = 0.f; } }
        __syncthreads();
    }
}

__device__ __forceinline__ void p11_final(Frame& F, const Args& A, float* xo) {
#ifdef HFFT_TEST
    const float tnum_ = *(const float*)(F.ws + WS_CTL + 60000), tden_ = *(const float*)(F.ws + WS_CTL + 60004); const bool tbad_ = !(tnum_ <= HFFT_TOL * tden_);
#endif
    const float* mod = (const float*)(F.ws + WS_MOD); const bf16* y = (const bf16*)(F.ws + WS_Y); const int* toks = (const int*)(F.ws + WS_TOKS);
    f32x4 g2[4], fg[4];
#pragma unroll
    for (int j = 0; j < 4; ++j) { const int c0 = 4 * F.lane + 256 * j; g2[j] = *(const f32x4*)(mod + 5120 + c0); fg[j] = *(const f32x4*)(A.in[I_FNG] + c0); }
    for (int m = F.gw; m < M; m += F.NGW) {
        f32x4* xr = (f32x4*)(xo + (size_t)m * D) + F.lane; const v2u* x1r = (const v2u*)((const bf16*)(F.ws + WS_X1B) + (size_t)m * D) + F.lane; const int s0 = toks[m * 2], s1 = toks[m * 2 + 1];
        const v2u* y0 = (const v2u*)(y + (size_t)s0 * D) + F.lane; const v2u* y1 = (const v2u*)(y + (size_t)s1 * D) + F.lane; f32x4 v[4]; float s = 0.f;
#pragma unroll
        for (int j = 0; j < 4; ++j) { const v2u a = y0[64 * j], b = y1[64 * j]; const f32x4 ys = (f32x4){bflo(a.x) + bflo(b.x), bfhi(a.x) + bfhi(b.x), bflo(a.y) + bflo(b.y), bfhi(a.y) + bfhi(b.y)};
            const v2u xw = x1r[64 * j]; v[j] = (f32x4){bflo(xw.x), bfhi(xw.x), bflo(xw.y), bfhi(xw.y)} + g2[j] * ys; s += (v[j].x * v[j].x + v[j].y * v[j].y) + (v[j].z * v[j].z + v[j].w * v[j].w); }
        const float rstd = 1.0f / sqrtf(wave_sum(s) * (1.f / D) + EPS);
#pragma unroll
        for (int j = 0; j < 4; ++j) { f32x4 ov = v[j] * rstd * fg[j];
#ifdef HFFT_TEST
            if (tbad_) ov = (f32x4){__builtin_nanf(""), 0.f, 0.f, 0.f};
#endif
            xr[64 * j] = ov; }
    }
}


namespace pg8 {
typedef short bf16x8 __attribute__((ext_vector_type(8)));
constexpr int BM = 256, BK = 64, HALF = 128, HTB = HALF * BK * 2, STAGE_BYTES = 8 * HTB, NXCD = 8, WGM = 8;
__host__ __device__ __forceinline__ int lds_byte(int r, int c) { const int st = (r >> 4) * 2 + (c >> 5), rr = r & 15, cc = c & 31, ob = rr * 64 + cc * 2; return st * 1024 + (ob ^ (((ob >> 9) & 1) << 5)); }
__host__ __device__ __forceinline__ void stage_rc(int b, int& R, int& C) { const int st = b / 1024, sb = b % 1024, swz = sb ^ (((sb >> 9) & 1) << 5); R = (st >> 1) * 16 + swz / 64; C = (st & 1) * 32 + (swz % 64) / 2; }
__host__ __device__ __forceinline__ int perm32(int rho) { const int n = rho >> 4, i = rho & 15; return 8 * (i >> 2) + 4 * n + (i & 3); }
struct Unit { int pm, pn, e; };
__device__ __forceinline__ unsigned cvt_pk_bf16(float lo, float hi) { unsigned r; asm volatile("v_cvt_pk_bf16_f32 %0, %1, %2" : "=v"(r) : "v"(lo), "v"(hi)); return r; }

struct DenseOrder {
    const bf16* A; const bf16* Bt; int lda, ldb; int nM, nN, nwg, G, c;
    __device__ void init(const bf16* A_, int lda_, const bf16* Bt_, int ldb_, int Mrows, int N, int G_, int c_) { A = A_; Bt = Bt_; lda = lda_; ldb = ldb_; nM = Mrows / BM; nN = N / BM; nwg = nM * nN; G = G_; c = c_; }
    __device__ bool next(int i, Unit& u) const {
        const long Lx = (long)i * G + c; if (Lx >= nwg) return false;
        int wgid = (int)Lx; { const int q = nwg / NXCD, r = nwg % NXCD, xcd = wgid % NXCD, off = wgid / NXCD; wgid = (xcd < r ? xcd * (q + 1) : r * (q + 1) + (xcd - r) * q) + off; }
        const int nig = WGM * nN, gid = wgid / nig, fm = gid * WGM, gsz = (nM - fm) < WGM ? (nM - fm) : WGM;
        u.pm = fm + ((wgid % nig) % gsz); u.pn = (wgid % nig) / gsz; u.e = 0; return true;
    }
    __device__ __forceinline__ const char* a_ptr(const Unit& u) const { return (const char*)(A + (size_t)u.pm * BM * lda); }
    __device__ __forceinline__ const char* b_ptr(const Unit& u) const { return (const char*)(Bt + (size_t)u.pn * BM * ldb); }
    __device__ __forceinline__ void a_rows(const Unit&, const int (&R)[2], unsigned (&ro)[2][2]) const {}
};
struct MoeOrder {
    const bf16* A; const bf16* WE; const int* stok; const LAS int* lo; int lda, ldb, nN, G, c; size_t boff;
    __device__ bool next(int i, Unit& u) const {
        const int T = lo[32] >> 8; const long Lx = (long)i * G + c; if (Lx >= (long)T * nN) return false;
        u.pm = (int)(Lx / nN); u.pn = (int)(Lx % nN); { const int l31 = (int)(threadIdx.x & 31); const unsigned long long bm = __ballot(lo[l31 + 1] <= u.pm * 256); u.e = __popc((unsigned)bm); }     return true;
    }
    __device__ __forceinline__ const char* a_ptr(const Unit& u) const { return stok ? (const char*)A : (const char*)(A + (size_t)u.pm * BM * lda); }
    __device__ __forceinline__ const char* b_ptr(const Unit& u) const { return (const char*)(WE + (size_t)u.e * (512 * 1024 + 1024 * 256) + boff + (size_t)u.pn * BM * ldb); }
    __device__ __forceinline__ void a_rows(const Unit& u, const int (&R)[2], unsigned (&ro)[2][2]) const {
#pragma unroll
        for (int h = 0; h < 2; ++h)
#pragma unroll
            for (int i = 0; i < 2; ++i) ro[h][i] = (unsigned)stok[u.pm * 256 + h * 128 + R[i]] * (unsigned)(lda * 2);
    }
};

template <class Epi, class Sched, bool GATHER, bool MID = false>
__device__ __forceinline__ void gemm_phase(LAS unsigned char* lds, const int K, const Sched& S, const Epi& E) {
    const int tid = threadIdx.x, wid = __builtin_amdgcn_readfirstlane(tid >> 6), lane = tid & 63, wr = wid >> 2, wc = wid & 3, fr = lane & 15, fq = lane >> 4;
    const int nt = K / BK; const int lda = S.lda, ldb = S.ldb;
    unsigned voffA[2], voffB[2]; int RA[2];
#pragma unroll
    for (int i = 0; i < 2; ++i) { int R, C; stage_rc(tid * 16 + i * 8192, R, C); const int Rb = Epi::PERM ? ((R & ~31) + perm32(R & 31)) : R; RA[i] = R;
        voffA[i] = GATHER ? (unsigned)(C * 2) : (unsigned)(R * lda + C) * 2u; voffB[i] = (unsigned)(Rb * ldb + C) * 2u; }
    const size_t kstep = (size_t)(BK * 2);
    const size_t hstepA = GATHER ? 0 : (size_t)HALF * lda * 2, hstepB = (size_t)HALF * ldb * 2;
    const unsigned ldsw = (unsigned)wid * 1024u;
    const int aoff = lds_byte(wr * 64 + fr, fq * 8), boff = lds_byte(wc * 32 + fr, fq * 8);
    unsigned roC[2][2] = {{0u, 0u}, {0u, 0u}}, roN[2][2] = {{0u, 0u}, {0u, 0u}};
#define PG8_SA(b, h) (((b) * 2 + (h)) * HTB)
#define PG8_SB(b, h) ((4 + (b) * 2 + (h)) * HTB)
#define PG8_STAGEB(bufoff, gbase) do { _Pragma("unroll") for (int _i = 0; _i < 2; ++_i) \
        __builtin_amdgcn_global_load_lds((const unsigned*)((const char*)(gbase) + voffB[_i]), (LAS unsigned*)(lds + (bufoff) + ldsw + _i * 8192), 16, 0, 0); } while (0)
#define PG8_STAGEA(bufoff, gbase, h, ro) do { _Pragma("unroll") for (int _i = 0; _i < 2; ++_i) \
        __builtin_amdgcn_global_load_lds((const unsigned*)((const char*)(gbase) + (h) * hstepA + voffA[_i] + (GATHER ? (ro)[h][_i] : 0u)), (LAS unsigned*)(lds + (bufoff) + ldsw + _i * 8192), 16, 0, 0); } while (0)
#define PG8_LDA(dst, b, h) do { _Pragma("unroll") for (int m = 0; m < 4; ++m) _Pragma("unroll") for (int k = 0; k < 2; ++k) dst[m][k] = *(const LAS bf16x8*)(lds + PG8_SA(b, h) + aoff + m * 2048 + k * 1024); } while (0)
#define PG8_LDB(dst, b, h) do { _Pragma("unroll") for (int n = 0; n < 2; ++n) _Pragma("unroll") for (int k = 0; k < 2; ++k) dst[n][k] = *(const LAS bf16x8*)(lds + PG8_SB(b, h) + boff + n * 2048 + k * 1024); } while (0)
#define PG8_MMA(ai, bj, At, Bt) do { __builtin_amdgcn_s_setprio(1); _Pragma("unroll") for (int m = 0; m < 4; ++m) _Pragma("unroll") for (int n = 0; n < 2; ++n) _Pragma("unroll") for (int k = 0; k < 2; ++k) \
        acc[ai][bj][m][n] = __builtin_amdgcn_mfma_f32_16x16x32_bf16(Bt[n][k], At[m][k], acc[ai][bj][m][n], 0, 0, 0); __builtin_amdgcn_s_setprio(0); } while (0)
#define PG8_WAIT_V(n) asm volatile("s_waitcnt vmcnt(" #n ")" ::: "memory")
#define PG8_WAIT_L(n) asm volatile("s_waitcnt lgkmcnt(" #n ")" ::: "memory")
#define PG8_BAR __builtin_amdgcn_s_barrier()
#define PG8_SCHED __builtin_amdgcn_sched_barrier(0)
    Unit cur, nxt; int ui = 0;
    if (!S.next(0, cur)) return;
    f32x4 acc[2][2][4][2];
#pragma unroll
    for (int a = 0; a < 2; ++a)
#pragma unroll
        for (int b = 0; b < 2; ++b)
#pragma unroll
            for (int m = 0; m < 4; ++m)
#pragma unroll
                for (int n = 0; n < 2; ++n) acc[a][b][m][n] = (f32x4){0.f, 0.f, 0.f, 0.f};
    bf16x8 At[4][2], B0[2][2], B1[2][2];
    const char* cA = S.a_ptr(cur); const char* cB = S.b_ptr(cur);
    if (GATHER) S.a_rows(cur, RA, roC);
    PG8_STAGEB(PG8_SB(0, 0), cB); PG8_STAGEB(PG8_SB(0, 1), cB + hstepB); PG8_STAGEA(PG8_SA(0, 0), cA, 0, roC); PG8_STAGEA(PG8_SA(0, 1), cA, 1, roC);
    if (wr == 1) PG8_BAR;
    PG8_WAIT_V(2); PG8_BAR;
    PG8_STAGEB(PG8_SB(1, 0), cB + kstep); PG8_STAGEA(PG8_SA(1, 0), cA + kstep, 0, roC); PG8_STAGEB(PG8_SB(1, 1), cB + hstepB + kstep);
    PG8_WAIT_V(6); PG8_BAR;
    for (;;) {
        const bool has_next = S.next(ui + 1, nxt);
        const char* nA = has_next ? S.a_ptr(nxt) : cA; const char* nB = has_next ? S.b_ptr(nxt) : cB;
        if (GATHER) { if (has_next) S.a_rows(nxt, RA, roN); else {
#pragma unroll
            for (int h = 0; h < 2; ++h)
#pragma unroll
                for (int i = 0; i < 2; ++i) roN[h][i] = roC[h][i]; } }
#pragma nounroll
        for (int t = 0; t < nt; t += 2) {
            if constexpr (MID) { if (t == (nt >> 1)) E.mid(acc, cur, wr, wc, fr, fq); }
            const bool last = (t == nt - 2);
            const char* a1 = cA + (size_t)(t + 1) * kstep;
            const char* a2 = last ? nA : cA + (size_t)(t + 2) * kstep; const char* b2 = last ? nB : cB + (size_t)(t + 2) * kstep;
            const char* a3 = a2 + kstep; const char* b3 = b2 + kstep;
            unsigned ro2[2][2];
#pragma unroll
            for (int h = 0; h < 2; ++h)
#pragma unroll
                for (int i = 0; i < 2; ++i) ro2[h][i] = GATHER ? (last ? roN[h][i] : roC[h][i]) : 0u;
            PG8_LDB(B0, 0, 0); PG8_LDB(B1, 0, 1); PG8_SCHED; PG8_LDA(At, 0, 0); PG8_STAGEA(PG8_SA(1, 1), a1, 1, roC);
            PG8_WAIT_V(8); PG8_WAIT_L(0); PG8_BAR; PG8_MMA(0, 0, At, B0); PG8_MMA(0, 1, At, B1); PG8_BAR; PG8_SCHED;
            PG8_LDA(At, 0, 1); PG8_STAGEB(PG8_SB(0, 0), b2); PG8_STAGEB(PG8_SB(0, 1), b2 + hstepB); PG8_STAGEA(PG8_SA(0, 0), a2, 0, ro2);
            PG8_WAIT_V(8); PG8_WAIT_L(0); PG8_BAR; PG8_MMA(1, 0, At, B0); PG8_MMA(1, 1, At, B1); PG8_BAR; PG8_SCHED;
            PG8_LDB(B0, 1, 0); PG8_LDB(B1, 1, 1); PG8_SCHED; PG8_LDA(At, 1, 0); PG8_STAGEA(PG8_SA(0, 1), a2, 1, ro2);
            PG8_WAIT_V(8); PG8_WAIT_L(0); PG8_BAR; PG8_MMA(0, 0, At, B0); PG8_MMA(0, 1, At, B1); PG8_BAR; PG8_SCHED;
            PG8_LDA(At, 1, 1); PG8_STAGEB(PG8_SB(1, 0), b3); PG8_STAGEB(PG8_SB(1, 1), b3 + hstepB); PG8_STAGEA(PG8_SA(1, 0), a3, 0, ro2);
            PG8_WAIT_V(8); PG8_WAIT_L(0); PG8_BAR; PG8_MMA(1, 0, At, B0); PG8_MMA(1, 1, At, B1); PG8_BAR; PG8_SCHED;
        }
        if (wr == 0) PG8_BAR;
        E(acc, cur, wr, wc, fr, fq);
        if (!has_next) break;
#pragma unroll
        for (int a = 0; a < 2; ++a)
#pragma unroll
            for (int b = 0; b < 2; ++b)
#pragma unroll
                for (int m = 0; m < 4; ++m)
#pragma unroll
                    for (int n = 0; n < 2; ++n) acc[a][b][m][n] = (f32x4){0.f, 0.f, 0.f, 0.f};
        cur = nxt; cA = nA; cB = nB; ++ui;
        if (GATHER) {
#pragma unroll
            for (int h = 0; h < 2; ++h)
#pragma unroll
                for (int i = 0; i < 2; ++i) roC[h][i] = roN[h][i]; }
        if (wr == 1) PG8_BAR;
    }
    PG8_WAIT_V(0);
    PG8_BAR;
#undef PG8_SA
#undef PG8_SB
#undef PG8_STAGEA
#undef PG8_STAGEB
#undef PG8_LDA
#undef PG8_LDB
#undef PG8_MMA
#undef PG8_WAIT_V
#undef PG8_WAIT_L
#undef PG8_BAR
#undef PG8_SCHED
}

struct EpiIn {
    static constexpr bool PERM = true; unsigned char* ws;
    __device__ __forceinline__ void operator()(const f32x4 (&acc)[2][2][4][2], const Unit& u, int wr, int wc, int fr, int fq) const {
        bf16* base; int ldc, colt; const bool sg = u.pn >= 9;
        if (u.pn < 6) { base = (bf16*)(ws + WS_PROJH); ldc = 1536; colt = u.pn * 256; } else if (u.pn < 9) { base = (bf16*)(ws + WS_PROJL); ldc = PL; colt = (u.pn - 6) * 256; } else { base = (bf16*)(ws + WS_GATES); ldc = 2048; colt = (u.pn - 9) * 256; }
        const int row0 = u.pm * BM + wr * 64 + fr, col0 = colt + wc * 32 + 8 * fq;
#pragma unroll
        for (int ai = 0; ai < 2; ++ai)
#pragma unroll
            for (int m = 0; m < 4; ++m) { bf16* rowp = base + (size_t)(row0 + ai * HALF + m * 16) * ldc + col0;
#pragma unroll
                for (int bj = 0; bj < 2; ++bj) { f32x4 v0 = acc[ai][bj][m][0], v1 = acc[ai][bj][m][1];
                    if (sg) {
#pragma unroll
                        for (int e = 0; e < 4; ++e) { v0[e] = __builtin_fmaxf(sigmoidf_(v0[e]), 8.6736174e-19f); v1[e] = __builtin_fmaxf(sigmoidf_(v1[e]), 8.6736174e-19f); } }
                    v4u w; w.x = cvt_pk_bf16(v0[0], v0[1]); w.y = cvt_pk_bf16(v0[2], v0[3]); w.z = cvt_pk_bf16(v1[0], v1[1]); w.w = cvt_pk_bf16(v1[2], v1[3]);
                    *(v4u*)(rowp + bj * HALF) = w; } }
    }
};
struct EpiQ {
    static constexpr bool PERM = false; unsigned char* ws; bf16* q;
    __device__ __forceinline__ void operator()(const f32x4 (&acc)[2][2][4][2], const Unit& u, int wr, int wc, int fr, int fq) const {
        const float* rsq = (const float*)(ws + WS_RSQ); const float* ct = (const float*)(ws + WS_ROPE); const float* st = ct + L * 16;
        const int row0 = u.pm * BM + wr * 64 + fr;
#pragma unroll
        for (int ai = 0; ai < 2; ++ai)
#pragma unroll
            for (int m = 0; m < 4; ++m) { const int row = row0 + ai * HALF + m * 16; const float sc = C2 * rsq[row];
                const f32x4 cs = *(const f32x4*)(ct + row * 16 + 4 * fq), sn = *(const f32x4*)(st + row * 16 + 4 * fq);
#pragma unroll
                for (int bj = 0; bj < 2; ++bj) { const int cg = u.pn * 256 + bj * HALF + wc * 32; f32x4 v0 = acc[ai][bj][m][0], v1 = acc[ai][bj][m][1];
                    if (((cg >> 5) % 3) == 2) { const f32x4 a = v0, b = v1; v0 = a * cs - b * sn; v1 = a * sn + b * cs; }
                    v0 = v0 * sc; v1 = v1 * sc; bf16* p = q + (size_t)row * 768 + cg + 4 * fq;
                    *(v2u*)p = (v2u){cvt_pk_bf16(v0[0], v0[1]), cvt_pk_bf16(v0[2], v0[3])}; *(v2u*)(p + 16) = (v2u){cvt_pk_bf16(v1[0], v1[1]), cvt_pk_bf16(v1[2], v1[3])}; }
                asm volatile("" ::: "memory"); }
    }
};
struct EpiKV {
    static constexpr bool PERM = true; unsigned char* ws;
    __device__ __forceinline__ void operator()(const f32x4 (&acc)[2][2][4][2], const Unit& u, int wr, int wc, int fr, int fq) const {
        const float* rs = (const float*)(ws + WS_RSKV); const int row0 = u.pm * BM + wr * 64 + fr; const bool isk = u.pn < 2;
#pragma unroll
        for (int ai = 0; ai < 2; ++ai)
#pragma unroll
            for (int m = 0; m < 4; ++m) { const int row = row0 + ai * HALF + m * 16; const float sc = rs[row];
#pragma unroll
                for (int bj = 0; bj < 2; ++bj) { const int c = u.pn * 256 + bj * HALF + wc * 32 + 8 * fq; const f32x4 v0 = acc[ai][bj][m][0] * sc, v1 = acc[ai][bj][m][1] * sc;
                    bf16* p = isk ? (bf16*)(ws + WS_K) + (size_t)row * 768 + (c >> 6) * 96 + (c & 63) : (bf16*)(ws + WS_V) + (size_t)row * 512 + (c - 512);
                    *(v4u*)p = (v4u){cvt_pk_bf16(v0[0], v0[1]), cvt_pk_bf16(v0[2], v0[3]), cvt_pk_bf16(v1[0], v1[1]), cvt_pk_bf16(v1[2], v1[3])}; } }
    }
};
struct EpiM1 {
    static constexpr bool PERM = false; unsigned char* ws; float* tmp;
    __device__ __forceinline__ void operator()(const f32x4 (&acc)[2][2][4][2], const Unit& u, int wr, int wc, int fr, int fq) const {
        const bf16* g = (const bf16*)(ws + WS_GATES); const int row0 = u.pm * BM + wr * 64 + fr, col0 = u.pn * BM + wc * 32 + 4 * fq;
#pragma unroll
        for (int ai = 0; ai < 2; ++ai)
#pragma unroll
            for (int m = 0; m < 4; ++m) { const int row = row0 + ai * HALF + m * 16;
#pragma unroll
                for (int bj = 0; bj < 2; ++bj)
#pragma unroll
                    for (int n = 0; n < 2; ++n) { const int c = col0 + bj * HALF + n * 16; const v2u gw = *(const v2u*)(g + (size_t)row * 2048 + c);
                        const f32x4 gv = (f32x4){bflo(gw.x), bfhi(gw.x), bflo(gw.y), bfhi(gw.y)}; *(f32x4*)(tmp + (size_t)row * D + c) = acc[ai][bj][m][n] * gv; } }
    }
};
struct EpiM2 {
    static constexpr bool PERM = true; unsigned char* ws; const float* tmp;
    __device__ __forceinline__ void operator()(const f32x4 (&acc)[2][2][4][2], const Unit& u, int wr, int wc, int fr, int fq) const {
        const bf16* g = (const bf16*)(ws + WS_GATES) + 1024; bf16* mix = (bf16*)(ws + WS_MIX); const int row0 = u.pm * BM + wr * 64 + fr, col0 = u.pn * BM + wc * 32 + 8 * fq;
#pragma unroll
        for (int ai = 0; ai < 2; ++ai)
#pragma unroll
            for (int m = 0; m < 4; ++m) { const int row = row0 + ai * HALF + m * 16;
#pragma unroll
                for (int bj = 0; bj < 2; ++bj) { const int c = col0 + bj * HALF; const v4u gw = *(const v4u*)(g + (size_t)row * 2048 + c);
                    const f32x4 t0 = *(const f32x4*)(tmp + (size_t)row * D + c), t1 = *(const f32x4*)(tmp + (size_t)row * D + c + 4);
                    const f32x4 v0 = t0 + acc[ai][bj][m][0] * (f32x4){bflo(gw.x), bfhi(gw.x), bflo(gw.y), bfhi(gw.y)}, v1 = t1 + acc[ai][bj][m][1] * (f32x4){bflo(gw.z), bfhi(gw.z), bflo(gw.w), bfhi(gw.w)};
                    *(v4u*)(mix + (size_t)row * D + c) = (v4u){cvt_pk_bf16(v0[0], v0[1]), cvt_pk_bf16(v0[2], v0[3]), cvt_pk_bf16(v1[0], v1[1]), cvt_pk_bf16(v1[2], v1[3])}; } }
    }
};
struct EpiMix {
    static constexpr bool PERM = true; unsigned char* ws;
    __device__ __forceinline__ void mid(f32x4 (&acc)[2][2][4][2], const Unit& u, int wr, int wc, int fr, int fq) const {
        unsigned long long gb = (unsigned long long)((const bf16*)(ws + WS_GATES) + (size_t)(u.pm * BM + wr * 64 + fr) * 2048 + u.pn * BM + wc * 32 + 8 * fq);
        asm volatile("" : "+v"(gb));
        const bf16* g = (const bf16*)gb;
#pragma unroll
        for (int ai = 0; ai < 2; ++ai)
#pragma unroll
            for (int m = 0; m < 4; ++m)
#pragma unroll
                for (int bj = 0; bj < 2; ++bj)
#pragma unroll
                    for (int n = 0; n < 2; ++n) { const bf16* p = g + (size_t)(ai * HALF + m * 16) * 2048 + bj * HALF + 4 * n; const v2u a = *(const v2u*)p, b = *(const v2u*)(p + 1024);
                        const f32x4 r = (f32x4){bflo(a.x) * __builtin_amdgcn_rcpf(bflo(b.x)), bfhi(a.x) * __builtin_amdgcn_rcpf(bfhi(b.x)), bflo(a.y) * __builtin_amdgcn_rcpf(bflo(b.y)), bfhi(a.y) * __builtin_amdgcn_rcpf(bfhi(b.y))};
                        acc[ai][bj][m][n] = acc[ai][bj][m][n] * r; asm volatile("" ::: "memory"); }
    }
    __device__ __forceinline__ void operator()(const f32x4 (&acc)[2][2][4][2], const Unit& u, int wr, int wc, int fr, int fq) const {
        const bf16* g = (const bf16*)(ws + WS_GATES) + 1024; bf16* mix = (bf16*)(ws + WS_MIX); const int row0 = u.pm * BM + wr * 64 + fr, col0 = u.pn * BM + wc * 32 + 8 * fq;
#pragma unroll
        for (int ai = 0; ai < 2; ++ai)
#pragma unroll
            for (int m = 0; m < 4; ++m) { const int row = row0 + ai * HALF + m * 16;
#pragma unroll
                for (int bj = 0; bj < 2; ++bj) { const int c = col0 + bj * HALF; const v4u gw = *(const v4u*)(g + (size_t)row * 2048 + c);
                    const f32x4 v0 = acc[ai][bj][m][0] * (f32x4){bflo(gw.x), bfhi(gw.x), bflo(gw.y), bfhi(gw.y)}, v1 = acc[ai][bj][m][1] * (f32x4){bflo(gw.z), bfhi(gw.z), bflo(gw.w), bfhi(gw.w)};
                    *(v4u*)(mix + (size_t)row * D + c) = (v4u){cvt_pk_bf16(v0[0], v0[1]), cvt_pk_bf16(v0[2], v0[3]), cvt_pk_bf16(v1[0], v1[1]), cvt_pk_bf16(v1[2], v1[3])}; } }
    }
};
struct EpiX1 {
    static constexpr bool PERM = false; unsigned char* ws; const float* x; bf16* x1;
    __device__ __forceinline__ void operator()(const f32x4 (&acc)[2][2][4][2], const Unit& u, int wr, int wc, int fr, int fq) const {
        const float* gt = (const float*)(ws + WS_MOD) + 2048; const int row0 = u.pm * BM + wr * 64 + fr, col0 = u.pn * BM + wc * 32 + 4 * fq;
        f32x4 gv[2][2];
#pragma unroll
        for (int bj = 0; bj < 2; ++bj)
#pragma unroll
            for (int n = 0; n < 2; ++n) gv[bj][n] = *(const f32x4*)(gt + col0 + bj * HALF + n * 16);
#pragma unroll
        for (int ai = 0; ai < 2; ++ai)
#pragma unroll
            for (int m = 0; m < 4; ++m) { const size_t off = (size_t)(row0 + ai * HALF + m * 16) * D + col0;
#pragma unroll
                for (int bj = 0; bj < 2; ++bj)
#pragma unroll
                    for (int n = 0; n < 2; ++n) { const f32x4 r = *(const f32x4*)(x + off + bj * HALF + n * 16) + gv[bj][n] * acc[ai][bj][m][n];
                        *(v2u*)(x1 + off + bj * HALF + n * 16) = (v2u){cvt_pk_bf16(r[0], r[1]), cvt_pk_bf16(r[2], r[3])}; } }
    }
};
struct EpiAct {
    static constexpr bool PERM = false; unsigned char* ws;
    __device__ __forceinline__ void operator()(const f32x4 (&acc)[2][2][4][2], const Unit& u, int wr, int wc, int fr, int fq) const {
        bf16* act = (bf16*)(ws + WS_ACT); const int row0 = u.pm * BM + wr * 64 + fr;
#pragma unroll
        for (int ai = 0; ai < 2; ++ai)
#pragma unroll
            for (int m = 0; m < 4; ++m) { const int row = row0 + ai * HALF + m * 16;
#pragma unroll
                for (int bj = 0; bj < 2; ++bj) { const int j = (u.pn * 256 + bj * HALF + wc * 32) / 2 + 4 * fq; const f32x4 g = acc[ai][bj][m][0], up = acc[ai][bj][m][1]; f32x4 a;
#pragma unroll
                    for (int e = 0; e < 4; ++e) a[e] = siluf_(g[e]) * up[e];
                    *(v2u*)(act + (size_t)row * DEXP + j) = (v2u){cvt_pk_bf16(a[0], a[1]), cvt_pk_bf16(a[2], a[3])}; } }
    }
};
struct EpiY {
    static constexpr bool PERM = true; unsigned char* ws;
    __device__ __forceinline__ void operator()(const f32x4 (&acc)[2][2][4][2], const Unit& u, int wr, int wc, int fr, int fq) const {
        bf16* y = (bf16*)(ws + WS_Y); const float* sw = (const float*)(ws + WS_SW); const int row0 = u.pm * BM + wr * 64 + fr, col0 = u.pn * BM + wc * 32 + 8 * fq;
#pragma unroll
        for (int ai = 0; ai < 2; ++ai)
#pragma unroll
            for (int m = 0; m < 4; ++m) { const int row = row0 + ai * HALF + m * 16; const float s = sw[row];
#pragma unroll
                for (int bj = 0; bj < 2; ++bj) { const f32x4 v0 = acc[ai][bj][m][0] * s, v1 = acc[ai][bj][m][1] * s;
                    *(v4u*)(y + (size_t)row * D + col0 + bj * HALF) = (v4u){cvt_pk_bf16(v0[0], v0[1]), cvt_pk_bf16(v0[2], v0[3]), cvt_pk_bf16(v1[0], v1[1]), cvt_pk_bf16(v1[2], v1[3])}; } }
    }
};
}


namespace att {
typedef short bf16x8 __attribute__((ext_vector_type(8)));
typedef short s16x4 __attribute__((ext_vector_type(4)));
typedef float f32x16 __attribute__((ext_vector_type(16)));
typedef short v4i16_t __attribute__((ext_vector_type(4)));
typedef LAS const char* lds_cptr;
constexpr int KSL = 12288, VSL = 8192, LDS_K = 0, LDS_V = 2 * KSL, LDS_WS = LDS_V + 2 * VSL, LDS_OST = LDS_WS + 8 * 256, LDS_BYTES_ATT = LDS_OST + 8 * 4096;
constexpr int NT = L / 64;
__device__ __forceinline__ int crow(int r, int hi) { return (r & 3) + 8 * (r >> 2) + 4 * hi; }
__device__ __forceinline__ void glds16(const void* gsrc, unsigned lds_dst) { unsigned keep;
    asm volatile("s_mov_b32 %0, m0\n\ts_mov_b32 m0, %2\n\ts_nop 0\n\tglobal_load_lds_dwordx4 %1, off\n\ts_mov_b32 m0, %0" : "=&s"(keep) : "v"(gsrc), "s"(lds_dst) : "memory"); }
__device__ __forceinline__ unsigned cvtpk(float lo, float hi) { typedef float f2 __attribute__((ext_vector_type(2))); typedef __bf16 b2 __attribute__((ext_vector_type(2))); f2 v = {lo, hi}; b2 b = __builtin_convertvector(v, b2); return __builtin_bit_cast(unsigned, b); }
__device__ __forceinline__ s16x4 vtr(lds_cptr p) { return __builtin_bit_cast(s16x4, __builtin_amdgcn_ds_read_tr16_b64_v4i16((LAS v4i16_t*)p)); }
#define MX3(a, b, c) __builtin_fmaxf(__builtin_fmaxf((a), (b)), (c))
__device__ __forceinline__ float rowmax(const f32x16& p0, const f32x16& p1) {
    float a = MX3(p0[0], p0[1], p1[0]), b = MX3(p0[2], p0[3], p1[1]); a = MX3(a, p1[2], p1[3]);
#pragma unroll
    for (int r = 4; r < 16; r += 4) { a = MX3(a, p0[r], p0[r + 1]); b = MX3(b, p0[r + 2], p0[r + 3]); a = MX3(a, p1[r], p1[r + 1]); b = MX3(b, p1[r + 2], p1[r + 3]); }
    float m = __builtin_fmaxf(a, b); auto rr = __builtin_amdgcn_permlane32_swap(__float_as_uint(m), __float_as_uint(m), false, false);
    return __builtin_fmaxf(__uint_as_float(rr[0]), __uint_as_float(rr[1])); }
#undef MX3
#define WAIT_BAR0() asm volatile("s_waitcnt vmcnt(0) lgkmcnt(0)\n\ts_barrier" ::: "memory")

template <int THRL> __device__ __forceinline__ void attn_unit(int h, int qb, const bf16* Q, const bf16* __restrict__ K, const bf16* __restrict__ V, bf16* Y, char* shm) {
    const int tid = threadIdx.x, lane = tid & 63, r32 = lane & 31, hi = lane >> 5; const int wid = __builtin_amdgcn_readfirstlane(tid >> 6);
    const int q0 = qb * 256;
    const unsigned lds0 = (unsigned)(uintptr_t)shm; float* wsf = (float*)(shm + LDS_WS) + wid * 64;
    const bf16* ksrc0 = K + h * 96 + (size_t)lane * 768 + wid * 8;
    const bf16* ksrc1 = ksrc0 + 64;
    const bf16* vsrc = V + h * 64 + (size_t)(16 * (wid & 3) + (lane >> 2)) * 512 + (wid >> 2) * 32 + (lane & 3) * 8;
    const unsigned kdst0 = lds0 + LDS_K + wid * 1024, kdst1 = kdst0 + 8192, vdst = lds0 + LDS_V + wid * 1024;
#define DMA(t, s) do { glds16(ksrc0 + (size_t)(t) * 64 * 768, (unsigned)__builtin_amdgcn_readfirstlane(kdst0 + (s) * KSL)); \
        if (wid < 4) glds16(ksrc1 + (size_t)(t) * 64 * 768, (unsigned)__builtin_amdgcn_readfirstlane(kdst1 + (s) * KSL)); \
        glds16(vsrc + (size_t)(t) * 64 * 512, (unsigned)__builtin_amdgcn_readfirstlane(vdst + (s) * VSL)); } while (0)
    DMA(0, 0);
    bf16x8 qr[6];
    { const bf16* Qw = Q + (size_t)(q0 + wid * 32 + r32) * 768 + h * 96 + hi * 8;
#pragma unroll
      for (int d0 = 0; d0 < 6; ++d0) qr[d0] = *reinterpret_cast<const bf16x8*>(Qw + d0 * 16); }
    float mhat = 0.f, l_reg = 0.f; f32x16 o[2]; o[0] = f32x16{}; o[1] = f32x16{}; f32x16 negm = f32x16{};
    const lds_cptr shm3 = (lds_cptr)shm; const lds_cptr kp0 = shm3 + LDS_K + hi * 1024 + r32 * 16;
    const lds_cptr vp0 = shm3 + LDS_V + ((lane >> 4) & 1) * 32 + (lane & 3) * 8 + (4 * hi + ((lane & 15) >> 2)) * 64;
#pragma nounroll
    for (int t = 0; t < NT; ++t) {
        WAIT_BAR0();
        const int s = t & 1;
        if (t + 1 < NT) DMA(t + 1, s ^ 1);
        const lds_cptr kp = kp0 + s * KSL; f32x16 p0 = negm, p1 = negm;
#pragma unroll
        for (int d0 = 0; d0 < 6; ++d0) { const bf16x8 b0 = *(const LAS bf16x8*)(kp + d0 * 2048), b1 = *(const LAS bf16x8*)(kp + d0 * 2048 + 512);
            p0 = __builtin_amdgcn_mfma_f32_32x32x16_bf16(b0, qr[d0], p0, 0, 0, 0); p1 = __builtin_amdgcn_mfma_f32_32x32x16_bf16(b1, qr[d0], p1, 0, 0, 0); }
        const float rm = rowmax(p0, p1);
        if (t == 0 || __any(rm > (float)THRL)) {
            const float dl = (t == 0) ? rm : __builtin_fmaxf(rm, 0.f); mhat += dl;
#pragma unroll
            for (int r = 0; r < 16; ++r) { p0[r] -= dl; p1[r] -= dl; negm[r] = -mhat; }
            const float f = __builtin_amdgcn_exp2f(-dl); l_reg *= f;
            if (t > 0) { if (hi == 0) wsf[r32] = f; asm volatile("s_waitcnt lgkmcnt(0)" ::: "memory");
#pragma unroll
                for (int d_ = 0; d_ < 2; ++d_)
#pragma unroll
                    for (int r = 0; r < 16; ++r) o[d_][r] *= wsf[crow(r, hi)]; }
        }
        float sacc = 0.f;
#pragma unroll
        for (int r = 0; r < 16; ++r) { p0[r] = __builtin_amdgcn_exp2f(p0[r]); p1[r] = __builtin_amdgcn_exp2f(p1[r]); sacc += p0[r] + p1[r]; }
        l_reg += sacc;
        bf16x8 pa[4];
#pragma unroll
        for (int ks = 0; ks < 2; ++ks) {
            const v4u w0 = (v4u){cvtpk(p0[8 * ks], p0[8 * ks + 1]), cvtpk(p0[8 * ks + 2], p0[8 * ks + 3]), cvtpk(p0[8 * ks + 4], p0[8 * ks + 5]), cvtpk(p0[8 * ks + 6], p0[8 * ks + 7])};
            const v4u w1 = (v4u){cvtpk(p1[8 * ks], p1[8 * ks + 1]), cvtpk(p1[8 * ks + 2], p1[8 * ks + 3]), cvtpk(p1[8 * ks + 4], p1[8 * ks + 5]), cvtpk(p1[8 * ks + 6], p1[8 * ks + 7])};
            pa[ks] = __builtin_bit_cast(bf16x8, w0); pa[2 + ks] = __builtin_bit_cast(bf16x8, w1); }
        const lds_cptr vp = vp0 + s * VSL;
#pragma unroll
        for (int dh = 0; dh < 2; ++dh)
#pragma unroll
            for (int ks = 0; ks < 4; ++ks) { const s16x4 vl = vtr(vp + dh * 4096 + ks * 1024), vh = vtr(vp + dh * 4096 + ks * 1024 + 512);
                const bf16x8 vf = (bf16x8){vl[0], vl[1], vl[2], vl[3], vh[0], vh[1], vh[2], vh[3]};
                o[dh] = __builtin_amdgcn_mfma_f32_32x32x16_bf16(pa[ks], vf, o[dh], 0, 0, 0); }
    }
    { auto rr = __builtin_amdgcn_permlane32_swap(__float_as_uint(l_reg), __float_as_uint(l_reg), false, false); l_reg = __uint_as_float(rr[0]) + __uint_as_float(rr[1]); }
    if (hi == 0) wsf[32 + r32] = l_reg; asm volatile("s_waitcnt lgkmcnt(0)" ::: "memory");
    float rli[16];
#pragma unroll
    for (int r = 0; r < 16; ++r) rli[r] = __builtin_amdgcn_rcpf(wsf[32 + crow(r, hi)]);
    bf16* Yw = Y + (size_t)(q0 + wid * 32) * D + h * 64; bf16* stg = (bf16*)(shm + LDS_OST) + wid * 2048;
#pragma unroll
    for (int r = 0; r < 16; ++r) { const int orow = crow(r, hi);
#pragma unroll
        for (int d0 = 0; d0 < 2; ++d0) stg[orow * 64 + d0 * 32 + r32] = (bf16)f2bf(o[d0][r] * rli[r]); }
    asm volatile("s_waitcnt lgkmcnt(0)" ::: "memory");
#pragma unroll
    for (int i = 0; i < 4; ++i) { const int row = i * 8 + (lane >> 3), ch = lane & 7; *(v4u*)(Yw + (size_t)row * D + ch * 8) = *(const v4u*)(stg + row * 64 + ch * 8); }
    asm volatile("s_waitcnt lgkmcnt(0)\n\ts_barrier" ::: "memory");
#undef DMA
}
#undef WAIT_BAR0
}


namespace att2 {
using att::bf16x8; using att::s16x4; using att::f32x16; using att::lds_cptr; using att::crow; using att::glds16; using att::cvtpk; using att::vtr; using att::rowmax;
constexpr int KSL = 12288, VSL = 8192, LDS_K = 0, LDS_V = 3 * KSL, LDS_WS = LDS_V + 3 * VSL, LDS_OST = LDS_WS + 8 * 256, LDS_BYTES_ATT = LDS_OST + 8 * 4096;
constexpr int NT = L / 64;
#define SBAR() __builtin_amdgcn_sched_barrier(0)
#define PIN(x) asm volatile("" : "+v"(x))
#define MFMA(a, b, c) __builtin_amdgcn_mfma_f32_32x32x16_bf16(a, b, c, 0, 0, 0)
#define WAIT_BAR(N) asm volatile("s_waitcnt vmcnt(" #N ") lgkmcnt(0)\n\ts_barrier" ::: "memory")
constexpr int LDS_FLAG = 96256;
template <int THRL, bool FAST> __device__ __forceinline__ void attn_unit(int h, int qb, const bf16* Q, const bf16* __restrict__ K, const bf16* __restrict__ V, bf16* Y, char* shm) {
    const int tid = threadIdx.x, lane = tid & 63, r32 = lane & 31, hi = lane >> 5; const int wid = __builtin_amdgcn_readfirstlane(tid >> 6);
    const int q0 = qb * 256;
    const unsigned lds0 = (unsigned)(uintptr_t)shm; float* wsf = (float*)(shm + LDS_WS) + wid * 64;
    const bf16* ksrc0 = K + h * 96 + (size_t)lane * 768 + wid * 8;
    const bf16* ksrc1 = ksrc0 + 64;
    const bf16* vsrc = V + h * 64 + (size_t)(16 * (wid & 3) + (lane >> 2)) * 512 + (wid >> 2) * 32 + (lane & 3) * 8;
    const unsigned kdst0 = lds0 + LDS_K + wid * 1024, kdst1 = kdst0 + 8192, vdst = lds0 + LDS_V + wid * 1024;
#define DMA_K(t, so) do { const int t_ = (t) < NT ? (t) : NT - 1; glds16(ksrc0 + (size_t)t_ * 64 * 768, (unsigned)__builtin_amdgcn_readfirstlane(kdst0 + (so))); \
        if (wid < 4) glds16(ksrc1 + (size_t)t_ * 64 * 768, (unsigned)__builtin_amdgcn_readfirstlane(kdst1 + (so))); } while (0)
#define DMA_V(t, so) do { const int t_ = (t) < NT ? (t) : NT - 1; glds16(vsrc + (size_t)t_ * 64 * 512, (unsigned)__builtin_amdgcn_readfirstlane(vdst + (so))); } while (0)
    DMA_K(0, 0); DMA_V(0, 0); DMA_K(1, KSL);
    bf16x8 qr[6];
    { const bf16* Qw = Q + (size_t)(q0 + wid * 32 + r32) * 768 + h * 96 + hi * 8;
#pragma unroll
      for (int d0 = 0; d0 < 6; ++d0) qr[d0] = *reinterpret_cast<const bf16x8*>(Qw + d0 * 16); }
    if (FAST && tid == 0) *(LAS int*)((LAS char*)shm + LDS_FLAG) = 0;
    float gmax = 0.f; float mhat = 0.f, l_reg = 0.f; f32x16 o[2]; o[0] = f32x16{}; o[1] = f32x16{}; f32x16 negm = f32x16{}; PIN(negm);
    const lds_cptr shm3 = (lds_cptr)shm; const lds_cptr kp0 = shm3 + LDS_K + hi * 1024 + r32 * 16;
    const lds_cptr vp0 = shm3 + LDS_V + ((lane >> 4) & 1) * 32 + (lane & 3) * 8 + (4 * hi + ((lane & 15) >> 2)) * 64;
    bool resc = false;
    f32x16 pA0, pA1, pB0, pB1; bf16x8 kf[4]; s16x4 vlo[8], vhi[8]; v4u pw0, pw1, pw2, pw3;
    WAIT_BAR(0);
    { pA0 = negm; pA1 = negm;
#pragma unroll
      for (int d0 = 0; d0 < 6; ++d0) { const bf16x8 b0 = *(const LAS bf16x8*)(kp0 + d0 * 2048), b1 = *(const LAS bf16x8*)(kp0 + d0 * 2048 + 512); pA0 = MFMA(b0, qr[d0], pA0); pA1 = MFMA(b1, qr[d0], pA1); }
      const float rm = rowmax(pA0, pA1); mhat = rm;
#pragma unroll
      for (int r = 0; r < 16; ++r) { pA0[r] = __builtin_amdgcn_exp2f(pA0[r] - rm); pA1[r] = __builtin_amdgcn_exp2f(pA1[r] - rm); negm[r] = -mhat; }
      PIN(negm); }
    asm volatile("s_waitcnt lgkmcnt(0)\n\ts_barrier" ::: "memory");
    DMA_K(2, 2 * KSL); DMA_V(1, VSL);
    int s_prev = 0, s_cur = 1, s_next = 2;
#define ROT() do { const int n_ = s_prev; s_prev = s_cur; s_cur = s_next; s_next = n_; } while (0)
#define RESC() do { if (resc) { _Pragma("unroll") for (int d_ = 0; d_ < 2; ++d_) _Pragma("unroll") for (int r = 0; r < 16; ++r) o[d_][r] *= wsf[crow(r, hi)]; } } while (0)
#define PKW(P, B) cvtpk(P[B], P[B + 1])
#define PAF(k) __builtin_bit_cast(bf16x8, pw##k)
#define VFR(i) (bf16x8){vlo[i][0], vlo[i][1], vlo[i][2], vlo[i][3], vhi[i][0], vhi[i][1], vhi[i][2], vhi[i][3]}
#define VRD(i) do { vlo[i] = vtr(vp_ + (((i) >> 2) * 4096 + ((i) & 3) * 1024)); vhi[i] = vtr(vp_ + (((i) >> 2) * 4096 + ((i) & 3) * 1024 + 512)); } while (0)
#define KRD(i) do { kf[(i) & 3] = *(const LAS bf16x8*)(kp_ + ((i) >> 1) * 2048 + ((i) & 1) * 512); } while (0)
#define GAPA(MF, A0, A1, A2, A3, W0, W1, PW) do { MF; sacc += A0; sacc += A1; sacc += A2; sacc += A3; PIN(sacc); W0; W1; PIN(PW); SBAR(); } while (0)
#define GAPM(MF) do { MF; SBAR(); } while (0)
#define EX(v) __builtin_amdgcn_exp2f(v)
#define GAPB(MF, X, B) do { MF; X[B] = EX(X[B]); X[B + 1] = EX(X[B + 1]); X[B + 2] = EX(X[B + 2]); X[B + 3] = EX(X[B + 3]); PIN(X); SBAR(); } while (0)
#define STEP(C0, C1, P0, P1, t) do { SBAR(); \
    const lds_cptr vp_ = vp0 + s_prev * VSL; const lds_cptr kp_ = kp0 + s_cur * KSL; \
    KRD(0); KRD(1); VRD(0); SBAR(); float sacc = (P0[0] + P0[1]); \
    KRD(2); SBAR(); GAPA(C0 = MFMA(kf[0], qr[0], negm), P0[2], P0[3], P0[4], P0[5],     pw0[0] = PKW(P0, 0),  pw0[1] = PKW(P0, 2),  pw0); \
    KRD(3); VRD(4); SBAR(); GAPA(C1 = MFMA(kf[1], qr[0], negm), P0[6], P0[7], P0[8], P0[9],     pw0[2] = PKW(P0, 4),  pw0[3] = PKW(P0, 6),  pw0); \
    KRD(4); VRD(1); SBAR(); GAPA(C0 = MFMA(kf[2], qr[1], C0),   P0[10], P0[11], P0[12], P0[13], pw1[0] = PKW(P0, 8),  pw1[1] = PKW(P0, 10), pw1); \
    KRD(5); VRD(5); SBAR(); GAPA(C1 = MFMA(kf[3], qr[1], C1),   P0[14], P0[15], P1[0], P1[1],   pw1[2] = PKW(P0, 12), pw1[3] = PKW(P0, 14), pw1); \
    KRD(6); VRD(2); SBAR(); GAPA(C0 = MFMA(kf[0], qr[2], C0),   P1[2], P1[3], P1[4], P1[5],     pw2[0] = PKW(P1, 0),  pw2[1] = PKW(P1, 2),  pw2); \
    KRD(7); VRD(6); SBAR(); GAPA(C1 = MFMA(kf[1], qr[2], C1),   P1[6], P1[7], P1[8], P1[9],     pw2[2] = PKW(P1, 4),  pw2[3] = PKW(P1, 6),  pw2); \
    KRD(8); VRD(3); SBAR(); GAPA(C0 = MFMA(kf[2], qr[3], C0),   P1[10], P1[11], P1[12], P1[13], pw3[0] = PKW(P1, 8),  pw3[1] = PKW(P1, 10), pw3); \
    KRD(9); VRD(7); SBAR(); GAPA(C1 = MFMA(kf[3], qr[3], C1),   P1[14], P1[15], 0.f, 0.f,       pw3[2] = PKW(P1, 12), pw3[3] = PKW(P1, 14), pw3); \
    KRD(10); SBAR(); GAPM(C0 = MFMA(kf[0], qr[4], C0)); \
    KRD(11); SBAR(); GAPM(C1 = MFMA(kf[1], qr[4], C1)); \
    DMA_K((t) + 2, s_prev * KSL); SBAR(); GAPM(C0 = MFMA(kf[2], qr[5], C0)); \
    DMA_V((t) + 1, s_next * VSL); SBAR(); GAPM(C1 = MFMA(kf[3], qr[5], C1)); \
    l_reg += sacc; if (FAST) gmax = __builtin_fmaxf(gmax, sacc); \
    if (!FAST) { const float rm = rowmax(C0, C1); resc = false; \
      if (__builtin_expect(__any(rm > (float)THRL), 0)) { const float dl = __builtin_fmaxf(rm, 0.f); mhat += dl; \
        _Pragma("unroll") for (int r = 0; r < 16; ++r) { C0[r] -= dl; C1[r] -= dl; } \
        _Pragma("unroll") for (int r = 0; r < 16; ++r) negm[r] = -mhat; PIN(negm); \
        const float f = __builtin_amdgcn_exp2f(-dl); l_reg *= f; if (hi == 0) wsf[r32] = f; resc = true; } } \
    SBAR(); \
    GAPB(o[0] = MFMA(PAF(0), VFR(0), o[0]), C0, 0);  GAPB(o[1] = MFMA(PAF(0), VFR(4), o[1]), C0, 4); \
    GAPB(o[0] = MFMA(PAF(1), VFR(1), o[0]), C0, 8);  GAPB(o[1] = MFMA(PAF(1), VFR(5), o[1]), C0, 12); \
    GAPB(o[0] = MFMA(PAF(2), VFR(2), o[0]), C1, 0);  GAPB(o[1] = MFMA(PAF(2), VFR(6), o[1]), C1, 4); \
    GAPB(o[0] = MFMA(PAF(3), VFR(3), o[0]), C1, 8);  GAPB(o[1] = MFMA(PAF(3), VFR(7), o[1]), C1, 12); \
    if (wid < 4) { WAIT_BAR(3); } else { WAIT_BAR(2); } \
    RESC(); ROT(); } while (0)
    int t = 1;
#pragma nounroll
    for (; t + 1 < NT; t += 2) {
        STEP(pB0, pB1, pA0, pA1, t);
        STEP(pA0, pA1, pB0, pB1, t + 1);
    }
    STEP(pB0, pB1, pA0, pA1, NT - 1);
    { float sacc = pB0[0] + pB0[1];
#pragma unroll
      for (int r = 2; r < 16; ++r) sacc += pB0[r];
#pragma unroll
      for (int r = 0; r < 16; ++r) sacc += pB1[r];
      l_reg += sacc; if (FAST) gmax = __builtin_fmaxf(gmax, sacc);
      pw0 = (v4u){PKW(pB0, 0), PKW(pB0, 2), PKW(pB0, 4), PKW(pB0, 6)}; pw1 = (v4u){PKW(pB0, 8), PKW(pB0, 10), PKW(pB0, 12), PKW(pB0, 14)};
      pw2 = (v4u){PKW(pB1, 0), PKW(pB1, 2), PKW(pB1, 4), PKW(pB1, 6)}; pw3 = (v4u){PKW(pB1, 8), PKW(pB1, 10), PKW(pB1, 12), PKW(pB1, 14)};
      const lds_cptr vp_ = vp0 + s_prev * VSL;
#pragma unroll
      for (int i = 0; i < 8; ++i) VRD(i);
      o[0] = MFMA(PAF(0), VFR(0), o[0]); o[1] = MFMA(PAF(0), VFR(4), o[1]); o[0] = MFMA(PAF(1), VFR(1), o[0]); o[1] = MFMA(PAF(1), VFR(5), o[1]);
      o[0] = MFMA(PAF(2), VFR(2), o[0]); o[1] = MFMA(PAF(2), VFR(6), o[1]); o[0] = MFMA(PAF(3), VFR(3), o[0]); o[1] = MFMA(PAF(3), VFR(7), o[1]); }
    { auto rr = __builtin_amdgcn_permlane32_swap(__float_as_uint(l_reg), __float_as_uint(l_reg), false, false); l_reg = __uint_as_float(rr[0]) + __uint_as_float(rr[1]); }
    if (hi == 0) wsf[32 + r32] = l_reg; asm volatile("s_waitcnt lgkmcnt(0)" ::: "memory");
    float rli[16];
#pragma unroll
    for (int r = 0; r < 16; ++r) rli[r] = __builtin_amdgcn_rcpf(wsf[32 + crow(r, hi)]);
    bf16* Yw = Y + (size_t)(q0 + wid * 32) * D + h * 64; bf16* stg = (bf16*)(shm + LDS_OST) + wid * 2048;
#pragma unroll
    for (int r = 0; r < 16; ++r) { const int orow = crow(r, hi);
#pragma unroll
        for (int d0 = 0; d0 < 2; ++d0) stg[orow * 64 + d0 * 32 + r32] = (bf16)f2bf(o[d0][r] * rli[r]); }
    asm volatile("s_waitcnt lgkmcnt(0)" ::: "memory");
#pragma unroll
    for (int i = 0; i < 4; ++i) { const int row = i * 8 + (lane >> 3), ch = lane & 7; *(v4u*)(Yw + (size_t)row * D + ch * 8) = *(const v4u*)(stg + row * 64 + ch * 8); }
    if (FAST) { if (__any(!(gmax < 1.0995116e12f)) && lane == 0) *(LAS int*)((LAS char*)shm + LDS_FLAG) = 1; }
    asm volatile("s_waitcnt vmcnt(0) lgkmcnt(0)\n\ts_barrier" ::: "memory");
#undef DMA_K
#undef DMA_V
#undef ROT
#undef RESC
#undef PKW
#undef PAF
#undef VFR
#undef VRD
#undef KRD
#undef GAPA
#undef GAPM
#undef GAPB
#undef EX
#undef STEP
}
#undef SBAR
#undef PIN
#undef MFMA
#undef WAIT_BAR
}

namespace toep {
typedef short bf16x8 __attribute__((ext_vector_type(8)));
typedef float f32x16 __attribute__((ext_vector_type(16)));
typedef LAS const char* lds_cptr;
constexpr int UB = 46080, WIN = 8704, LDS_U = 0, LDS_W = 2 * UB, LDS_S = LDS_W + 4 * WIN, NCH = 34;
__device__ __forceinline__ v4u funnel(v4u a, v4u b, int cq) {
    unsigned v[8] = {a.x, a.y, a.z, a.w, b.x, b.y, b.z, b.w}; const int c2 = cq >> 1;
    if (c2 & 1) {
#pragma unroll
        for (int k = 0; k < 7; ++k) v[k] = v[k + 1]; }
    if (c2 & 2) {
#pragma unroll
        for (int k = 0; k < 6; ++k) v[k] = v[k + 2]; }
    v4u o;
    if (cq & 1) { o.x = __builtin_amdgcn_alignbit(v[1], v[0], 16); o.y = __builtin_amdgcn_alignbit(v[2], v[1], 16); o.z = __builtin_amdgcn_alignbit(v[3], v[2], 16); o.w = __builtin_amdgcn_alignbit(v[4], v[3], 16); }
    else { o.x = v[0]; o.y = v[1]; o.z = v[2]; o.w = v[3]; }
    return o;
}
struct Stg { v4u a[2], e[2]; };
__device__ __forceinline__ void stage_load(Stg& s, int g, const bf16* GrX, const bf16* GrY, int lane) {
    const int sw = g >= NCH ? 1 : 0, q = g - sw * NCH; const int baseU = L + 1024 - 512 * q, baseL = baseU + 17376;
    const bf16* up = (sw ? GrY : GrX) + baseU; const bf16* lo = (sw ? GrX : GrY) + baseL; const int pe = 64 + (lane % 6);
    s.a[0] = *(const v4u*)(up + 8 * lane); s.e[0] = *(const v4u*)(up + 8 * pe);
    s.a[1] = *(const v4u*)(lo + 8 * lane); s.e[1] = *(const v4u*)(lo + 8 * pe);
}
__device__ __forceinline__ v4u shfl_dn1(v4u x) { return (v4u){(unsigned)__shfl_down((int)x.x, 1), (unsigned)__shfl_down((int)x.y, 1), (unsigned)__shfl_down((int)x.z, 1), (unsigned)__shfl_down((int)x.w, 1)}; }
__device__ __forceinline__ void stage_write(const Stg& s, char* shm, int bq, int cq, int lane) {
#pragma unroll
    for (int w = 0; w < 2; ++w) { char* img = shm + LDS_W + (bq * 2 + w) * WIN + cq * 1088;
        v4u nb = shfl_dn1(s.a[w]); const v4u ne = shfl_dn1(s.e[w]);
        const v4u e0 = (v4u){(unsigned)__builtin_amdgcn_readfirstlane((int)s.e[w].x), (unsigned)__builtin_amdgcn_readfirstlane((int)s.e[w].y), (unsigned)__builtin_amdgcn_readfirstlane((int)s.e[w].z), (unsigned)__builtin_amdgcn_readfirstlane((int)s.e[w].w)};
        if (lane == 63) nb = e0;
        *(v4u*)(img + 16 * lane) = funnel(s.a[w], nb, cq);
        if (lane < 4) *(v4u*)(img + 16 * (64 + lane)) = funnel(s.e[w], ne, cq); }
}
#define TMF(A, B, C) __builtin_amdgcn_mfma_f32_32x32x16_bf16(A, B, C, 0, 0, 0)
#define TSB() __builtin_amdgcn_sched_barrier(0)
template <int NS> __device__ __forceinline__ void chunk_fast(f32x16& a0, f32x16& a1, lds_cptr win, lds_cptr b0) {
    bf16x8 fr[3][6];
#define TLD(s, k) do { const int ao_ = 64 * (15 - (s)), bo_ = -80 * (s); fr[k][0] = *(const LAS bf16x8*)(win + ao_); fr[k][1] = *(const LAS bf16x8*)(win + ao_ + 32); \
        fr[k][2] = *(const LAS bf16x8*)(b0 + bo_); fr[k][3] = *(const LAS bf16x8*)(b0 + bo_ + 32); fr[k][4] = *(const LAS bf16x8*)(b0 + 2560 + bo_); fr[k][5] = *(const LAS bf16x8*)(b0 + 2560 + bo_ + 32); } while (0)
    TLD(0, 0); TLD(1, 1); TSB();
#pragma unroll
    for (int s = 0; s < NS; ++s) { const int k = s % 3;
        if (s + 2 < NS) TLD(s + 2, (s + 2) % 3);
        TSB();
        a0 = TMF(fr[k][0], fr[k][2], a0); a1 = TMF(fr[k][0], fr[k][4], a1); a0 = TMF(fr[k][1], fr[k][3], a0); a1 = TMF(fr[k][1], fr[k][5], a1);
        TSB(); }
#undef TLD
}
__device__ __forceinline__ void chunk_mixed(f32x16& aL, lds_cptr winL, lds_cptr bL, f32x16& aU, lds_cptr winU, lds_cptr bU) {
    bf16x8 fr[2][8];
#define TLD(s, k) do { const int ao_ = 64 * (15 - (s)), bo_ = -80 * (s); fr[k][0] = *(const LAS bf16x8*)(winL + ao_); fr[k][1] = *(const LAS bf16x8*)(winL + ao_ + 32); fr[k][2] = *(const LAS bf16x8*)(winU + ao_); fr[k][3] = *(const LAS bf16x8*)(winU + ao_ + 32); \
        fr[k][4] = *(const LAS bf16x8*)(bL + bo_); fr[k][5] = *(const LAS bf16x8*)(bL + bo_ + 32); fr[k][6] = *(const LAS bf16x8*)(bU + bo_); fr[k][7] = *(const LAS bf16x8*)(bU + bo_ + 32); } while (0)
    TLD(0, 0); TSB();
#pragma unroll
    for (int s = 0; s < 16; ++s) { const int k = s & 1;
        if (s + 1 < 16) TLD(s + 1, k ^ 1);
        TSB();
        aL = TMF(fr[k][0], fr[k][4], aL); aU = TMF(fr[k][2], fr[k][6], aU); aL = TMF(fr[k][1], fr[k][5], aL); aU = TMF(fr[k][3], fr[k][7], aU);
        TSB(); }
#undef TLD
}
#undef TSB
__device__ __forceinline__ void toep_unit(int pair, const bf16* Gr, const bf16* uT, const float* fsum, const float* hbias, bf16* zT, char* shm) {
    const int tid = threadIdx.x, lane = tid & 63, r = lane & 31, h = lane >> 5; const int wid = __builtin_amdgcn_readfirstlane(tid >> 6);
    const int cX = 2 * pair; const bf16* GrX = Gr + (size_t)cX * NG; const bf16* GrY = GrX + NG;
    if (wid < 2) { const int c = cX + wid; float s = 0.f; for (int b = lane; b < 256; b += 64) s += fsum[b * 1024 + c] + fsum[b * 1024 + 512 + c]; s = wave_sum(s); if (lane == 0) ((float*)(shm + LDS_S))[wid] = 1.0f / s; }
#pragma unroll
    for (int ch = 0; ch < 2; ++ch) { const bf16* us = uT + (size_t)(cX + ch) * L; char* ub = shm + LDS_U + ch * UB;
        for (int p = tid; p < 2048; p += 512) *(v4u*)(ub + ((p >> 2) + 32) * 80 + (p & 3) * 16) = *(const v4u*)(us + p * 8);
        if (tid < 320) { const int blk = tid / 5, sub = tid % 5, bi = blk < 32 ? blk : 512 + blk; *(v4u*)(ub + bi * 80 + sub * 16) = (v4u){0u, 0u, 0u, 0u}; } }
    Stg st; stage_load(st, 0, GrX, GrY, lane); stage_write(st, shm, 0, wid, lane);
    asm volatile("s_waitcnt vmcnt(0) lgkmcnt(0)\n\ts_barrier" ::: "memory");
    f32x16 aX0 = f32x16{}, aX1 = f32x16{}, aY0 = f32x16{}, aY1 = f32x16{};
    const lds_cptr shm3 = (lds_cptr)shm; const int ap = 31 - r; const int laneA = (ap & 7) * 1088 + 16 * (ap >> 3) + 16 * h; const int I0 = 2 * wid;
#define CHUNK_ITER(SW, COMPUTE) do { const int g = (SW) * NCH + q, bq = g & 1, dcu = -16 + 16 * q; \
        if (g + 1 < 2 * NCH) stage_load(st, g + 1, GrX, GrY, lane); \
        const lds_cptr winU = shm3 + LDS_W + (bq * 2) * WIN + laneA, winL = winU + WIN; \
        const lds_cptr bU0 = shm3 + LDS_U + ((SW) ? UB : 0) + (32 * I0 + r - dcu + 32) * 80 + 16 * h; \
        const lds_cptr bL0 = shm3 + LDS_U + ((SW) ? 0 : UB) + (32 * I0 + r - (dcu - 543) + 32) * 80 + 16 * h; \
        (void)winU; (void)winL; (void)bU0; (void)bL0; \
        COMPUTE; \
        if (g + 1 < 2 * NCH) { asm volatile("s_waitcnt vmcnt(0)" ::: "memory"); stage_write(st, shm, bq ^ 1, wid, lane); } \
        asm volatile("s_waitcnt lgkmcnt(0)\n\ts_barrier" ::: "memory"); } while (0)
#define SWEEP(SW, U0, U1, L0, L1) do { int q = 0; const int qa = 2 * I0 + 3, qb = 2 * I0 + 5; \
        _Pragma("nounroll") for (; q < qa; ++q) CHUNK_ITER(SW, chunk_fast<16>(U0, U1, winU, bU0)); \
        _Pragma("nounroll") for (; q < qb; ++q) CHUNK_ITER(SW, chunk_mixed(L0, winL, bL0, U1, winU, bU0 + 2560)); \
        _Pragma("nounroll") for (; q < NCH - 1; ++q) CHUNK_ITER(SW, chunk_fast<16>(L0, L1, winL, bL0)); \
        _Pragma("nounroll") for (; q < NCH; ++q) CHUNK_ITER(SW, chunk_fast<15>(L0, L1, winL, bL0)); } while (0)
    SWEEP(0, aX0, aX1, aY0, aY1);
    SWEEP(1, aY0, aY1, aX0, aX1);
#undef SWEEP
#undef CHUNK_ITER
#pragma unroll
    for (int ch = 0; ch < 2; ++ch) { const float invS = ((const float*)(shm + LDS_S))[ch], bias = hbias[cX + ch]; bf16* zrow = zT + (size_t)(cX + ch) * L;
#pragma unroll
        for (int ii = 0; ii < 2; ++ii) { const f32x16& a = ch == 0 ? (ii == 0 ? aX0 : aX1) : (ii == 0 ? aY0 : aY1); const int blk = 32 * (I0 + ii) + r;
#pragma unroll
            for (int g4 = 0; g4 < 4; ++g4) { const v2u uw = *(const v2u*)(shm + LDS_U + ch * UB + (blk + 32) * 80 + 16 * g4 + 8 * h);
                const float z0 = a[4 * g4] * invS + bias * bflo(uw.x), z1 = a[4 * g4 + 1] * invS + bias * bfhi(uw.x), z2 = a[4 * g4 + 2] * invS + bias * bflo(uw.y), z3 = a[4 * g4 + 3] * invS + bias * bfhi(uw.y);
                *(v2u*)(zrow + 32 * blk + 8 * g4 + 4 * h) = (v2u){pk2(z0, z1), pk2(z2, z3)}; } } }
    asm volatile("s_waitcnt lgkmcnt(0)\n\ts_barrier" ::: "memory");
}
#undef TMF
}


namespace hfft {
constexpr int FN = 32768, EX1S = 513;
constexpr size_t LDS_SC = 131584;
__host__ __device__ constexpr float twc(int j) { switch (j) { case 0: return 1.000000000e+00f; case 1: return 9.951847267e-01f; case 2: return 9.807852804e-01f; case 3: return 9.569403357e-01f; case 4: return 9.238795325e-01f; case 5: return 8.819212643e-01f; case 6: return 8.314696123e-01f; case 7: return 7.730104534e-01f; case 8: return 7.071067812e-01f; case 9: return 6.343932842e-01f; case 10: return 5.555702330e-01f; case 11: return 4.713967368e-01f; case 12: return 3.826834324e-01f; case 13: return 2.902846773e-01f; case 14: return 1.950903220e-01f; case 15: return 9.801714033e-02f; case 16: return 6.123233996e-17f; case 17: return -9.801714033e-02f; case 18: return -1.950903220e-01f; case 19: return -2.902846773e-01f; case 20: return -3.826834324e-01f; case 21: return -4.713967368e-01f; case 22: return -5.555702330e-01f; case 23: return -6.343932842e-01f; case 24: return -7.071067812e-01f; case 25: return -7.730104534e-01f; case 26: return -8.314696123e-01f; case 27: return -8.819212643e-01f; case 28: return -9.238795325e-01f; case 29: return -9.569403357e-01f; case 30: return -9.807852804e-01f; case 31: return -9.951847267e-01f; default: return 0.f; } }
__host__ __device__ constexpr float tws(int j) { switch (j) { case 0: return -0.000000000e+00f; case 1: return -9.801714033e-02f; case 2: return -1.950903220e-01f; case 3: return -2.902846773e-01f; case 4: return -3.826834324e-01f; case 5: return -4.713967368e-01f; case 6: return -5.555702330e-01f; case 7: return -6.343932842e-01f; case 8: return -7.071067812e-01f; case 9: return -7.730104534e-01f; case 10: return -8.314696123e-01f; case 11: return -8.819212643e-01f; case 12: return -9.238795325e-01f; case 13: return -9.569403357e-01f; case 14: return -9.807852804e-01f; case 15: return -9.951847267e-01f; case 16: return -1.000000000e+00f; case 17: return -9.951847267e-01f; case 18: return -9.807852804e-01f; case 19: return -9.569403357e-01f; case 20: return -9.238795325e-01f; case 21: return -8.819212643e-01f; case 22: return -8.314696123e-01f; case 23: return -7.730104534e-01f; case 24: return -7.071067812e-01f; case 25: return -6.343932842e-01f; case 26: return -5.555702330e-01f; case 27: return -4.713967368e-01f; case 28: return -3.826834324e-01f; case 29: return -2.902846773e-01f; case 30: return -1.950903220e-01f; case 31: return -9.801714033e-02f; default: return 0.f; } }
__host__ __device__ constexpr int brev(int i, int bits) { return bits == 6 ? (((i & 1) << 5) | ((i & 2) << 3) | ((i & 4) << 1) | ((i & 8) >> 1) | ((i & 16) >> 3) | ((i & 32) >> 5)) : (((i & 1) << 2) | (i & 2) | ((i & 4) >> 2)); }
template <int R, int LOG, int OFF> __device__ __forceinline__ void fft_dif(float (&re)[64], float (&im)[64]) {
#pragma unroll
    for (int s = 0; s < LOG; ++s) { const int half = R >> (s + 1);
#pragma unroll
        for (int b = 0; b < R; b += 2 * half)
#pragma unroll
            for (int j = 0; j < half; ++j) { const int i0 = OFF + b + j, i1 = i0 + half; const int tw = j * (32 / half); const float c = twc(tw), sn = tws(tw);
                const float tr = re[i0] - re[i1], ti = im[i0] - im[i1]; re[i0] += re[i1]; im[i0] += im[i1];
                if (tw == 0) { re[i1] = tr; im[i1] = ti; }
                else if (tw == 16) { re[i1] = ti; im[i1] = -tr; }
                else { re[i1] = tr * c - ti * sn; im[i1] = tr * sn + ti * c; }
                if ((j & 3) == 3 || j == half - 1) __builtin_amdgcn_sched_barrier(0); } }
}
__device__ __forceinline__ void twiddle64(float (&re)[64], float (&im)[64], float wr, float wi) {
    float cr = wr, ci = wi;
#pragma unroll
    for (int k = 1; k < 64; ++k) { const int i = brev(k, 6); const float xr = re[i], xi = im[i]; re[i] = xr * cr - xi * ci; im[i] = xr * ci + xi * cr;
        if (k < 63) { const float nr = cr * wr - ci * wi; ci = cr * wi + ci * wr; cr = nr; } if ((k & 7) == 7) __builtin_amdgcn_sched_barrier(0); }
}
#define XAT(B0, B1, C) (*(((C) < 16384) ? ((B0) + (C)) : ((B1) + ((C) - 16384))))
__device__ __forceinline__ void fft32k(float (&re)[64], float (&im)[64], LAS float* X, const float* twa, int tid_in) {
#define OPQ_TID() int tid = tid_in; asm volatile("" : "+v"(tid)); const int k1 = tid & 63, hi = tid >> 6; (void)k1; (void)hi
    float wr, wi; { OPQ_TID(); wr = twa[2 * tid]; wi = twa[2 * tid + 1]; }
#ifdef FFT_STLOOP
#pragma nounroll
#else
#pragma unroll
#endif
    for (int st = 0; st < 2; ++st) {
    fft_dif<64, 6, 0>(re, im);
    twiddle64(re, im, wr, wi);
    if (st == 0) {
    { OPQ_TID(); LAS float* w0 = X + tid; LAS float* w1 = w0 + 16384; asm volatile("" : "+v"(w1)); LAS float* r0 = X + k1 * EX1S + hi;
#pragma unroll
    for (int i = 0; i < 64; ++i) XAT(w0, w1, brev(i, 6) * EX1S) = re[i];
    __syncthreads();
#pragma unroll
    for (int m1 = 0; m1 < 64; ++m1) re[m1] = r0[8 * m1];
    __syncthreads();
#pragma unroll
    for (int i = 0; i < 64; ++i) XAT(w0, w1, brev(i, 6) * EX1S) = im[i];
    __syncthreads();
#pragma unroll
    for (int m1 = 0; m1 < 64; ++m1) im[m1] = r0[8 * m1];
    __syncthreads(); }
    { OPQ_TID(); wr = twa[2 * 64 * hi]; wi = twa[2 * 64 * hi + 1]; }
    } else {
    { OPQ_TID(); LAS float* w0 = X + hi * 64 + k1; LAS float* w1 = w0 + 16384; asm volatile("" : "+v"(w1)); LAS float* r0 = X + hi * 4096 + k1;
#pragma unroll
    for (int i = 0; i < 64; ++i) XAT(w0, w1, brev(i, 6) * 512) = re[i];
    __syncthreads();
#pragma unroll
    for (int e = 0; e < 8; ++e)
#pragma unroll
        for (int m2 = 0; m2 < 8; ++m2) re[8 * e + m2] = r0[(e * 8 + m2) * 64];
    __syncthreads();
#pragma unroll
    for (int i = 0; i < 64; ++i) XAT(w0, w1, brev(i, 6) * 512) = im[i];
    __syncthreads();
#pragma unroll
    for (int e = 0; e < 8; ++e)
#pragma unroll
        for (int m2 = 0; m2 < 8; ++m2) im[8 * e + m2] = r0[(e * 8 + m2) * 64];
    __syncthreads(); }
    } }
    fft_dif<8, 3, 0>(re, im); fft_dif<8, 3, 8>(re, im); fft_dif<8, 3, 16>(re, im); fft_dif<8, 3, 24>(re, im);
    fft_dif<8, 3, 32>(re, im); fft_dif<8, 3, 40>(re, im); fft_dif<8, 3, 48>(re, im); fft_dif<8, 3, 56>(re, im);
#undef OPQ_TID
}
__device__ __forceinline__ void reg_barrier(float (&re)[64], float (&im)[64]) {
#pragma unroll
    for (int i = 0; i < 64; i += 8) { asm volatile("" : "+v"(re[i]), "+v"(re[i + 1]), "+v"(re[i + 2]), "+v"(re[i + 3]), "+v"(re[i + 4]), "+v"(re[i + 5]), "+v"(re[i + 6]), "+v"(re[i + 7]));
        asm volatile("" : "+v"(im[i]), "+v"(im[i + 1]), "+v"(im[i + 2]), "+v"(im[i + 3]), "+v"(im[i + 4]), "+v"(im[i + 5]), "+v"(im[i + 6]), "+v"(im[i + 7])); }
    asm volatile("" ::: "memory"); __builtin_amdgcn_sched_barrier(0);
}
typedef _Float16 h2_t __attribute__((ext_vector_type(2)));
__device__ __forceinline__ unsigned ldg_off(const unsigned* base, unsigned off) { asm volatile("" : "+v"(off)); return *(const unsigned*)((const char*)base + off); }
__device__ __forceinline__ void stg_off(unsigned* base, unsigned off, unsigned v) { asm volatile("" : "+v"(off)); *(unsigned*)((char*)base + off) = v; }
__device__ __forceinline__ void conv_pair(const bf16* GrA, const bf16* GrB, const bf16* uA, const bf16* uB, bf16* zA, bf16* zB, float invSA, float invSB, float biasA, float biasB,
                                          const float* twa, unsigned* scr, LAS float* X, int tid_in) {
#define OPQ_T() int tid = tid_in; asm volatile("" : "+v"(tid))
#pragma nounroll
    for (int pass = 0; pass < 3; ++pass) {
    float re[64], im[64];
    if (pass == 0) {
    { OPQ_T(); const unsigned tr = 511u - (unsigned)tid;
#pragma unroll
    for (int n1 = 0; n1 < 64; ++n1) { float va, vb;
        if (n1 < 32) { va = bf2f((GrA + (LAGMAX - 511 - 512 * n1))[tr]); vb = bf2f((GrB + (LAGMAX - 511 - 512 * n1))[tr]); }
        else { va = bf2f((GrA + (LAGMAX - 511 + 2 * L - 512 * n1))[tr]); vb = bf2f((GrB + (LAGMAX - 511 + 2 * L - 512 * n1))[tr]); if (n1 == 32 && tid == 0) { va = 0.f; vb = 0.f; } }
        re[n1] = va; im[n1] = vb; } }
    } else if (pass == 1) {
    { OPQ_T();
#pragma unroll
    for (int n1 = 0; n1 < 64; ++n1) { re[n1] = (n1 < 32) ? bf2f((uA + 512 * n1)[tid]) : 0.f; im[n1] = (n1 < 32) ? bf2f((uB + 512 * n1)[tid]) : 0.f; } }
    } else {
    { OPQ_T(); const unsigned bb = (unsigned)((tid & 63) + 512 * ((tid >> 6) & 7)), bq = 3647u - bb, ob = bb << 2, oq = bq << 2;
      const LAS unsigned* o0 = (const LAS unsigned*)X + bb; const LAS unsigned* o1 = o0 + 16384; asm volatile("" : "+v"(o1));
      const LAS unsigned* p0 = (const LAS unsigned*)X + bq; const LAS unsigned* p1 = p0 + 16384; asm volatile("" : "+v"(p1));
#pragma unroll
    for (int ch = 0; ch < 8; ++ch) {
        unsigned cz[8], cq[8], ck[8], cp[8];
#pragma unroll
        for (int q = 0; q < 8; ++q) { const int c = 64 * ch + 4096 * brev(q, 3);
            if (c == 0) { const unsigned ip = (unsigned)(FN - (int)bb) & (unsigned)(FN - 1); cq[q] = ((const LAS unsigned*)X)[ip]; cp[q] = ldg_off(scr, ip << 2); }
            else { cq[q] = XAT(p0, p1, FN - 3647 - c); cp[q] = ldg_off(scr, oq + 4u * (unsigned)(FN - 3647 - c)); }
            cz[q] = XAT(o0, o1, c); ck[q] = ldg_off(scr, ob + 4u * (unsigned)c); }
#pragma unroll
        for (int q = 0; q < 8; ++q) { const int r = 8 * ch + q;
            const h2_t zo = __builtin_bit_cast(h2_t, cz[q]), zp = __builtin_bit_cast(h2_t, cq[q]), wk = __builtin_bit_cast(h2_t, ck[q]), wp = __builtin_bit_cast(h2_t, cp[q]);
            const float zr = (float)zo.y, zi = (float)zo.x, pr = (float)zp.y, pi = (float)zp.x, wr = (float)wk.x, wi = (float)wk.y, qr = (float)wp.x, qi = (float)wp.y;
            const float uar = zr + pr, uai = zi - pi, ubr = zi + pi, ubi = pr - zr;
            const float gar = wr + qr, gai = wi - qi, gbr = wi + qi, gbi = qr - wr;
            re[r] = (uar * gar - uai * gai) - (ubr * gbi + ubi * gbr);
            im[r] = -((uar * gai + uai * gar) + (ubr * gbr - ubi * gbi)); }
        __builtin_amdgcn_sched_barrier(0); } }
    __syncthreads();
    reg_barrier(re, im);
    { OPQ_T(); const int k1 = tid & 63, jg = tid >> 6; LAS float* w0 = X + jg * 512 + k1; LAS float* w1 = w0 + 16384; asm volatile("" : "+v"(w1)); LAS float* r0 = X + tid; LAS float* r1 = r0 + 16384; asm volatile("" : "+v"(r1));
#pragma unroll
    for (int e = 0; e < 8; ++e)
#pragma unroll
        for (int i = 0; i < 8; ++i) XAT(w0, w1, brev(i, 3) * 4096 + 64 * e) = re[8 * e + i];
    __syncthreads();
#pragma unroll
    for (int n1 = 0; n1 < 64; ++n1) re[n1] = XAT(r0, r1, n1 * 512);
    __syncthreads();
#pragma unroll
    for (int e = 0; e < 8; ++e)
#pragma unroll
        for (int i = 0; i < 8; ++i) XAT(w0, w1, brev(i, 3) * 4096 + 64 * e) = im[8 * e + i];
    __syncthreads();
#pragma unroll
    for (int n1 = 0; n1 < 64; ++n1) im[n1] = XAT(r0, r1, n1 * 512);
    __syncthreads(); }
    }
    reg_barrier(re, im);
    fft32k(re, im, X, twa, tid_in);
    reg_barrier(re, im);
    if (pass == 0) {
    { OPQ_T(); const unsigned ob = (unsigned)((tid & 63) + 512 * ((tid >> 6) & 7)) << 2;
#pragma unroll
    for (int e = 0; e < 8; ++e)
#pragma unroll
        for (int i = 0; i < 8; ++i) { const h2_t hv = {(_Float16)(re[8 * e + i] * 0.015625f), (_Float16)(im[8 * e + i] * 0.015625f)}; stg_off(scr, ob + 4u * (unsigned)(64 * e + 4096 * brev(i, 3)), __builtin_bit_cast(unsigned, hv)); } }
    } else if (pass == 1) {
    { OPQ_T(); LAS unsigned* w0 = (LAS unsigned*)X + (tid & 63) + 512 * (tid >> 6); LAS unsigned* w1 = w0 + 16384; asm volatile("" : "+v"(w1));
#pragma unroll
    for (int e = 0; e < 8; ++e)
#pragma unroll
        for (int i = 0; i < 8; ++i) { const h2_t hv = {(_Float16)(im[8 * e + i] * 0.015625f), (_Float16)(re[8 * e + i] * 0.015625f)}; XAT(w0, w1, 64 * e + 4096 * brev(i, 3)) = __builtin_bit_cast(unsigned, hv); } }
    asm volatile("s_waitcnt vmcnt(0)" ::: "memory");
    __syncthreads();
    } else {
    OPQ_T(); const int k1 = tid & 63, jg = tid >> 6;
    const float scA = invSA * (1024.0f / (float)FN), scB = -invSB * (1024.0f / (float)FN);
#pragma unroll
    for (int e = 0; e < 8; ++e)
#pragma unroll
        for (int i = 0; i < 8; i += 2) { const int tc = 64 * e + 4096 * brev(i, 3), tv = k1 + 512 * jg;
            (zA + tc)[tv] = (bf16)f2bf(re[8 * e + i] * scA + biasA * bf2f((uA + tc)[tv])); (zB + tc)[tv] = (bf16)f2bf(im[8 * e + i] * scB + biasB * bf2f((uB + tc)[tv])); }
    }
    asm volatile("" ::: "memory"); __builtin_amdgcn_sched_barrier(0);
    }
#undef OPQ_T
}
__device__ __forceinline__ void conv_unit(int pair, const bf16* Gr, const bf16* uT, const float* fsum, const float* hbias, bf16* zT, const float* twa, unsigned* scr, char* shm, int wid) {
    const int lane = fresh_lane(), tid = wid * 64 + lane; LAS float* X = (LAS float*)shm; LAS float* SC = (LAS float*)(shm + LDS_SC);
    const int cX = 2 * pair;
    if (wid < 2) { const int c = cX + wid; float s = 0.f; for (int b = lane; b < 256; b += 64) s += fsum[b * 1024 + c] + fsum[b * 1024 + 512 + c]; s = wave_sum(s); if (lane == 0) SC[wid] = 1.0f / s; }
    __syncthreads();
    conv_pair(Gr + (size_t)cX * NG, Gr + (size_t)(cX + 1) * NG, uT + (size_t)cX * L, uT + (size_t)(cX + 1) * L, zT + (size_t)cX * L, zT + (size_t)(cX + 1) * L, SC[0], SC[1], hbias[cX], hbias[cX + 1], twa, scr, X, tid);
    __syncthreads();
}
}

#define XB_TMO      128
#define XB_XCNT(j)  (256  + 64 * (j))
#define XB_XSUB(j)  (1280 + 64 * (j))
#define XB_XGEN(j)  (2304 + 64 * (j))
#define XB_TOP      3328
#define XB_TOPGEN   3392
#define XCD_BAR_WORDS 3456
#define XB_SPIN_CAP (1u << 18)
__device__ __forceinline__ unsigned xb_ld(unsigned* p)              { return __hip_atomic_load(p, __ATOMIC_RELAXED, __HIP_MEMORY_SCOPE_AGENT); }
__device__ __forceinline__ unsigned xb_add(unsigned* p, unsigned v) { return __hip_atomic_fetch_add(p, v, __ATOMIC_RELAXED, __HIP_MEMORY_SCOPE_AGENT); }
__device__ __forceinline__ unsigned xb_xcc_id() { return (unsigned)__builtin_amdgcn_s_getreg((3 << 11) | 20) & 0xFu; }
#define XB_SPIN(cond, bar) do { unsigned _sp = 0; while (cond) { __builtin_amdgcn_s_sleep(1); \
    if ((++_sp & 255u) == 0u) { if (xb_ld(&(bar)[XB_TMO])) break; if (_sp > XB_SPIN_CAP) { atomicAdd(&(bar)[XB_TMO], 1u); break; } } } } while (0)
struct XcdBarrier { unsigned* bar; unsigned x; volatile LAS unsigned* st; };
__device__ __forceinline__ XcdBarrier xcd_barrier_post(unsigned* bar, volatile LAS unsigned* st) {
    XcdBarrier b; b.bar = bar; b.x = xb_xcc_id(); b.st = st;
    if (threadIdx.x == 0) (void)xb_add(&bar[XB_XCNT(b.x)], 1u);
    return b;
}
__device__ __forceinline__ void xcd_barrier_complete(unsigned* bar, unsigned x, unsigned& nloc, unsigned& nx) {
    const unsigned G = gridDim.x * gridDim.y * gridDim.z;
    unsigned sum, cnt, mine, sp = 0u;
    for (;;) {
        sum = 0u; cnt = 0u; mine = 0u;
#pragma unroll
        for (unsigned j = 0; j < 16; ++j) { const unsigned c = xb_ld(&bar[XB_XCNT(j)]); sum += c; cnt += (c > 0u) ? 1u : 0u; mine = (j == x) ? c : mine; }
        if (sum == G) break;
        __builtin_amdgcn_s_sleep(1);
        if ((++sp & 255u) == 0u) { if (xb_ld(&bar[XB_TMO])) break; if (sp > XB_SPIN_CAP) { atomicAdd(&bar[XB_TMO], 1u); break; } }
    }
    nloc = mine > 0u ? mine : 1u; nx = cnt > 0u ? cnt : 1u;
}
__device__ __forceinline__ void xcd_barrier(const XcdBarrier& b) {
    asm volatile("s_waitcnt vmcnt(0)" ::: "memory");
    __syncthreads();
    if (threadIdx.x == 0) {
        unsigned* bar = b.bar;
        __builtin_amdgcn_s_waitcnt(0);
        unsigned nloc = b.st[0], nx = b.st[1];
        if (nloc == 0u) { xcd_barrier_complete(bar, b.x, nloc, nx); b.st[0] = nloc; b.st[1] = nx; }
        const unsigned old = xb_add(&bar[XB_XSUB(b.x)], 1u);
        const unsigned gen = old / nloc;
        if (old + 1u == (gen + 1u) * nloc) {
            __builtin_amdgcn_fence(__ATOMIC_RELEASE, "agent");
            asm volatile("s_waitcnt vmcnt(0)" ::: "memory");
            const unsigned og = xb_add(&bar[XB_TOP], 1u);
            const unsigned tg = og / nx;
            if (og + 1u == (tg + 1u) * nx) xb_add(&bar[XB_TOPGEN], 1u);
            else XB_SPIN(xb_ld(&bar[XB_TOPGEN]) == tg, bar);
            __builtin_amdgcn_fence(__ATOMIC_ACQUIRE, "agent");
            xb_add(&bar[XB_XGEN(b.x)], 1u);
            asm volatile("s_waitcnt vmcnt(0)" ::: "memory");
        } else {
            XB_SPIN(xb_ld(&bar[XB_XGEN(b.x)]) == gen, bar);
            __builtin_amdgcn_fence(__ATOMIC_ACQUIRE, "agent");
            asm volatile("s_waitcnt vmcnt(0)" ::: "memory");
        }
    }
    __syncthreads();
}

constexpr int LDS_BYTES = 135168;
__global__ void __launch_bounds__(512, 2) mk(Args args) {
    extern __shared__ __attribute__((aligned(16))) unsigned char lds[];
    Frame F; F.ws = args.ws; F.lds = (LAS unsigned char*)lds;
    F.tid = threadIdx.x; F.lane = F.tid & 63; F.wave = __builtin_amdgcn_readfirstlane(F.tid >> 6);
    F.G = gridDim.x; { const int bx = blockIdx.x; F.vcu = (F.G % 8 == 0) ? (bx % 8) * (F.G / 8) + bx / 8 : bx; }
    F.gw = F.vcu * 8 + F.wave; F.NGW = F.G * 8;
    const int lo = args.ph_lo, hi = args.ph_hi;
    { volatile LAS unsigned* mz = (volatile LAS unsigned*)(F.lds + 133120); if (F.tid < 16) mz[F.tid] = 0u; }
    __syncthreads();
    XcdBarrier bar; bar.bar = (unsigned*)(F.ws + WS_CTL) + args.li * 4096; bar.x = 0; bar.st = nullptr;
    if (hi - lo > 1) bar = xcd_barrier_post((unsigned*)(F.ws + WS_CTL) + args.li * 4096, (volatile LAS unsigned*)(F.lds + 133120));
#define SEAM(k) do { if (IN(k) && IN((k) + 1)) xcd_barrier(bar); } while (0)
#define SEAMX(k, j) do { if (IN(k) && IN(j)) xcd_barrier(bar); } while (0)
#ifndef PHMASK
#define PHMASK 0xffffff
#endif
#define IN(k) (((PHMASK >> (k)) & 1) && lo <= (k) && (k) < hi)
    if (IN(0)) { p0_mod(F, args); p0_weights(F, args, 0, P0W_IN, F.gw, F.NGW, false); }
    if (!(IN(0) && IN(1))) { SEAM(0); }
    if (IN(1)) { p0b_h1(F, args); }
    SEAM(1);
    if (IN(2)) { pg8::DenseOrder S; S.init((const bf16*)(F.ws + WS_H1), D, (const bf16*)(F.ws + WS_WIN), D, M, NIN, F.G, (int)blockIdx.x); pg8::EpiIn E{F.ws};
        pg8::gemm_phase<pg8::EpiIn, pg8::DenseOrder, false>(F.lds, D, S, E);
        { const int nlong = (int)(((long)(M / 256) * (NIN / 256)) % F.G); const bool all = (nlong == 0);
          if (all || (int)blockIdx.x >= nlong) { const int bi = all ? (int)blockIdx.x : (int)blockIdx.x - nlong, nb = all ? F.G : F.G - nlong;
              __syncthreads();
              p0_weights(F, args, P0W_IN, P0W_ALL, bi * 8 + F.wave, nb * 8, true); p0_filter(F, args, bi, nb); } } }
    SEAM(2);
    if (IN(3)) { p2_prep(F, args, (unsigned char*)args.out); }
    SEAM(3);
    if (IN(4)) {
#if !defined(PH4SEL) || PH4SEL == 0
        { pg8::DenseOrder S; S.init((const bf16*)(F.ws + WS_PROJL), PL, (const bf16*)(F.ws + WS_WUQ), QL, M, 768, F.G, (int)blockIdx.x); pg8::EpiQ E{F.ws, (bf16*)((unsigned char*)args.out + DO_Q)};
          pg8::gemm_phase<pg8::EpiQ, pg8::DenseOrder, false>(F.lds, QL, S, E); }
#endif
#if !defined(PH4SEL) || PH4SEL == 1
        { pg8::DenseOrder S; S.init((const bf16*)(F.ws + WS_PROJL) + 384, PL, (const bf16*)(F.ws + WS_WUKV), KVL, M, 1024, F.G, (int)blockIdx.x); pg8::EpiKV E{F.ws};
          pg8::gemm_phase<pg8::EpiKV, pg8::DenseOrder, false>(F.lds, KVL, S, E); }
#endif
    }
    SEAM(4);
    if (IN(5)) {
        const bf16* Q = (const bf16*)((unsigned char*)args.out + DO_Q); const bf16* Kb = (const bf16*)(F.ws + WS_K); const bf16* Vb = (const bf16*)(F.ws + WS_V); bf16* Y = (bf16*)(F.ws + WS_YCAT) + 512;
        for (int u = blockIdx.x; u < 512; u += F.G) { att2::attn_unit<8, true>(u & 7, u >> 3, Q, Kb, Vb, Y, (char*)lds);
            const int redo = __builtin_amdgcn_readfirstlane(*(volatile LAS int*)(lds + att2::LDS_FLAG)); __syncthreads();
            if (redo) att2::attn_unit<8, false>(u & 7, u >> 3, Q, Kb, Vb, Y, (char*)lds); }
#ifdef HFFT_TEST
        for (int u = blockIdx.x; u < 256; u += F.G) { bf16* z2 = (2 * u < 256) ? (bf16*)(F.ws + 44 * MiB) : (bf16*)(F.ws + 152 * MiB) - (size_t)256 * L;
            hfft::conv_unit(u, (const bf16*)(F.ws + WS_GR), (const bf16*)((unsigned char*)args.out + DO_UT), (const float*)(F.ws + WS_FSUM), args.in[I_HBIAS], z2, (const float*)(F.ws + WS_TWA), (unsigned*)(F.ws + WS_FSCR) + (size_t)blockIdx.x * 32768, (char*)lds, F.wave); }
#endif
#ifndef HFFT_TEST
#ifdef CONV_REPS
        _Pragma("nounroll") for (int rep_ = 0; rep_ < CONV_REPS; ++rep_)
#endif
        for (int u = blockIdx.x; u < 256; u += F.G) hfft::conv_unit(u, (const bf16*)(F.ws + WS_GR), (const bf16*)((unsigned char*)args.out + DO_UT), (const float*)(F.ws + WS_FSUM), args.in[I_HBIAS], (bf16*)(F.ws + WS_ZT), (const float*)(F.ws + WS_TWA), (unsigned*)(F.ws + WS_FSCR) + (size_t)blockIdx.x * 32768, (char*)lds, F.wave);
#else
        for (int u = blockIdx.x; u < 256; u += F.G) toep::toep_unit(u, (const bf16*)(F.ws + WS_GR), (const bf16*)((unsigned char*)args.out + DO_UT), (const float*)(F.ws + WS_FSUM), args.in[I_HBIAS], (bf16*)(F.ws + WS_ZT), (char*)lds);
#endif
#ifdef HFFT_TEST
        asm volatile("s_waitcnt vmcnt(0)" ::: "memory"); __syncthreads();
        for (int u = blockIdx.x; u < 256; u += F.G) { const bf16* za = (const bf16*)(F.ws + WS_ZT) + (size_t)(2 * u) * L; const bf16* zb = ((2 * u < 256) ? (const bf16*)(F.ws + 44 * MiB) : (const bf16*)(F.ws + 152 * MiB) - (size_t)256 * L) + (size_t)(2 * u) * L; float num = 0.f, den = 0.f;
            for (int i = F.tid; i < 2 * L; i += 512) { const float a = bf2f(za[i]), b = bf2f(zb[i]); num += (a - b) * (a - b); den += a * a; }
            num = wave_sum(num); den = wave_sum(den);
            if (F.lane == 0) { atomicAdd((float*)(F.ws + WS_CTL + 60000), num); atomicAdd((float*)(F.ws + WS_CTL + 60004), den); } }
#endif
    }
    SEAM(5);
    if (IN(6)) { p5_post(F, (unsigned char*)args.out); }
    SEAM(6);
    if (IN(7)) { pg8::DenseOrder S; S.init((const bf16*)(F.ws + WS_YCAT), D, (const bf16*)(F.ws + WS_WCAT), D, M, D, F.G, (int)blockIdx.x); pg8::EpiMix E{F.ws};
        pg8::gemm_phase<pg8::EpiMix, pg8::DenseOrder, false, true>(F.lds, D, S, E); }
    SEAMX(7, 9);
    if (IN(9)) { pg8::DenseOrder S; S.init((const bf16*)(F.ws + WS_MIX), D, (const bf16*)(F.ws + WS_WMIX), D, M, D, F.G, (int)blockIdx.x); pg8::EpiX1 E{F.ws, args.in[I_X], (bf16*)(F.ws + WS_X1B)};
        pg8::gemm_phase<pg8::EpiX1, pg8::DenseOrder, false>(F.lds, D, S, E); }
    SEAM(9);
    if (IN(10)) { p8_route(F, args, (const bf16*)(F.ws + WS_X1B)); }
      if (!(IN(10) && IN(11))) { SEAM(10); }
    if (IN(11)) { p8b_slots(F); }
    SEAM(11);
    if (IN(12)) { LAS int* lo = (LAS int*)(F.lds + 132096); moe_offsets(F, lo, 0);
        pg8::MoeOrder S{(const bf16*)(F.ws + WS_H2), (const bf16*)(F.ws + WS_WE), (const int*)(F.ws + WS_STOK), lo, D, D, 2, F.G, (int)blockIdx.x, 0}; pg8::EpiAct E{F.ws};
        pg8::gemm_phase<pg8::EpiAct, pg8::MoeOrder, true>(F.lds, D, S, E);
        { const int n1 = (lo[32] >> 8) * 2, nl = (n1 > F.G && n1 < 2 * F.G) ? n1 - F.G : 0; const bool all = (nl == 0);
          if (all || (int)blockIdx.x >= nl) { const int bi = all ? (int)blockIdx.x : (int)blockIdx.x - nl, nb = all ? F.G : F.G - nl; __syncthreads(); p8_wconv2(F, args, bi * 8 + F.wave, nb * 8); } } }
    SEAM(12);
    if (IN(13)) { LAS int* lo = (LAS int*)(F.lds + 132096); moe_offsets(F, lo, 0);
        pg8::MoeOrder S{(const bf16*)(F.ws + WS_ACT), (const bf16*)(F.ws + WS_WE), nullptr, lo, DEXP, DEXP, 4, F.G, (int)blockIdx.x, (size_t)512 * 1024}; pg8::EpiY E{F.ws};
        pg8::gemm_phase<pg8::EpiY, pg8::MoeOrder, false>(F.lds, DEXP, S, E); }
    SEAM(13);
    if (IN(14)) { p11_final(F, args, args.out); }
#undef IN
}

enum { E_IN = 0, E_Q, E_KV, E_M1, E_M2, E_X1, E_ACT, E_Y };
struct NG_ { const bf16* A; int lda; const bf16* BT; int ldb; int K; int N; unsigned char* ws; unsigned char* dout; const float* x; };
__device__ __forceinline__ float ndot(const bf16* a, const bf16* b, int K) { float s = 0.f; for (int k = 0; k < K; k += 2) { const unsigned wa = *(const unsigned*)(a + k), wb = *(const unsigned*)(b + k); s += bflo(wa) * bflo(wb) + bfhi(wa) * bfhi(wb); } return s; }
template <int MODE> __global__ void __launch_bounds__(256) k_ngemm(NG_ p) {
    const int col = blockIdx.x * 256 + threadIdx.x, row = blockIdx.y; if (col >= p.N) return;
    unsigned char* ws = p.ws; const float* mod = (const float*)(ws + WS_MOD);
    if (MODE == E_IN) { const float acc = ndot(p.A + (size_t)row * p.lda, p.BT + (size_t)col * p.ldb, p.K);
        if (col < 1536) ((bf16*)(ws + WS_PROJH))[(size_t)row * 1536 + col] = (bf16)f2bf(acc);
        else if (col < 2304) ((bf16*)(ws + WS_PROJL))[(size_t)row * PL + col - 1536] = (bf16)f2bf(acc);
        else ((bf16*)(ws + WS_GATES))[(size_t)row * 2048 + col - 2304] = (bf16)f2bf(sigmoidf_(acc)); }
    if (MODE == E_Q) { const int h = col / 96, d = col % 96; const float sc = C2 * ((const float*)(ws + WS_RSQ))[row]; const float* ct = (const float*)(ws + WS_ROPE); const float* st = ct + L * 16;
        float acc = ndot(p.A + (size_t)row * p.lda, p.BT + (size_t)col * p.ldb, p.K), o = acc;
        if (d >= 64) { const int i = (d - 64) & 15; const int pc = h * 96 + (d < 80 ? d + 16 : d - 16); const float other = ndot(p.A + (size_t)row * p.lda, p.BT + (size_t)pc * p.ldb, p.K);
            const float cs = ct[row * 16 + i], sn = st[row * 16 + i]; o = d < 80 ? acc * cs - other * sn : other * sn + acc * cs; }
        ((bf16*)(p.dout + DO_Q))[(size_t)row * 768 + col] = (bf16)f2bf(o * sc); }
    if (MODE == E_KV) { const float acc = ndot(p.A + (size_t)row * p.lda, p.BT + (size_t)col * p.ldb, p.K) * ((const float*)(ws + WS_RSKV))[row];
        if (col < 512) ((bf16*)(ws + WS_K))[(size_t)row * 768 + (col >> 6) * 96 + (col & 63)] = (bf16)f2bf(acc); else ((bf16*)(ws + WS_V))[(size_t)row * 512 + col - 512] = (bf16)f2bf(acc); }
    if (MODE == E_M1) { const float acc = ndot(p.A + (size_t)row * p.lda, p.BT + (size_t)col * p.ldb, p.K);
        ((float*)p.dout)[(size_t)row * D + col] = acc * bf2f(((const bf16*)(ws + WS_GATES))[(size_t)row * 2048 + col]); }
    if (MODE == E_M2) { const float acc = ndot(p.A + (size_t)row * p.lda, p.BT + (size_t)col * p.ldb, p.K);
        ((bf16*)(ws + WS_MIX))[(size_t)row * D + col] = (bf16)f2bf(((const float*)p.dout)[(size_t)row * D + col] + acc * bf2f(((const bf16*)(ws + WS_GATES))[(size_t)row * 2048 + 1024 + col])); }
    if (MODE == E_X1) { const float acc = ndot(p.A + (size_t)row * p.lda, p.BT + (size_t)col * p.ldb, p.K);
        ((float*)p.dout)[(size_t)row * D + col] = p.x[(size_t)row * D + col] + mod[2048 + col] * acc; }
    if (MODE == E_ACT || MODE == E_Y) {
        __shared__ int lo[33];
        if (threadIdx.x == 0) { const int* bcnt = (const int*)(ws + WS_BCNT); int o = 0; for (int e = 0; e < 32; ++e) { int tot = 0; for (int b = 0; b < 256; ++b) tot += bcnt[b * 32 + e]; lo[e] = o; o += (tot + 255) & ~255; } lo[32] = o; }
        __syncthreads();
        if (row >= lo[32]) return; int e = 0; while (row >= lo[e + 1]) ++e;
        const bf16* WE = (const bf16*)(ws + WS_WE) + (size_t)e * (512 * 1024 + 1024 * 256);
        if (MODE == E_ACT) { const int tok = ((const int*)(ws + WS_STOK))[row]; const bf16* a = (const bf16*)(ws + WS_H2) + (size_t)tok * D; const int gr = 32 * (col >> 4) + (col & 15);
            const float g = ndot(a, WE + (size_t)gr * D, D), u = ndot(a, WE + (size_t)(gr + 16) * D, D);
            ((bf16*)(ws + WS_ACT))[(size_t)row * DEXP + col] = (bf16)f2bf(siluf_(g) * u); }
        else { const float acc = ndot((const bf16*)(ws + WS_ACT) + (size_t)row * DEXP, WE + 512 * 1024 + (size_t)col * DEXP, DEXP);
            ((bf16*)(ws + WS_Y))[(size_t)row * D + col] = (bf16)f2bf(acc * ((const float*)(ws + WS_SW))[row]); }
    }
}

__global__ void __launch_bounds__(256) k_nattn(const bf16* Q, const bf16* K, const bf16* V, bf16* ycat) {
    const int t = blockIdx.x * 256 + threadIdx.x, h = blockIdx.y;
    float q[96]; { const bf16* qp = Q + (size_t)t * 768 + h * 96; for (int d = 0; d < 96; ++d) q[d] = bf2f(qp[d]); }
    float o[64]; for (int d = 0; d < 64; ++d) o[d] = 0.f; float m = -INFINITY, l = 0.f;
    for (int j = 0; j < L; ++j) { const unsigned* kp = (const unsigned*)(K + (size_t)j * 768 + h * 96); float s = 0.f;
#pragma unroll
        for (int d = 0; d < 48; ++d) { const unsigned w = kp[d]; s += q[2 * d] * bflo(w) + q[2 * d + 1] * bfhi(w); }
        const float mn = fmaxf(m, s), al = exp2f(m - mn), p = exp2f(s - mn); l = l * al + p; m = mn;
        const unsigned* vp = (const unsigned*)(V + (size_t)j * 512 + h * 64);
#pragma unroll
        for (int d = 0; d < 32; ++d) { const unsigned w = vp[d]; o[2 * d] = o[2 * d] * al + p * bflo(w); o[2 * d + 1] = o[2 * d + 1] * al + p * bfhi(w); } }
    const float il = 1.f / l; bf16* op = ycat + (size_t)t * D + 512 + h * 64; for (int d = 0; d < 64; ++d) op[d] = (bf16)f2bf(o[d] * il);
}
__global__ void __launch_bounds__(256) k_ntoep(const bf16* Gr, const bf16* uT, const float* fsum, const float* hbias, bf16* zT) {
    const int t = blockIdx.x * 256 + threadIdx.x, c = blockIdx.y; const bf16* g = Gr + (size_t)c * NG; const bf16* u = uT + (size_t)c * L;
    float S = 0.f; for (int b = 0; b < 256; ++b) S += fsum[b * 1024 + c] + fsum[b * 1024 + 512 + c];
    float acc = 0.f; for (int s = 0; s < L; ++s) acc += bf2f(u[s]) * bf2f(g[LAGMAX - (t - s)]);
    zT[(size_t)c * L + t] = (bf16)f2bf(acc / S + hbias[c] * bf2f(u[t]));
}

extern "C" void kernel_launch(void* const* d_in, const int* in_sizes, int n_in, void* d_out, int out_size, void* d_ws, size_t ws_size, hipStream_t stream) {
    static int grid = 0;
    if (grid == 0) {
        if (n_in != 33 || out_size != M * D || ws_size < 256 * MiB) { fprintf(stderr, "kernel_launch: unexpected shapes (n_in %d out %d ws %zu)\n", n_in, out_size, ws_size); grid = -1; return; }
        int dev = 0, cus = 0; hipGetDevice(&dev); hipDeviceGetAttribute(&cus, hipDeviceAttributeMultiprocessorCount, dev);
        hipFuncSetAttribute((const void*)mk, hipFuncAttributeMaxDynamicSharedMemorySize, LDS_BYTES);
        grid = cus > 0 ? cus : 256;
    }
    if (grid < 0) return;
    hipMemsetAsync((char*)d_ws + WS_CTL, 0, 64 * 1024, stream);
    Args a{}; for (int i = 0; i < 33; ++i) a.in[i] = (const float*)d_in[i]; a.out = (float*)d_out; a.ws = (unsigned char*)d_ws;
    int nl = 0; auto run = [&](int lo, int hi) { a.ph_lo = lo; a.ph_hi = hi; a.li = (nl++) & 3; hipLaunchKernelGGL(mk, dim3(grid), dim3(512), LDS_BYTES, stream, a); };
#ifdef MULTI
    for (int p = 0; p < 15; ++p) run(p, p + 1);
#elif defined(PROBE_A)
    run(0, PROBE_B); run(PROBE_A, 15);
#else
    run(0, 15);
#endif
}
```

```cpp
#include <hip/hip_runtime.h>
#include <cstdint>
#include <cstdio>
#include <cmath>

constexpr int D = 1024, L = 16384, M = L;
constexpr int HY = 512, NH = 8, QKD = 96, VH = 64, QL = 384, KVL = 256;
constexpr int NIN = 4352;
constexpr int PL = 768;
constexpr int NEXP = 32, DEXP = 256, NGRP = 4, EPG = 8;
constexpr float EPS = 1e-6f;
constexpr float C2 = 0.10206207261596575f * 1.4426950408889634f;
constexpr int LAGMAX = L + 1023;
constexpr int NG = 2 * L + 3072;
constexpr int MAXSLOT = 40960;

constexpr size_t MiB = 1u << 20;
constexpr size_t WS_CTL = 0;
constexpr size_t WS_MOD = 64 * 1024;
constexpr size_t WS_BCCNT = 57856;
constexpr size_t WS_MODCNT = 57600;
constexpr size_t WS_RSQ = 128 * 1024, WS_RSKV = 192 * 1024;
constexpr size_t WS_FSUM = 256 * 1024;
constexpr size_t WS_ROPE = 1280 * 1024;
constexpr size_t WS_WRT = 3328 * 1024;
constexpr size_t WS_TWA = 96 * 1024;
constexpr size_t WS_FSCR = 160 * MiB;
constexpr size_t WS_TOKE = 3584 * 1024;
constexpr size_t WS_TOKW = WS_TOKE + 128 * 1024;
constexpr size_t WS_TOKR = WS_TOKW + 128 * 1024;
constexpr size_t WS_TOKS = WS_TOKR + 128 * 1024;
constexpr size_t WS_BCNT = WS_TOKS + 128 * 1024;
constexpr size_t WS_STOK = WS_BCNT + 32 * 1024;
constexpr size_t WS_SW = WS_STOK + 160 * 1024;
static_assert(WS_SW + 160 * 1024 <= 6 * MiB, "misc region");
constexpr size_t WS_WB = 6 * MiB;
constexpr size_t WS_WIN = WS_WB;
constexpr size_t WS_WUQ = WS_WIN + (size_t)NIN * D * 2;
constexpr size_t WS_WUKV = WS_WUQ + 768 * 384 * 2;
constexpr size_t WS_WCAT = WS_WUKV + 1024 * 256 * 2;
constexpr size_t WS_WMIX = WS_WCAT + 1024 * 1024 * 2;
static_assert(WS_WMIX + 1024 * 1024 * 2 <= 20 * MiB, "WB region");
constexpr size_t WS_R1 = 20 * MiB;
constexpr size_t WS_R2 = 52 * MiB;
constexpr size_t WS_R3 = 88 * MiB;
constexpr size_t WS_R4 = 136 * MiB;
constexpr size_t WS_R5 = 192 * MiB;
constexpr size_t WS_H1 = WS_R1, WS_K = WS_R1, WS_H2 = WS_R1;
constexpr size_t WS_GR = WS_R2, WS_MIX = WS_R2;
constexpr size_t WS_PROJH = WS_R3, WS_V = WS_R3, WS_YCAT = WS_R3 + 16 * MiB;
constexpr size_t WS_PROJL = WS_R4, WS_ZT = WS_R4, WS_ACT = WS_R4;
constexpr size_t WS_GATES = WS_R5, WS_WE = WS_R5;
constexpr size_t WS_X1B = 104 * MiB;
constexpr size_t WS_Y = 20 * MiB;
static_assert((size_t)512 * NG * 2 <= 36 * MiB, "Gr fits");
constexpr size_t DO_X0 = 0, DO_UT = 16 * MiB, DO_Q = 32 * MiB;

typedef unsigned short bf16;
typedef unsigned v4u __attribute__((ext_vector_type(4)));
typedef unsigned v2u __attribute__((ext_vector_type(2)));
typedef float f32x4 __attribute__((ext_vector_type(4)));
#define LAS __attribute__((address_space(3)))

__device__ __forceinline__ unsigned f2bf(float f) { unsigned u = __builtin_bit_cast(unsigned, f); return (u + 0x7fffu + ((u >> 16) & 1u)) >> 16; }
__device__ __forceinline__ float bf2f(unsigned b) { return __builtin_bit_cast(float, (b & 0xffffu) << 16); }
__device__ __forceinline__ unsigned pk2(float lo, float hi) { unsigned r; asm("v_cvt_pk_bf16_f32 %0, %1, %2" : "=v"(r) : "v"(lo), "v"(hi)); return r; }
__device__ __forceinline__ float bflo(unsigned w) { return __builtin_bit_cast(float, w << 16); }
__device__ __forceinline__ float bfhi(unsigned w) { return __builtin_bit_cast(float, w & 0xffff0000u); }
__device__ __forceinline__ float wave_sum(float v) {
#pragma unroll
    for (int o = 1; o < 64; o <<= 1) v += __shfl_xor(v, o);
    return v;
}
__device__ __forceinline__ float sigmoidf_(float v) { return __builtin_amdgcn_rcpf(1.f + __expf(-v)); }
__device__ __forceinline__ float siluf_(float v) { return v * __builtin_amdgcn_rcpf(1.f + __expf(-v)); }

__device__ __forceinline__ int fresh_lane() { int l; asm volatile("v_mbcnt_lo_u32_b32 %0, -1, 0\n\tv_mbcnt_hi_u32_b32 %0, -1, %0" : "=v"(l)); return l; }
struct Args { const float* in[33]; float* out; unsigned char* ws; int ph_lo, ph_hi, li, pad; };
enum { I_X = 0, I_C, I_ADAW, I_ADAB, I_NMG, I_WIN, I_HCW, I_HCB, I_FW1, I_FB1, I_FF1, I_FW2, I_FB2, I_FF2, I_FW3, I_HBIAS, I_QNG, I_KVNG, I_WUQ, I_WUK, I_WUV,
       I_WHY, I_WMLA, I_WMIX, I_NFG, I_WGRP, I_BGRP, I_WRT, I_BRT, I_WGATE, I_WUP, I_WDOWN, I_FNG };

struct Frame {
    unsigned char* ws; LAS unsigned char* lds;
    int tid, lane, wave, vcu, G, gw, NGW;
};

__device__ __forceinline__ void transpose_item(const float* srcA, const float* srcB, int ldw, const float* kscale, bf16* dst, int ldk, bool zero, LAS float* scr, int lane) {
    const float* s = (lane & 16) ? srcB + ((lane & 31) - 16) : srcA + (lane & 31);
    float tv[32];
#pragma unroll
    for (int i = 0; i < 32; ++i) { const int kk = 2 * i + (lane >> 5); tv[i] = zero ? 0.f : s[(size_t)kk * ldw]; }
#pragma unroll
    for (int i = 0; i < 32; ++i) { const int kk = 2 * i + (lane >> 5); float v = tv[i]; if (kscale) v *= kscale[kk]; scr[kk * 33 + (lane & 31)] = v; }
    asm volatile("s_waitcnt lgkmcnt(0)" ::: "memory");
    const int c = lane & 7;
#pragma unroll
    for (int j = 0; j < 4; ++j) { const int n = (lane >> 3) + 8 * j; const LAS float* p = scr + (8 * c) * 33 + n;
        v4u o; o.x = pk2(p[0 * 33], p[1 * 33]); o.y = pk2(p[2 * 33], p[3 * 33]); o.z = pk2(p[4 * 33], p[5 * 33]); o.w = pk2(p[6 * 33], p[7 * 33]);
        *(v4u*)(dst + (size_t)n * ldk + 8 * c) = o; }
    asm volatile("s_waitcnt lgkmcnt(0)" ::: "memory");
}

constexpr int P0W_IN = (NIN / 32) * (D / 64), P0W_ALL = P0W_IN + (768 / 32) * (QL / 64) + (1024 / 32) * (KVL / 64) + 32 * 16 + 32 * 16;
__device__ __forceinline__ void p0_weights(Frame& F, const Args& A, int it_lo, int it_hi, int gw, int ngw, bool tables) {
    LAS float* scr = (LAS float*)(F.lds + F.wave * 8704);
    constexpr int I_IN = (NIN / 32) * (D / 64), I_UQ = (768 / 32) * (QL / 64), I_UKV = (1024 / 32) * (KVL / 64), I_CAT = 32 * 16, I_MIX = 32 * 16;
    for (int it = it_lo + gw; it < it_hi; it += ngw) {
        int r = it; const float* s; int ldw; const float* ksc = nullptr; bf16* dst; int ldk; bool pad = false;
        if (r < I_IN) { const int nb = r % (NIN / 32), kb = r / (NIN / 32), n0 = nb * 32, k0 = kb * 64; pad = (n0 >= 2208 && n0 < 2304); const int sc = n0 < 2208 ? n0 : n0 - 96;
            s = A.in[I_WIN] + (size_t)k0 * 4256 + (pad ? 0 : sc); ldw = 4256; dst = (bf16*)(F.ws + WS_WIN) + (size_t)n0 * D + k0; ldk = D; }
        else if ((r -= I_IN) < I_UQ) { const int nb = r % 24, kb = r / 24, n0 = nb * 32, k0 = kb * 64; s = A.in[I_WUQ] + (size_t)k0 * 768 + n0; ldw = 768; ksc = A.in[I_QNG] + k0;
            dst = (bf16*)(F.ws + WS_WUQ) + (size_t)n0 * QL + k0; ldk = QL; }
        else if ((r -= I_UQ) < I_UKV) { const int nb = r % 32, kb = r / 32, n0 = nb * 32, k0 = kb * 64; s = (n0 < 512 ? A.in[I_WUK] + n0 : A.in[I_WUV] + (n0 - 512)) + (size_t)k0 * 512; ldw = 512; ksc = A.in[I_KVNG] + k0;
            dst = (bf16*)(F.ws + WS_WUKV) + (size_t)n0 * KVL + k0; ldk = KVL; }
        else if ((r -= I_UKV) < I_CAT) { const int nb = r % 32, kb = r / 32, n0 = nb * 32, k0 = kb * 64; s = (kb < 8 ? A.in[I_WHY] + (size_t)k0 * D : A.in[I_WMLA] + (size_t)(k0 - 512) * D) + n0; ldw = D;
            dst = (bf16*)(F.ws + WS_WCAT) + (size_t)n0 * D + k0; ldk = D; }
        else { r -= I_CAT; const int nb = r % 32, kb = r / 32, n0 = nb * 32, k0 = kb * 64; s = A.in[I_WMIX] + (size_t)k0 * D + n0; ldw = D; dst = (bf16*)(F.ws + WS_WMIX) + (size_t)n0 * D + k0; ldk = D; }
        transpose_item(s, s + 16, ldw, ksc, dst, ldk, pad, scr, F.lane);
    }
    if (!tables) return;
    float* wrt = (float*)(F.ws + WS_WRT);
    for (int i = gw * 64 + F.lane; i < 36 * 1024; i += ngw * 64) { const int o = i >> 10, k = i & 1023; wrt[i] = o < 4 ? A.in[I_WGRP][k * 4 + o] : A.in[I_WRT][k * 32 + (o - 4)]; }
    { float* tw = (float*)(F.ws + WS_TWA); for (int i = gw * 64 + F.lane; i < 512; i += ngw * 64) { const float xr = -(float)i * (1.0f / 16384.0f); tw[2 * i] = cospif(xr); tw[2 * i + 1] = sinpif(xr); } }
    float* ct = (float*)(F.ws + WS_ROPE); float* st = ct + L * 16;
    const double inv = pow(10000.0, -(double)(F.lane & 15) / 16.0);
    for (int i = gw * 64 + F.lane; i < L * 16; i += ngw * 64) { const int pos = i >> 4; const double ang = (double)pos * inv;
        const double q = rint(ang * 0.15915494309189535); double r = fma(-q, 6.283185307179586232, ang); r = fma(-q, 2.4492935982947064e-16, r); const float rf = (float)r;
        ct[i] = cosf(rf); st[i] = sinf(rf); }
}

__device__ __forceinline__ void p0_mod(Frame& F, const Args& A) {
    LAS float* red = (LAS float*)(F.lds + 70000);
    for (int ob = blockIdx.x; ob < 256; ob += F.G) {
        const int j = F.tid & 31, kq = F.tid >> 5; float acc = 0.f;
        if (j < 24) { float cv[64], wv[64];
#pragma unroll
            for (int i = 0; i < 64; ++i) { const int k = kq + 16 * i; cv[i] = A.in[I_C][k]; wv[i] = A.in[I_ADAW][(size_t)k * 6144 + ob * 24 + j]; }
#pragma unroll
            for (int i = 0; i < 64; ++i) acc += siluf_(cv[i]) * wv[i]; }
        red[kq * 32 + j] = acc; __syncthreads();
        if (F.tid < 64) { if (F.tid < 24) { float s = A.in[I_ADAB][ob * 24 + F.tid]; for (int q = 0; q < 16; ++q) s += red[q * 32 + F.tid]; __hip_atomic_store((float*)(F.ws + WS_MOD) + ob * 24 + F.tid, s, __ATOMIC_RELAXED, __HIP_MEMORY_SCOPE_AGENT); }
            asm volatile("s_waitcnt vmcnt(0)" ::: "memory");
            if (F.tid == 0) __hip_atomic_fetch_add((unsigned*)(F.ws + WS_CTL + WS_MODCNT), 1u, __ATOMIC_RELAXED, __HIP_MEMORY_SCOPE_AGENT); }
        __syncthreads();
    }
}

__device__ __forceinline__ void p0_filter(Frame& F, const Args& A, int pb0, int npb) {
    typedef short bf16x8_ __attribute__((ext_vector_type(8))); typedef float f32x16_ __attribute__((ext_vector_type(16)));
    LAS float* Z = (LAS float*)(F.lds + 72192);
    LAS float* H1 = Z + 65 * 36;
    LAS bf16* H2B = (LAS bf16*)(H1 + 65 * 64);
    bf16* Gr = (bf16*)(F.ws + WS_GR);
    const int lane = F.lane, c32 = lane & 31, h = lane >> 5;
    LAS float* WL = (LAS float*)(F.lds);
    __syncthreads();
    for (int i = F.tid; i < 2112; i += 512) WL[i] = A.in[I_FW1][i];
    for (int i = F.tid; i < 4096; i += 512) WL[2112 + i] = A.in[I_FW2][i];
    if (F.tid < 64) { WL[6208 + F.tid] = A.in[I_FB1][F.tid]; WL[6272 + F.tid] = A.in[I_FB2][F.tid]; WL[6336 + F.tid] = A.in[I_FF1][F.tid]; WL[6400 + F.tid] = A.in[I_FF2][F.tid]; }
    __syncthreads();
    if (pb0 >= 256) return;
    bf16x8_ bfr[4][4];
#pragma unroll
    for (int dc = 0; dc < 4; ++dc) { const int dir = dc >> 1, c = 32 * (2 * F.wave + (dc & 1)) + c32;
#pragma unroll
        for (int ks = 0; ks < 4; ++ks) { const float* wp = A.in[I_FW3] + (size_t)(16 * ks + 8 * h) * 1024 + dir * 512 + c; float w[8];
#pragma unroll
            for (int jj = 0; jj < 8; ++jj) w[jj] = wp[jj * 1024];
            const v4u pk = (v4u){pk2(w[0], w[1]), pk2(w[2], w[3]), pk2(w[4], w[5]), pk2(w[6], w[7])}; bfr[dc][ks] = __builtin_bit_cast(bf16x8_, pk); } }
    for (int pb = pb0; pb < 256; pb += npb) {
        const int k0 = pb * 64;
        for (int i = F.tid; i < 65 * 33; i += 512) { const int kk = i / 33, f = i % 33, k = k0 + kk; float v;
            if (f == 0) v = (float)k / (float)(L - 1);
            else { const int bi = (f - 1) & 15; const float band = 1e-4f + (float)bi * ((15.0f - 1e-4f) / 15.0f); const float ang = 6.283185307179586f * band * (float)k / (float)L;
                   v = (f <= 16) ? cosf(ang) : -sinf(ang); }
            Z[kk * 36 + f] = v; }
        __syncthreads();
        { const int o = F.tid & 63, kq = F.tid >> 6; float w[33];
#pragma unroll
          for (int f = 0; f < 33; ++f) w[f] = WL[f * 64 + o];
          const float b = WL[6208 + o], fq = WL[6336 + o];
          for (int kk = kq; kk < 65; kk += 8) { float acc = b; const LAS f32x4* zr = (const LAS f32x4*)(Z + kk * 36);
#pragma unroll
              for (int f4 = 0; f4 < 8; ++f4) { const f32x4 zv = zr[f4]; acc += zv.x * w[4 * f4]; acc += zv.y * w[4 * f4 + 1]; acc += zv.z * w[4 * f4 + 2]; acc += zv.w * w[4 * f4 + 3]; }
              acc += Z[kk * 36 + 32] * w[32];
              H1[kk * 64 + o] = sinf(fq * acc); } }
        __syncthreads();
        { const int o = F.tid & 63, kq = F.tid >> 6; float w[64];
#pragma unroll
          for (int m = 0; m < 64; ++m) w[m] = WL[2112 + m * 64 + o];
          const float b = WL[6272 + o], fq = WL[6400 + o];
          for (int kk = kq; kk < 65; kk += 8) { float acc = b; const LAS f32x4* hr = (const LAS f32x4*)(H1 + kk * 64);
#pragma unroll
              for (int m4 = 0; m4 < 16; ++m4) { const f32x4 hv = hr[m4]; acc += hv.x * w[4 * m4]; acc += hv.y * w[4 * m4 + 1]; acc += hv.z * w[4 * m4 + 2]; acc += hv.w * w[4 * m4 + 3]; }
              H2B[kk * 72 + o] = (bf16)f2bf(sinf(fq * acc)); } }
        __syncthreads();
#pragma unroll
        for (int dc = 0; dc < 4; ++dc) { const int dir = dc >> 1, ct = 2 * F.wave + (dc & 1), c = 32 * ct + c32;
            const float adel = 3.0701134573253945f + (float)c * ((15.350567286626973f - 3.0701134573253945f) / 511.0f);
            float asum = 0.f; bf16* row = Gr + (size_t)c * NG;
#pragma unroll
            for (int rt = 0; rt < 2; ++rt) { f32x16_ acc = f32x16_{};
#pragma unroll
                for (int ks = 0; ks < 4; ++ks) { const bf16x8_ af = *(const LAS bf16x8_*)((LAS const char*)H2B + (32 * rt + c32 + dir) * 144 + 32 * ks + 16 * h);
                    acc = __builtin_amdgcn_mfma_f32_32x32x16_bf16(af, bfr[dc][ks], acc, 0, 0, 0); }
#pragma unroll
                for (int g4 = 0; g4 < 4; ++g4) { const int p = 32 * rt + 8 * g4 + 4 * h; float v[4];
#pragma unroll
                    for (int e = 0; e < 4; ++e) { const int k = k0 + p + e + dir; const float t = (float)k * (1.0f / (float)(L - 1)); float x = acc[4 * g4 + e] * (__expf(-t * adel) + 0.05f); if (k >= L) x = 0.f; v[e] = x; asum += fabsf(x); }
                    if (dir == 0) *(v2u*)(row + (LAGMAX - k0 - p - 3)) = (v2u){pk2(v[3], v[2]), pk2(v[1], v[0])};
                    else *(v2u*)(row + (LAGMAX + 1 + k0 + p)) = (v2u){pk2(v[0], v[1]), pk2(v[2], v[3])}; } }
            asum += __shfl_xor(asum, 32);
            if (h == 0) ((float*)(F.ws + WS_FSUM))[pb * 1024 + dir * 512 + c] = asum;
        }
        { bf16* row = Gr + (size_t)F.tid * NG; *(v2u*)(row + 4 * pb) = (v2u){0u, 0u}; *(v4u*)(row + 2 * L + 1024 + 8 * pb) = (v4u){0u, 0u, 0u, 0u}; }
        __syncthreads();
    }
}

__device__ __forceinline__ void p0b_h1(Frame& F, const Args& A) {
    const float* mod = (const float*)(F.ws + WS_MOD); bf16* h1 = (bf16*)(F.ws + WS_H1);
    if (F.tid == 0) { unsigned* p = (unsigned*)(F.ws + WS_CTL + WS_MODCNT); unsigned sp = 0; while (__hip_atomic_load(p, __ATOMIC_RELAXED, __HIP_MEMORY_SCOPE_AGENT) < 256u) { __builtin_amdgcn_s_sleep(2); if (++sp > (1u << 22)) break; } }
    __syncthreads();
    f32x4 gm[4], sh[4];
#pragma unroll
    for (int j = 0; j < 4; ++j) { const int c0 = 4 * F.lane + 256 * j; const f32x4 g = *(const f32x4*)(A.in[I_NMG] + c0), sc = *(const f32x4*)(mod + 1024 + c0); gm[j] = g * (sc + 1.0f); sh[j] = *(const f32x4*)(mod + c0); }
    for (int m = F.gw; m < M; m += F.NGW) {
        const f32x4* xr = (const f32x4*)(A.in[I_X] + (size_t)m * D) + F.lane; f32x4 v[4]; float s = 0.f;
#pragma unroll
        for (int j = 0; j < 4; ++j) { v[j] = xr[64 * j]; s += (v[j].x * v[j].x + v[j].y * v[j].y) + (v[j].z * v[j].z + v[j].w * v[j].w); }
        const float rstd = 1.0f / sqrtf(wave_sum(s) * (1.f / D) + EPS);
        v2u* o = (v2u*)(h1 + (size_t)m * D) + F.lane;
#pragma unroll
        for (int j = 0; j < 4; ++j) { const f32x4 y = v[j] * rstd * gm[j] + sh[j]; o[64 * j] = (v2u){pk2(y.x, y.y), pk2(y.z, y.w)}; }
    }
}

__device__ __forceinline__ void p2_prep(Frame& F, const Args& A, unsigned char* dout) {
    const bf16* pH = (const bf16*)(F.ws + WS_PROJH); const bf16* pL = (const bf16*)(F.ws + WS_PROJL);
    bf16* x0 = (bf16*)(dout + DO_X0); bf16* uT = (bf16*)(dout + DO_UT); bf16* Kb = (bf16*)(F.ws + WS_K);
    {
        const int cp = F.tid & 255, th = F.tid >> 8, c = 2 * cp; const float* cw = A.in[I_HCW]; const float* cb = A.in[I_HCB];
        float w0[3][2], w1[3][2], w2[3][2], bb[3][2];
#pragma unroll
        for (int p = 0; p < 3; ++p)
#pragma unroll
            for (int e = 0; e < 2; ++e) { const int col = p * 512 + c + e; w0[p][e] = cw[col]; w1[p][e] = cw[1536 + col]; w2[p][e] = cw[3072 + col]; bb[p][e] = cb[col]; }
        for (int tb = blockIdx.x; tb < L / 64; tb += F.G) {
            const int t0 = tb * 64 + th * 32; unsigned pv[3], cu[3];
#pragma unroll
            for (int p = 0; p < 3; ++p) { pv[p] = t0 > 0 ? *(const unsigned*)(pH + (size_t)(t0 - 1) * 1536 + p * 512 + c) : 0u; cu[p] = *(const unsigned*)(pH + (size_t)t0 * 1536 + p * 512 + c); }
#pragma unroll 1
            for (int g8 = 0; g8 < 4; ++g8) { unsigned nx[8][3]; float ua[8], ub[8];
#pragma unroll
                for (int i = 0; i < 8; ++i) { const int t = t0 + g8 * 8 + i;
#pragma unroll
                    for (int p = 0; p < 3; ++p) nx[i][p] = (t + 1 < L) ? *(const unsigned*)(pH + (size_t)(t + 1) * 1536 + p * 512 + c) : 0u; }
#pragma unroll
                for (int i = 0; i < 8; ++i) { const int t = t0 + g8 * 8 + i; float ha[3], hb[3];
#pragma unroll
                    for (int p = 0; p < 3; ++p) { ha[p] = w0[p][0] * bflo(pv[p]) + w1[p][0] * bflo(cu[p]) + w2[p][0] * bflo(nx[i][p]) + bb[p][0]; hb[p] = w0[p][1] * bfhi(pv[p]) + w1[p][1] * bfhi(cu[p]) + w2[p][1] * bfhi(nx[i][p]) + bb[p][1];
                        pv[p] = cu[p]; cu[p] = nx[i][p]; }
                    *(unsigned*)(x0 + (size_t)t * 512 + c) = pk2(ha[0], hb[0]); ua[i] = ha[2] * ha[1]; ub[i] = hb[2] * hb[1]; }
                *(v4u*)(uT + (size_t)c * L + t0 + g8 * 8) = (v4u){pk2(ua[0], ua[1]), pk2(ua[2], ua[3]), pk2(ua[4], ua[5]), pk2(ua[6], ua[7])};
                *(v4u*)(uT + (size_t)(c + 1) * L + t0 + g8 * 8) = (v4u){pk2(ub[0], ub[1]), pk2(ub[2], ub[3]), pk2(ub[4], ub[5]), pk2(ub[6], ub[7])}; }
        }
    }
    {
        float* rsq = (float*)(F.ws + WS_RSQ); float* rskv = (float*)(F.ws + WS_RSKV); const float* ct = (const float*)(F.ws + WS_ROPE); const float* st = ct + L * 16;
        constexpr int RB = 4; const int l2 = F.lane < 2 ? F.lane : 1;
        for (int m0 = F.gw; m0 < M; m0 += F.NGW * RB) {
            v4u a[RB], b[RB], xa[RB], xb[RB]; f32x4 c0[RB], c1[RB], n0[RB], n1[RB];
#pragma unroll
            for (int q = 0; q < RB; ++q) { const int m = (m0 + q * F.NGW < M) ? m0 + q * F.NGW : m0; const bf16* r = pL + (size_t)m * PL;
                a[q] = *(const v4u*)(r + 8 * F.lane); b[q] = *(const v4u*)(r + 512 + 8 * (F.lane & 15));
                xa[q] = *(const v4u*)(r + 640 + 8 * l2); xb[q] = *(const v4u*)(r + 656 + 8 * l2);
                c0[q] = *(const f32x4*)(ct + m * 16 + 8 * l2); c1[q] = *(const f32x4*)(ct + m * 16 + 8 * l2 + 4); n0[q] = *(const f32x4*)(st + m * 16 + 8 * l2); n1[q] = *(const f32x4*)(st + m * 16 + 8 * l2 + 4); }
            float s1[RB], s2[RB];
#pragma unroll
            for (int q = 0; q < RB; ++q) { float sa = 0.f, sb = 0.f;
                { const unsigned w[4] = {a[q].x, a[q].y, a[q].z, a[q].w};
#pragma unroll
                  for (int i = 0; i < 4; ++i) { const float lo = bflo(w[i]), hi = bfhi(w[i]); sa += lo * lo + hi * hi; } }
                { const unsigned w[4] = {b[q].x, b[q].y, b[q].z, b[q].w};
#pragma unroll
                  for (int i = 0; i < 4; ++i) { const float lo = bflo(w[i]), hi = bfhi(w[i]); sb += lo * lo + hi * hi; } }
                if (F.lane >= 16) sb = 0.f;
                s1[q] = F.lane < 48 ? sa : 0.f; s2[q] = (F.lane < 48 ? 0.f : sa) + sb; }
#pragma unroll
            for (int q = 0; q < RB; ++q) { s1[q] = wave_sum(s1[q]); s2[q] = wave_sum(s2[q]); }
#pragma unroll
            for (int q = 0; q < RB; ++q) { const int m = m0 + q * F.NGW; if (m < M) {
                if (F.lane == 0) { rsq[m] = 1.0f / sqrtf(s1[q] * (1.f / QL) + EPS); rskv[m] = 1.0f / sqrtf(s2[q] * (1.f / KVL) + EPS); }
                if (F.lane < 2) {
                    const float cs[8] = {c0[q].x, c0[q].y, c0[q].z, c0[q].w, c1[q].x, c1[q].y, c1[q].z, c1[q].w}, sn[8] = {n0[q].x, n0[q].y, n0[q].z, n0[q].w, n1[q].x, n1[q].y, n1[q].z, n1[q].w};
                    const unsigned wa[4] = {xa[q].x, xa[q].y, xa[q].z, xa[q].w}, wb[4] = {xb[q].x, xb[q].y, xb[q].z, xb[q].w}; unsigned o1[4], o2[4];
#pragma unroll
                    for (int i = 0; i < 4; ++i) { const float a0 = bflo(wa[i]), a1 = bfhi(wa[i]), b0 = bflo(wb[i]), b1 = bfhi(wb[i]);
                        o1[i] = pk2(a0 * cs[2 * i] - b0 * sn[2 * i], a1 * cs[2 * i + 1] - b1 * sn[2 * i + 1]); o2[i] = pk2(a0 * sn[2 * i] + b0 * cs[2 * i], a1 * sn[2 * i + 1] + b1 * cs[2 * i + 1]); }
#pragma unroll
                    for (int h = 0; h < NH; ++h) { *(v4u*)(Kb + (size_t)m * 768 + h * 96 + 64 + 8 * F.lane) = (v4u){o1[0], o1[1], o1[2], o1[3]}; *(v4u*)(Kb + (size_t)m * 768 + h * 96 + 80 + 8 * F.lane) = (v4u){o2[0], o2[1], o2[2], o2[3]}; } } } }
        }
    }
}

__device__ __forceinline__ void p5_post(Frame& F, unsigned char* dout) {
    const bf16* x0 = (const bf16*)(dout + DO_X0); const bf16* zT = (const bf16*)(F.ws + WS_ZT); bf16* yc = (bf16*)(F.ws + WS_YCAT);
    const int cp = F.tid & 255, th = F.tid >> 8, c = 2 * cp;
    for (int tb = blockIdx.x; tb < L / 64; tb += F.G) {
        const int t0 = tb * 64 + th * 32; const v4u* za = (const v4u*)(zT + (size_t)c * L + t0); const v4u* zb = (const v4u*)(zT + (size_t)(c + 1) * L + t0);
        v4u qa[4], qb[4]; unsigned xv[32];
#pragma unroll
        for (int g = 0; g < 4; ++g) { qa[g] = za[g]; qb[g] = zb[g]; }
#pragma unroll
        for (int i = 0; i < 32; ++i) xv[i] = *(const unsigned*)(x0 + (size_t)(t0 + i) * 512 + c);
#pragma unroll
        for (int g = 0; g < 4; ++g) { const unsigned wa[4] = {qa[g].x, qa[g].y, qa[g].z, qa[g].w}, wb[4] = {qb[g].x, qb[g].y, qb[g].z, qb[g].w};
#pragma unroll
            for (int i = 0; i < 8; ++i) { const int k = g * 8 + i; const float zva = (i & 1) ? bfhi(wa[i >> 1]) : bflo(wa[i >> 1]), zvb = (i & 1) ? bfhi(wb[i >> 1]) : bflo(wb[i >> 1]);
                *(unsigned*)(yc + (size_t)(t0 + k) * D + c) = pk2(bflo(xv[k]) * zva, bfhi(xv[k]) * zvb); } }
    }
}

__device__ __forceinline__ void p8_route(Frame& F, const Args& A, const bf16* x1) {
    const float* mod = (const float*)(F.ws + WS_MOD); bf16* h2 = (bf16*)(F.ws + WS_H2); const float* wrt = (const float*)(F.ws + WS_WRT);
    int* toke = (int*)(F.ws + WS_TOKE); float* tokw = (float*)(F.ws + WS_TOKW); int* tokr = (int*)(F.ws + WS_TOKR); int* bcnt = (int*)(F.ws + WS_BCNT);
    LAS int* le = (LAS int*)(F.lds + 70000);
    LAS int* lr = le + 128;
    f32x4 gm[4], sh[4];
#pragma unroll
    for (int j = 0; j < 4; ++j) { const int c0 = 4 * F.lane + 256 * j; const f32x4 g = *(const f32x4*)(A.in[I_NFG] + c0), sc = *(const f32x4*)(mod + 4096 + c0); gm[j] = g * (sc + 1.0f); sh[j] = *(const f32x4*)(mod + 3072 + c0); }
    for (int rb = blockIdx.x; rb < M / 64; rb += F.G) {
        constexpr int RQ = 2;
        for (int rr0 = F.wave; rr0 < 64; rr0 += 8 * RQ) {
            f32x4 v[RQ][4]; float s[RQ]; int mrow[RQ];
#pragma unroll
            for (int q = 0; q < RQ; ++q) { const int rr = rr0 + 8 * q; const int m = rb * 64 + rr; mrow[q] = m; const v2u* xr = (const v2u*)(x1 + (size_t)m * D) + F.lane; s[q] = 0.f;
#pragma unroll
                for (int j = 0; j < 4; ++j) { const v2u xw = xr[64 * j]; v[q][j] = (f32x4){bflo(xw.x), bfhi(xw.x), bflo(xw.y), bfhi(xw.y)}; } }
#pragma unroll
            for (int q = 0; q < RQ; ++q)
#pragma unroll
                for (int j = 0; j < 4; ++j) s[q] += (v[q][j].x * v[q][j].x + v[q][j].y * v[q][j].y) + (v[q][j].z * v[q][j].z + v[q][j].w * v[q][j].w);
#pragma unroll
            for (int q = 0; q < RQ; ++q) s[q] = wave_sum(s[q]);
#pragma unroll
            for (int q = 0; q < RQ; ++q) { const float rstd = 1.0f / sqrtf(s[q] * (1.f / D) + EPS); v2u* o = (v2u*)(h2 + (size_t)mrow[q] * D) + F.lane;
#pragma unroll
                for (int j = 0; j < 4; ++j) { v[q][j] = v[q][j] * rstd * gm[j] + sh[j]; o[64 * j] = (v2u){pk2(v[q][j].x, v[q][j].y), pk2(v[q][j].z, v[q][j].w)}; } }
            float gl[RQ][4];
#pragma unroll
            for (int g = 0; g < 4; ++g) { const f32x4* wr = (const f32x4*)(wrt + g * 1024) + F.lane; float p[RQ];
#pragma unroll
                for (int q = 0; q < RQ; ++q) p[q] = 0.f;
#pragma unroll
                for (int j = 0; j < 4; ++j) { const f32x4 w = wr[64 * j];
#pragma unroll
                    for (int q = 0; q < RQ; ++q) p[q] += (v[q][j].x * w.x + v[q][j].y * w.y) + (v[q][j].z * w.z + v[q][j].w * w.w); }
#pragma unroll
                for (int q = 0; q < RQ; ++q) gl[q][g] = p[q]; }
#pragma unroll
            for (int g = 0; g < 4; ++g)
#pragma unroll
                for (int q = 0; q < RQ; ++q) gl[q][g] = wave_sum(gl[q][g]) + A.in[I_BGRP][g];
            int gi[RQ]; float gmx[RQ];
#pragma unroll
            for (int q = 0; q < RQ; ++q) { int gq = 0; float mx = -INFINITY;
#pragma unroll
                for (int g = 0; g < 4; ++g) if (gl[q][g] > mx) { mx = gl[q][g]; gq = g; }
                gi[q] = __builtin_amdgcn_readfirstlane(gq); gmx[q] = mx; }
            float ev[RQ][8];
#pragma unroll
            for (int q = 0; q < RQ; ++q)
#pragma unroll
                for (int e = 0; e < 8; ++e) { const f32x4* wr = (const f32x4*)(wrt + (4 + gi[q] * 8 + e) * 1024) + F.lane; float p = 0.f;
#pragma unroll
                    for (int j = 0; j < 4; ++j) { const f32x4 w = wr[64 * j]; p += (v[q][j].x * w.x + v[q][j].y * w.y) + (v[q][j].z * w.z + v[q][j].w * w.w); }
                    ev[q][e] = p; }
#pragma unroll
            for (int e = 0; e < 8; ++e)
#pragma unroll
                for (int q = 0; q < RQ; ++q) ev[q][e] = wave_sum(ev[q][e]) + A.in[I_BRT][gi[q] * 8 + e];
            if (F.lane == 0) {
#pragma unroll
              for (int q = 0; q < RQ; ++q) { const int m = mrow[q], rr = rr0 + 8 * q;
                float gs = 0.f;
#pragma unroll
                for (int g = 0; g < 4; ++g) gs += __expf(gl[q][g] - gmx[q]);
                const float psel = 1.0f / gs;
                int i0 = 0; float v0 = ev[q][0];
#pragma unroll
                for (int e = 1; e < 8; ++e) if (ev[q][e] > v0) { v0 = ev[q][e]; i0 = e; }
                int i1 = -1; float v1 = -INFINITY;
#pragma unroll
                for (int e = 0; e < 8; ++e) if (e != i0 && ev[q][e] > v1) { v1 = ev[q][e]; i1 = e; }
                const float e1 = __expf(v1 - v0), w0 = psel / (1.f + e1), w1 = psel * e1 / (1.f + e1);
                toke[m * 2] = gi[q] * 8 + i0; toke[m * 2 + 1] = gi[q] * 8 + i1; tokw[m * 2] = w0; tokw[m * 2 + 1] = w1;
                le[rr * 2] = gi[q] * 8 + i0; le[rr * 2 + 1] = gi[q] * 8 + i1; }
            }
        }
        __syncthreads();
        if (F.tid < 160) { const bool rk = F.tid < 128; const int me = rk ? le[F.tid] : F.tid - 128, lim = rk ? F.tid : 128; int r = 0;
#pragma unroll 8
            for (int j4 = 0; j4 < 32; ++j4) { const v4u o = *(const LAS v4u*)(le + 4 * j4);
                r += (4 * j4 < lim && (int)o.x == me) + (4 * j4 + 1 < lim && (int)o.y == me) + (4 * j4 + 2 < lim && (int)o.z == me) + (4 * j4 + 3 < lim && (int)o.w == me); }
            if (rk) lr[F.tid] = r; else __hip_atomic_store(bcnt + rb * 32 + (F.tid - 128), r, __ATOMIC_RELAXED, __HIP_MEMORY_SCOPE_AGENT); }
        if (F.tid >= 128 && F.tid < 192) { asm volatile("s_waitcnt vmcnt(0)" ::: "memory");
            if (F.tid == 128) __hip_atomic_fetch_add((unsigned*)(F.ws + WS_CTL + WS_BCCNT), 1u, __ATOMIC_RELAXED, __HIP_MEMORY_SCOPE_AGENT); }
        __syncthreads();
        if (F.tid < 128) tokr[rb * 128 + F.tid] = lr[F.tid];
        __syncthreads();
    }
    LAS float* scr = (LAS float*)(F.lds + F.wave * 8704);
    bf16* WE = (bf16*)(F.ws + WS_WE);
    constexpr int I1 = 16 * 16, I2 = 32 * 4, IPE = I1 + I2;
#ifdef WCONV_REPS
    _Pragma("nounroll") for (int rep_ = 0; rep_ < WCONV_REPS; ++rep_)
#endif
    for (int it = F.gw; it < NEXP * IPE; it += F.NGW) {
        const int e = it / IPE; int r = it % IPE; bf16* w1t = WE + (size_t)e * (512 * 1024 + 1024 * 256); bf16* w2t = w1t + 512 * 1024;
        const float* sa; const float* sb; int ldw; bf16* dst; int ldk;
        if (r < I1) { const int g = r % 16, kb = r / 16, k0 = kb * 64; sa = A.in[I_WGATE] + ((size_t)e * D + k0) * DEXP + 16 * g; sb = A.in[I_WUP] + ((size_t)e * D + k0) * DEXP + 16 * g; ldw = DEXP;
            dst = w1t + (size_t)(32 * g) * D + k0; ldk = D; }
        else { r -= I1; const int nb = r % 32, kb = r / 32, n0 = nb * 32, k0 = kb * 64; sa = A.in[I_WDOWN] + ((size_t)e * DEXP + k0) * D + n0; sb = sa + 16; ldw = D; dst = w2t + (size_t)n0 * DEXP + k0; ldk = DEXP; }
        transpose_item(sa, sb, ldw, nullptr, dst, ldk, false, scr, F.lane);
    }
}

__device__ __forceinline__ void moe_offsets(Frame& F, LAS int* lo, int blk) {
    const int* bcnt = (const int*)(F.ws + WS_BCNT);
    if (F.tid < 256) { const int e = F.tid & 31, ch = F.tid >> 5; int tot = 0, base = 0;
#pragma unroll 8
        for (int i = 0; i < 32; ++i) { const int b = ch * 32 + i; const int c = bcnt[b * 32 + e]; tot += c; base += (b < blk) ? c : 0; }
        tot += __shfl_xor(tot, 32); base += __shfl_xor(base, 32);
        if ((F.tid & 32) == 0) { lo[128 + (F.tid >> 6) * 32 + e] = tot; lo[(F.tid >> 6) * 32 + e] = base; } }
    __syncthreads();
    { int tot = 0, base = 0;
      if (F.tid < 32) { for (int w = 0; w < 4; ++w) { tot += lo[128 + w * 32 + F.tid]; base += lo[w * 32 + F.tid]; } }
      __syncthreads();
      if (F.tid < 32) { lo[80 + F.tid] = tot; lo[40 + F.tid] = base; } }
    __syncthreads();
    if (F.tid < 64) { const int e = F.tid & 31; const int val = (lo[80 + e] + 255) & ~255; int sc = val;
#pragma unroll
        for (int o = 1; o < 32; o <<= 1) { const int t = __shfl_up(sc, o); if (e >= o) sc += t; }
        if (F.tid < 32) { lo[e] = sc - val; if (e == 31) lo[32] = sc; } }
    __syncthreads();
}
__device__ __forceinline__ void p8b_slots(Frame& F) {
    LAS int* lo = (LAS int*)(F.lds + 70000);
    const int* toke = (const int*)(F.ws + WS_TOKE); const float* tokw = (const float*)(F.ws + WS_TOKW); const int* tokr = (const int*)(F.ws + WS_TOKR);
    int* toks = (int*)(F.ws + WS_TOKS); int* stok = (int*)(F.ws + WS_STOK); float* sw = (float*)(F.ws + WS_SW);
    if (F.tid == 0) { unsigned* p = (unsigned*)(F.ws + WS_CTL + WS_BCCNT); unsigned sp = 0; while (__hip_atomic_load(p, __ATOMIC_RELAXED, __HIP_MEMORY_SCOPE_AGENT) < (unsigned)(M / 64)) { __builtin_amdgcn_s_sleep(2); if (++sp > (1u << 22)) break; } }
    __syncthreads();
    for (int rb = blockIdx.x; rb < 256; rb += F.G) {
        moe_offsets(F, lo, rb);
        if (F.tid < 128) { const int i = rb * 128 + F.tid, e = toke[i], slot = lo[e] + lo[40 + e] + tokr[i]; toks[i] = slot; stok[slot] = i >> 1; sw[slot] = tokw[i]; }
        if (rb < 32) { const int e = rb, beg = lo[e] + lo[80 + e], end = lo[e + 1]; for (int s = beg + F.tid; s < end; s += 512) { stok[s] = 0; sw[s] = 0.f; } }
        __syncthreads();
    }
}

__device__ __forceinline__ void p11_final(Frame& F, const Args& A, float* xo) {
#ifdef HFFT_TEST
    const float tnum_ = *(const float*)(F.ws + WS_CTL + 60000), tden_ = *(const float*)(F.ws + WS_CTL + 60004); const bool tbad_ = !(tnum_ <= HFFT_TOL * tden_);
#endif
    const float* mod = (const float*)(F.ws + WS_MOD); const bf16* y = (const bf16*)(F.ws + WS_Y); const int* toks = (const int*)(F.ws + WS_TOKS);
    f32x4 g2[4], fg[4];
#pragma unroll
    for (int j = 0; j < 4; ++j) { const int c0 = 4 * F.lane + 256 * j; g2[j] = *(const f32x4*)(mod + 5120 + c0); fg[j] = *(const f32x4*)(A.in[I_FNG] + c0); }
    for (int m = F.gw; m < M; m += F.NGW) {
        f32x4* xr = (f32x4*)(xo + (size_t)m * D) + F.lane; const v2u* x1r = (const v2u*)((const bf16*)(F.ws + WS_X1B) + (size_t)m * D) + F.lane; const int s0 = toks[m * 2], s1 = toks[m * 2 + 1];
        const v2u* y0 = (const v2u*)(y + (size_t)s0 * D) + F.lane; const v2u* y1 = (const v2u*)(y + (size_t)s1 * D) + F.lane; f32x4 v[4]; float s = 0.f;
#pragma unroll
        for (int j = 0; j < 4; ++j) { const v2u a = y0[64 * j], b = y1[64 * j]; const f32x4 ys = (f32x4){bflo(a.x) + bflo(b.x), bfhi(a.x) + bfhi(b.x), bflo(a.y) + bflo(b.y), bfhi(a.y) + bfhi(b.y)};
            const v2u xw = x1r[64 * j]; v[j] = (f32x4){bflo(xw.x), bfhi(xw.x), bflo(xw.y), bfhi(xw.y)} + g2[j] * ys; s += (v[j].x * v[j].x + v[j].y * v[j].y) + (v[j].z * v[j].z + v[j].w * v[j].w); }
        const float rstd = 1.0f / sqrtf(wave_sum(s) * (1.f / D) + EPS);
#pragma unroll
        for (int j = 0; j < 4; ++j) { f32x4 ov = v[j] * rstd * fg[j];
#ifdef HFFT_TEST
            if (tbad_) ov = (f32x4){__builtin_nanf(""), 0.f, 0.f, 0.f};
#endif
            xr[64 * j] = ov; }
    }
}


namespace pg8 {
typedef short bf16x8 __attribute__((ext_vector_type(8)));
constexpr int BM = 256, BK = 64, HALF = 128, HTB = HALF * BK * 2, STAGE_BYTES = 8 * HTB, NXCD = 8, WGM = 8;
__host__ __device__ __forceinline__ int lds_byte(int r, int c) { const int st = (r >> 4) * 2 + (c >> 5), rr = r & 15, cc = c & 31, ob = rr * 64 + cc * 2; return st * 1024 + (ob ^ (((ob >> 9) & 1) << 5)); }
__host__ __device__ __forceinline__ void stage_rc(int b, int& R, int& C) { const int st = b / 1024, sb = b % 1024, swz = sb ^ (((sb >> 9) & 1) << 5); R = (st >> 1) * 16 + swz / 64; C = (st & 1) * 32 + (swz % 64) / 2; }
__host__ __device__ __forceinline__ int perm32(int rho) { const int n = rho >> 4, i = rho & 15; return 8 * (i >> 2) + 4 * n + (i & 3); }
struct Unit { int pm, pn, e; };
__device__ __forceinline__ unsigned cvt_pk_bf16(float lo, float hi) { unsigned r; asm volatile("v_cvt_pk_bf16_f32 %0, %1, %2" : "=v"(r) : "v"(lo), "v"(hi)); return r; }

struct DenseOrder {
    const bf16* A; const bf16* Bt; int lda, ldb; int nM, nN, nwg, G, c;
    __device__ void init(const bf16* A_, int lda_, const bf16* Bt_, int ldb_, int Mrows, int N, int G_, int c_) { A = A_; Bt = Bt_; lda = lda_; ldb = ldb_; nM = Mrows / BM; nN = N / BM; nwg = nM * nN; G = G_; c = c_; }
    __device__ bool next(int i, Unit& u) const {
        const long Lx = (long)i * G + c; if (Lx >= nwg) return false;
        int wgid = (int)Lx; { const int q = nwg / NXCD, r = nwg % NXCD, xcd = wgid % NXCD, off = wgid / NXCD; wgid = (xcd < r ? xcd * (q + 1) : r * (q + 1) + (xcd - r) * q) + off; }
        const int nig = WGM * nN, gid = wgid / nig, fm = gid * WGM, gsz = (nM - fm) < WGM ? (nM - fm) : WGM;
        u.pm = fm + ((wgid % nig) % gsz); u.pn = (wgid % nig) / gsz; u.e = 0; return true;
    }
    __device__ __forceinline__ const char* a_ptr(const Unit& u) const { return (const char*)(A + (size_t)u.pm * BM * lda); }
    __device__ __forceinline__ const char* b_ptr(const Unit& u) const { return (const char*)(Bt + (size_t)u.pn * BM * ldb); }
    __device__ __forceinline__ void a_rows(const Unit&, const int (&R)[2], unsigned (&ro)[2][2]) const {}
};
struct MoeOrder {
    const bf16* A; const bf16* WE; const int* stok; const LAS int* lo; int lda, ldb, nN, G, c; size_t boff;
    __device__ bool next(int i, Unit& u) const {
        const int T = lo[32] >> 8; const long Lx = (long)i * G + c; if (Lx >= (long)T * nN) return false;
        u.pm = (int)(Lx / nN); u.pn = (int)(Lx % nN); { const int l31 = (int)(threadIdx.x & 31); const unsigned long long bm = __ballot(lo[l31 + 1] <= u.pm * 256); u.e = __popc((unsigned)bm); }     return true;
    }
    __device__ __forceinline__ const char* a_ptr(const Unit& u) const { return stok ? (const char*)A : (const char*)(A + (size_t)u.pm * BM * lda); }
    __device__ __forceinline__ const char* b_ptr(const Unit& u) const { return (const char*)(WE + (size_t)u.e * (512 * 1024 + 1024 * 256) + boff + (size_t)u.pn * BM * ldb); }
    __device__ __forceinline__ void a_rows(const Unit& u, const int (&R)[2], unsigned (&ro)[2][2]) const {
#pragma unroll
        for (int h = 0; h < 2; ++h)
#pragma unroll
            for (int i = 0; i < 2; ++i) ro[h][i] = (unsigned)stok[u.pm * 256 + h * 128 + R[i]] * (unsigned)(lda * 2);
    }
};

template <class Epi, class Sched, bool GATHER, bool MID = false>
__device__ __forceinline__ void gemm_phase(LAS unsigned char* lds, const int K, const Sched& S, const Epi& E) {
    const int tid = threadIdx.x, wid = __builtin_amdgcn_readfirstlane(tid >> 6), lane = tid & 63, wr = wid >> 2, wc = wid & 3, fr = lane & 15, fq = lane >> 4;
    const int nt = K / BK; const int lda = S.lda, ldb = S.ldb;
    unsigned voffA[2], voffB[2]; int RA[2];
#pragma unroll
    for (int i = 0; i < 2; ++i) { int R, C; stage_rc(tid * 16 + i * 8192, R, C); const int Rb = Epi::PERM ? ((R & ~31) + perm32(R & 31)) : R; RA[i] = R;
        voffA[i] = GATHER ? (unsigned)(C * 2) : (unsigned)(R * lda + C) * 2u; voffB[i] = (unsigned)(Rb * ldb + C) * 2u; }
    const size_t kstep = (size_t)(BK * 2);
    const size_t hstepA = GATHER ? 0 : (size_t)HALF * lda * 2, hstepB = (size_t)HALF * ldb * 2;
    const unsigned ldsw = (unsigned)wid * 1024u;
    const int aoff = lds_byte(wr * 64 + fr, fq * 8), boff = lds_byte(wc * 32 + fr, fq * 8);
    unsigned roC[2][2] = {{0u, 0u}, {0u, 0u}}, roN[2][2] = {{0u, 0u}, {0u, 0u}};
#define PG8_SA(b, h) (((b) * 2 + (h)) * HTB)
#define PG8_SB(b, h) ((4 + (b) * 2 + (h)) * HTB)
#define PG8_STAGEB(bufoff, gbase) do { _Pragma("unroll") for (int _i = 0; _i < 2; ++_i) \
        __builtin_amdgcn_global_load_lds((const unsigned*)((const char*)(gbase) + voffB[_i]), (LAS unsigned*)(lds + (bufoff) + ldsw + _i * 8192), 16, 0, 0); } while (0)
#define PG8_STAGEA(bufoff, gbase, h, ro) do { _Pragma("unroll") for (int _i = 0; _i < 2; ++_i) \
        __builtin_amdgcn_global_load_lds((const unsigned*)((const char*)(gbase) + (h) * hstepA + voffA[_i] + (GATHER ? (ro)[h][_i] : 0u)), (LAS unsigned*)(lds + (bufoff) + ldsw + _i * 8192), 16, 0, 0); } while (0)
#define PG8_LDA(dst, b, h) do { _Pragma("unroll") for (int m = 0; m < 4; ++m) _Pragma("unroll") for (int k = 0; k < 2; ++k) dst[m][k] = *(const LAS bf16x8*)(lds + PG8_SA(b, h) + aoff + m * 2048 + k * 1024); } while (0)
#define PG8_LDB(dst, b, h) do { _Pragma("unroll") for (int n = 0; n < 2; ++n) _Pragma("unroll") for (int k = 0; k < 2; ++k) dst[n][k] = *(const LAS bf16x8*)(lds + PG8_SB(b, h) + boff + n * 2048 + k * 1024); } while (0)
#define PG8_MMA(ai, bj, At, Bt) do { __builtin_amdgcn_s_setprio(1); _Pragma("unroll") for (int m = 0; m < 4; ++m) _Pragma("unroll") for (int n = 0; n < 2; ++n) _Pragma("unroll") for (int k = 0; k < 2; ++k) \
        acc[ai][bj][m][n] = __builtin_amdgcn_mfma_f32_16x16x32_bf16(Bt[n][k], At[m][k], acc[ai][bj][m][n], 0, 0, 0); __builtin_amdgcn_s_setprio(0); } while (0)
#define PG8_WAIT_V(n) asm volatile("s_waitcnt vmcnt(" #n ")" ::: "memory")
#define PG8_WAIT_L(n) asm volatile("s_waitcnt lgkmcnt(" #n ")" ::: "memory")
#define PG8_BAR __builtin_amdgcn_s_barrier()
#define PG8_SCHED __builtin_amdgcn_sched_barrier(0)
    Unit cur, nxt; int ui = 0;
    if (!S.next(0, cur)) return;
    f32x4 acc[2][2][4][2];
#pragma unroll
    for (int a = 0; a < 2; ++a)
#pragma unroll
        for (int b = 0; b < 2; ++b)
#pragma unroll
            for (int m = 0; m < 4; ++m)
#pragma unroll
                for (int n = 0; n < 2; ++n) acc[a][b][m][n] = (f32x4){0.f, 0.f, 0.f, 0.f};
    bf16x8 At[4][2], B0[2][2], B1[2][2];
    const char* cA = S.a_ptr(cur); const char* cB = S.b_ptr(cur);
    if (GATHER) S.a_rows(cur, RA, roC);
    PG8_STAGEB(PG8_SB(0, 0), cB); PG8_STAGEB(PG8_SB(0, 1), cB + hstepB); PG8_STAGEA(PG8_SA(0, 0), cA, 0, roC); PG8_STAGEA(PG8_SA(0, 1), cA, 1, roC);
    if (wr == 1) PG8_BAR;
    PG8_WAIT_V(2); PG8_BAR;
    PG8_STAGEB(PG8_SB(1, 0), cB + kstep); PG8_STAGEA(PG8_SA(1, 0), cA + kstep, 0, roC); PG8_STAGEB(PG8_SB(1, 1), cB + hstepB + kstep);
    PG8_WAIT_V(6); PG8_BAR;
    for (;;) {
        const bool has_next = S.next(ui + 1, nxt);
        const char* nA = has_next ? S.a_ptr(nxt) : cA; const char* nB = has_next ? S.b_ptr(nxt) : cB;
        if (GATHER) { if (has_next) S.a_rows(nxt, RA, roN); else {
#pragma unroll
            for (int h = 0; h < 2; ++h)
#pragma unroll
                for (int i = 0; i < 2; ++i) roN[h][i] = roC[h][i]; } }
#pragma nounroll
        for (int t = 0; t < nt; t += 2) {
            if constexpr (MID) { if (t == (nt >> 1)) E.mid(acc, cur, wr, wc, fr, fq); }
            const bool last = (t == nt - 2);
            const char* a1 = cA + (size_t)(t + 1) * kstep;
            const char* a2 = last ? nA : cA + (size_t)(t + 2) * kstep; const char* b2 = last ? nB : cB + (size_t)(t + 2) * kstep;
            const char* a3 = a2 + kstep; const char* b3 = b2 + kstep;
            unsigned ro2[2][2];
#pragma unroll
            for (int h = 0; h < 2; ++h)
#pragma unroll
                for (int i = 0; i < 2; ++i) ro2[h][i] = GATHER ? (last ? roN[h][i] : roC[h][i]) : 0u;
            PG8_LDB(B0, 0, 0); PG8_LDB(B1, 0, 1); PG8_SCHED; PG8_LDA(At, 0, 0); PG8_STAGEA(PG8_SA(1, 1), a1, 1, roC);
            PG8_WAIT_V(8); PG8_WAIT_L(0); PG8_BAR; PG8_MMA(0, 0, At, B0); PG8_MMA(0, 1, At, B1); PG8_BAR; PG8_SCHED;
            PG8_LDA(At, 0, 1); PG8_STAGEB(PG8_SB(0, 0), b2); PG8_STAGEB(PG8_SB(0, 1), b2 + hstepB); PG8_STAGEA(PG8_SA(0, 0), a2, 0, ro2);
            PG8_WAIT_V(8); PG8_WAIT_L(0); PG8_BAR; PG8_MMA(1, 0, At, B0); PG8_MMA(1, 1, At, B1); PG8_BAR; PG8_SCHED;
            PG8_LDB(B0, 1, 0); PG8_LDB(B1, 1, 1); PG8_SCHED; PG8_LDA(At, 1, 0); PG8_STAGEA(PG8_SA(0, 1), a2, 1, ro2);
            PG8_WAIT_V(8); PG8_WAIT_L(0); PG8_BAR; PG8_MMA(0, 0, At, B0); PG8_MMA(0, 1, At, B1); PG8_BAR; PG8_SCHED;
            PG8_LDA(At, 1, 1); PG8_STAGEB(PG8_SB(1, 0), b3); PG8_STAGEB(PG8_SB(1, 1), b3 + hstepB); PG8_STAGEA(PG8_SA(1, 0), a3, 0, ro2);
            PG8_WAIT_V(8); PG8_WAIT_L(0); PG8_BAR; PG8_MMA(1, 0, At, B0); PG8_MMA(1, 1, At, B1); PG8_BAR; PG8_SCHED;
        }
        if (wr == 0) PG8_BAR;
        E(acc, cur, wr, wc, fr, fq);
        if (!has_next) break;
#pragma unroll
        for (int a = 0; a < 2; ++a)
#pragma unroll
            for (int b = 0; b < 2; ++b)
#pragma unroll
                for (int m = 0; m < 4; ++m)
#pragma unroll
                    for (int n = 0; n < 2; ++n) acc[a][b][m][n] = (f32x4){0.f, 0.f, 0.f, 0.f};
        cur = nxt; cA = nA; cB = nB; ++ui;
        if (GATHER) {
#pragma unroll
            for (int h = 0; h < 2; ++h)
#pragma unroll
                for (int i = 0; i < 2; ++i) roC[h][i] = roN[h][i]; }
        if (wr == 1) PG8_BAR;
    }
    PG8_WAIT_V(0);
    PG8_BAR;
#undef PG8_SA
#undef PG8_SB
#undef PG8_STAGEA
#undef PG8_STAGEB
#undef PG8_LDA
#undef PG8_LDB
#undef PG8_MMA
#undef PG8_WAIT_V
#undef PG8_WAIT_L
#undef PG8_BAR
#undef PG8_SCHED
}

struct EpiIn {
    static constexpr bool PERM = true; unsigned char* ws;
    __device__ __forceinline__ void operator()(const f32x4 (&acc)[2][2][4][2], const Unit& u, int wr, int wc, int fr, int fq) const {
        bf16* base; int ldc, colt; const bool sg = u.pn >= 9;
        if (u.pn < 6) { base = (bf16*)(ws + WS_PROJH); ldc = 1536; colt = u.pn * 256; } else if (u.pn < 9) { base = (bf16*)(ws + WS_PROJL); ldc = PL; colt = (u.pn - 6) * 256; } else { base = (bf16*)(ws + WS_GATES); ldc = 2048; colt = (u.pn - 9) * 256; }
        const int row0 = u.pm * BM + wr * 64 + fr, col0 = colt + wc * 32 + 8 * fq;
#pragma unroll
        for (int ai = 0; ai < 2; ++ai)
#pragma unroll
            for (int m = 0; m < 4; ++m) { bf16* rowp = base + (size_t)(row0 + ai * HALF + m * 16) * ldc + col0;
#pragma unroll
                for (int bj = 0; bj < 2; ++bj) { f32x4 v0 = acc[ai][bj][m][0], v1 = acc[ai][bj][m][1];
                    if (sg) {
#pragma unroll
                        for (int e = 0; e < 4; ++e) { v0[e] = __builtin_fmaxf(sigmoidf_(v0[e]), 8.6736174e-19f); v1[e] = __builtin_fmaxf(sigmoidf_(v1[e]), 8.6736174e-19f); } }
                    v4u w; w.x = cvt_pk_bf16(v0[0], v0[1]); w.y = cvt_pk_bf16(v0[2], v0[3]); w.z = cvt_pk_bf16(v1[0], v1[1]); w.w = cvt_pk_bf16(v1[2], v1[3]);
                    *(v4u*)(rowp + bj * HALF) = w; } }
    }
};
struct EpiQ {
    static constexpr bool PERM = false; unsigned char* ws; bf16* q;
    __device__ __forceinline__ void operator()(const f32x4 (&acc)[2][2][4][2], const Unit& u, int wr, int wc, int fr, int fq) const {
        const float* rsq = (const float*)(ws + WS_RSQ); const float* ct = (const float*)(ws + WS_ROPE); const float* st = ct + L * 16;
        const int row0 = u.pm * BM + wr * 64 + fr;
#pragma unroll
        for (int ai = 0; ai < 2; ++ai)
#pragma unroll
            for (int m = 0; m < 4; ++m) { const int row = row0 + ai * HALF + m * 16; const float sc = C2 * rsq[row];
                const f32x4 cs = *(const f32x4*)(ct + row * 16 + 4 * fq), sn = *(const f32x4*)(st + row * 16 + 4 * fq);
#pragma unroll
                for (int bj = 0; bj < 2; ++bj) { const int cg = u.pn * 256 + bj * HALF + wc * 32; f32x4 v0 = acc[ai][bj][m][0], v1 = acc[ai][bj][m][1];
                    if (((cg >> 5) % 3) == 2) { const f32x4 a = v0, b = v1; v0 = a * cs - b * sn; v1 = a * sn + b * cs; }
                    v0 = v0 * sc; v1 = v1 * sc; bf16* p = q + (size_t)row * 768 + cg + 4 * fq;
                    *(v2u*)p = (v2u){cvt_pk_bf16(v0[0], v0[1]), cvt_pk_bf16(v0[2], v0[3])}; *(v2u*)(p + 16) = (v2u){cvt_pk_bf16(v1[0], v1[1]), cvt_pk_bf16(v1[2], v1[3])}; }
                asm volatile("" ::: "memory"); }
    }
};
struct EpiKV {
    static constexpr bool PERM = true; unsigned char* ws;
    __device__ __forceinline__ void operator()(const f32x4 (&acc)[2][2][4][2], const Unit& u, int wr, int wc, int fr, int fq) const {
        const float* rs = (const float*)(ws + WS_RSKV); const int row0 = u.pm * BM + wr * 64 + fr; const bool isk = u.pn < 2;
#pragma unroll
        for (int ai = 0; ai < 2; ++ai)
#pragma unroll
            for (int m = 0; m < 4; ++m) { const int row = row0 + ai * HALF + m * 16; const float sc = rs[row];
#pragma unroll
                for (int bj = 0; bj < 2; ++bj) { const int c = u.pn * 256 + bj * HALF + wc * 32 + 8 * fq; const f32x4 v0 = acc[ai][bj][m][0] * sc, v1 = acc[ai][bj][m][1] * sc;
                    bf16* p = isk ? (bf16*)(ws + WS_K) + (size_t)row * 768 + (c >> 6) * 96 + (c & 63) : (bf16*)(ws + WS_V) + (size_t)row * 512 + (c - 512);
                    *(v4u*)p = (v4u){cvt_pk_bf16(v0[0], v0[1]), cvt_pk_bf16(v0[2], v0[3]), cvt_pk_bf16(v1[0], v1[1]), cvt_pk_bf16(v1[2], v1[3])}; } }
    }
};
struct EpiM1 {
    static constexpr bool PERM = false; unsigned char* ws; float* tmp;
    __device__ __forceinline__ void operator()(const f32x4 (&acc)[2][2][4][2], const Unit& u, int wr, int wc, int fr, int fq) const {
        const bf16* g = (const bf16*)(ws + WS_GATES); const int row0 = u.pm * BM + wr * 64 + fr, col0 = u.pn * BM + wc * 32 + 4 * fq;
#pragma unroll
        for (int ai = 0; ai < 2; ++ai)
#pragma unroll
            for (int m = 0; m < 4; ++m) { const int row = row0 + ai * HALF + m * 16;
#pragma unroll
                for (int bj = 0; bj < 2; ++bj)
#pragma unroll
                    for (int n = 0; n < 2; ++n) { const int c = col0 + bj * HALF + n * 16; const v2u gw = *(const v2u*)(g + (size_t)row * 2048 + c);
                        const f32x4 gv = (f32x4){bflo(gw.x), bfhi(gw.x), bflo(gw.y), bfhi(gw.y)}; *(f32x4*)(tmp + (size_t)row * D + c) = acc[ai][bj][m][n] * gv; } }
    }
};
struct EpiM2 {
    static constexpr bool PERM = true; unsigned char* ws; const float* tmp;
    __device__ __forceinline__ void operator()(const f32x4 (&acc)[2][2][4][2], const Unit& u, int wr, int wc, int fr, int fq) const {
        const bf16* g = (const bf16*)(ws + WS_GATES) + 1024; bf16* mix = (bf16*)(ws + WS_MIX); const int row0 = u.pm * BM + wr * 64 + fr, col0 = u.pn * BM + wc * 32 + 8 * fq;
#pragma unroll
        for (int ai = 0; ai < 2; ++ai)
#pragma unroll
            for (int m = 0; m < 4; ++m) { const int row = row0 + ai * HALF + m * 16;
#pragma unroll
                for (int bj = 0; bj < 2; ++bj) { const int c = col0 + bj * HALF; const v4u gw = *(const v4u*)(g + (size_t)row * 2048 + c);
                    const f32x4 t0 = *(const f32x4*)(tmp + (size_t)row * D + c), t1 = *(const f32x4*)(tmp + (size_t)row * D + c + 4);
                    const f32x4 v0 = t0 + acc[ai][bj][m][0] * (f32x4){bflo(gw.x), bfhi(gw.x), bflo(gw.y), bfhi(gw.y)}, v1 = t1 + acc[ai][bj][m][1] * (f32x4){bflo(gw.z), bfhi(gw.z), bflo(gw.w), bfhi(gw.w)};
                    *(v4u*)(mix + (size_t)row * D + c) = (v4u){cvt_pk_bf16(v0[0], v0[1]), cvt_pk_bf16(v0[2], v0[3]), cvt_pk_bf16(v1[0], v1[1]), cvt_pk_bf16(v1[2], v1[3])}; } }
    }
};
struct EpiMix {
    static constexpr bool PERM = true; unsigned char* ws;
    __device__ __forceinline__ void mid(f32x4 (&acc)[2][2][4][2], const Unit& u, int wr, int wc, int fr, int fq) const {
        unsigned long long gb = (unsigned long long)((const bf16*)(ws + WS_GATES) + (size_t)(u.pm * BM + wr * 64 + fr) * 2048 + u.pn * BM + wc * 32 + 8 * fq);
        asm volatile("" : "+v"(gb));
        const bf16* g = (const bf16*)gb;
#pragma unroll
        for (int ai = 0; ai < 2; ++ai)
#pragma unroll
            for (int m = 0; m < 4; ++m)
#pragma unroll
                for (int bj = 0; bj < 2; ++bj)
#pragma unroll
                    for (int n = 0; n < 2; ++n) { const bf16* p = g + (size_t)(ai * HALF + m * 16) * 2048 + bj * HALF + 4 * n; const v2u a = *(const v2u*)p, b = *(const v2u*)(p + 1024);
                        const f32x4 r = (f32x4){bflo(a.x) * __builtin_amdgcn_rcpf(bflo(b.x)), bfhi(a.x) * __builtin_amdgcn_rcpf(bfhi(b.x)), bflo(a.y) * __builtin_amdgcn_rcpf(bflo(b.y)), bfhi(a.y) * __builtin_amdgcn_rcpf(bfhi(b.y))};
                        acc[ai][bj][m][n] = acc[ai][bj][m][n] * r; asm volatile("" ::: "memory"); }
    }
    __device__ __forceinline__ void operator()(const f32x4 (&acc)[2][2][4][2], const Unit& u, int wr, int wc, int fr, int fq) const {
        const bf16* g = (const bf16*)(ws + WS_GATES) + 1024; bf16* mix = (bf16*)(ws + WS_MIX); const int row0 = u.pm * BM + wr * 64 + fr, col0 = u.pn * BM + wc * 32 + 8 * fq;
#pragma unroll
        for (int ai = 0; ai < 2; ++ai)
#pragma unroll
            for (int m = 0; m < 4; ++m) { const int row = row0 + ai * HALF + m * 16;
#pragma unroll
                for (int bj = 0; bj < 2; ++bj) { const int c = col0 + bj * HALF; const v4u gw = *(const v4u*)(g + (size_t)row * 2048 + c);
                    const f32x4 v0 = acc[ai][bj][m][0] * (f32x4){bflo(gw.x), bfhi(gw.x), bflo(gw.y), bfhi(gw.y)}, v1 = acc[ai][bj][m][1] * (f32x4){bflo(gw.z), bfhi(gw.z), bflo(gw.w), bfhi(gw.w)};
                    *(v4u*)(mix + (size_t)row * D + c) = (v4u){cvt_pk_bf16(v0[0], v0[1]), cvt_pk_bf16(v0[2], v0[3]), cvt_pk_bf16(v1[0], v1[1]), cvt_pk_bf16(v1[2], v1[3])}; } }
    }
};
struct EpiX1 {
    static constexpr bool PERM = false; unsigned char* ws; const float* x; bf16* x1;
    __device__ __forceinline__ void operator()(const f32x4 (&acc)[2][2][4][2], const Unit& u, int wr, int wc, int fr, int fq) const {
        const float* gt = (const float*)(ws + WS_MOD) + 2048; const int row0 = u.pm * BM + wr * 64 + fr, col0 = u.pn * BM + wc * 32 + 4 * fq;
        f32x4 gv[2][2];
#pragma unroll
        for (int bj = 0; bj < 2; ++bj)
#pragma unroll
            for (int n = 0; n < 2; ++n) gv[bj][n] = *(const f32x4*)(gt + col0 + bj * HALF + n * 16);
#pragma unroll
        for (int ai = 0; ai < 2; ++ai)
#pragma unroll
            for (int m = 0; m < 4; ++m) { const size_t off = (size_t)(row0 + ai * HALF + m * 16) * D + col0;
#pragma unroll
                for (int bj = 0; bj < 2; ++bj)
#pragma unroll
                    for (int n = 0; n < 2; ++n) { const f32x4 r = *(const f32x4*)(x + off + bj * HALF + n * 16) + gv[bj][n] * acc[ai][bj][m][n];
                        *(v2u*)(x1 + off + bj * HALF + n * 16) = (v2u){cvt_pk_bf16(r[0], r[1]), cvt_pk_bf16(r[2], r[3])}; } }
    }
};
struct EpiAct {
    static constexpr bool PERM = false; unsigned char* ws;
    __device__ __forceinline__ void operator()(const f32x4 (&acc)[2][2][4][2], const Unit& u, int wr, int wc, int fr, int fq) const {
        bf16* act = (bf16*)(ws + WS_ACT); const int row0 = u.pm * BM + wr * 64 + fr;
#pragma unroll
        for (int ai = 0; ai < 2; ++ai)
#pragma unroll
            for (int m = 0; m < 4; ++m) { const int row = row0 + ai * HALF + m * 16;
#pragma unroll
                for (int bj = 0; bj < 2; ++bj) { const int j = (u.pn * 256 + bj * HALF + wc * 32) / 2 + 4 * fq; const f32x4 g = acc[ai][bj][m][0], up = acc[ai][bj][m][1]; f32x4 a;
#pragma unroll
                    for (int e = 0; e < 4; ++e) a[e] = siluf_(g[e]) * up[e];
                    *(v2u*)(act + (size_t)row * DEXP + j) = (v2u){cvt_pk_bf16(a[0], a[1]), cvt_pk_bf16(a[2], a[3])}; } }
    }
};
struct EpiY {
    static constexpr bool PERM = true; unsigned char* ws;
    __device__ __forceinline__ void operator()(const f32x4 (&acc)[2][2][4][2], const Unit& u, int wr, int wc, int fr, int fq) const {
        bf16* y = (bf16*)(ws + WS_Y); const float* sw = (const float*)(ws + WS_SW); const int row0 = u.pm * BM + wr * 64 + fr, col0 = u.pn * BM + wc * 32 + 8 * fq;
#pragma unroll
        for (int ai = 0; ai < 2; ++ai)
#pragma unroll
            for (int m = 0; m < 4; ++m) { const int row = row0 + ai * HALF + m * 16; const float s = sw[row];
#pragma unroll
                for (int bj = 0; bj < 2; ++bj) { const f32x4 v0 = acc[ai][bj][m][0] * s, v1 = acc[ai][bj][m][1] * s;
                    *(v4u*)(y + (size_t)row * D + col0 + bj * HALF) = (v4u){cvt_pk_bf16(v0[0], v0[1]), cvt_pk_bf16(v0[2], v0[3]), cvt_pk_bf16(v1[0], v1[1]), cvt_pk_bf16(v1[2], v1[3])}; } }
    }
};
}


namespace att {
typedef short bf16x8 __attribute__((ext_vector_type(8)));
typedef short s16x4 __attribute__((ext_vector_type(4)));
typedef float f32x16 __attribute__((ext_vector_type(16)));
typedef short v4i16_t __attribute__((ext_vector_type(4)));
typedef LAS const char* lds_cptr;
constexpr int KSL = 12288, VSL = 8192, LDS_K = 0, LDS_V = 2 * KSL, LDS_WS = LDS_V + 2 * VSL, LDS_OST = LDS_WS + 8 * 256, LDS_BYTES_ATT = LDS_OST + 8 * 4096;
constexpr int NT = L / 64;
__device__ __forceinline__ int crow(int r, int hi) { return (r & 3) + 8 * (r >> 2) + 4 * hi; }
__device__ __forceinline__ void glds16(const void* gsrc, unsigned lds_dst) { unsigned keep;
    asm volatile("s_mov_b32 %0, m0\n\ts_mov_b32 m0, %2\n\ts_nop 0\n\tglobal_load_lds_dwordx4 %1, off\n\ts_mov_b32 m0, %0" : "=&s"(keep) : "v"(gsrc), "s"(lds_dst) : "memory"); }
__device__ __forceinline__ unsigned cvtpk(float lo, float hi) { typedef float f2 __attribute__((ext_vector_type(2))); typedef __bf16 b2 __attribute__((ext_vector_type(2))); f2 v = {lo, hi}; b2 b = __builtin_convertvector(v, b2); return __builtin_bit_cast(unsigned, b); }
__device__ __forceinline__ s16x4 vtr(lds_cptr p) { return __builtin_bit_cast(s16x4, __builtin_amdgcn_ds_read_tr16_b64_v4i16((LAS v4i16_t*)p)); }
#define MX3(a, b, c) __builtin_fmaxf(__builtin_fmaxf((a), (b)), (c))
__device__ __forceinline__ float rowmax(const f32x16& p0, const f32x16& p1) {
    float a = MX3(p0[0], p0[1], p1[0]), b = MX3(p0[2], p0[3], p1[1]); a = MX3(a, p1[2], p1[3]);
#pragma unroll
    for (int r = 4; r < 16; r += 4) { a = MX3(a, p0[r], p0[r + 1]); b = MX3(b, p0[r + 2], p0[r + 3]); a = MX3(a, p1[r], p1[r + 1]); b = MX3(b, p1[r + 2], p1[r + 3]); }
    float m = __builtin_fmaxf(a, b); auto rr = __builtin_amdgcn_permlane32_swap(__float_as_uint(m), __float_as_uint(m), false, false);
    return __builtin_fmaxf(__uint_as_float(rr[0]), __uint_as_float(rr[1])); }
#undef MX3
#define WAIT_BAR0() asm volatile("s_waitcnt vmcnt(0) lgkmcnt(0)\n\ts_barrier" ::: "memory")

template <int THRL> __device__ __forceinline__ void attn_unit(int h, int qb, const bf16* Q, const bf16* __restrict__ K, const bf16* __restrict__ V, bf16* Y, char* shm) {
    const int tid = threadIdx.x, lane = tid & 63, r32 = lane & 31, hi = lane >> 5; const int wid = __builtin_amdgcn_readfirstlane(tid >> 6);
    const int q0 = qb * 256;
    const unsigned lds0 = (unsigned)(uintptr_t)shm; float* wsf = (float*)(shm + LDS_WS) + wid * 64;
    const bf16* ksrc0 = K + h * 96 + (size_t)lane * 768 + wid * 8;
    const bf16* ksrc1 = ksrc0 + 64;
    const bf16* vsrc = V + h * 64 + (size_t)(16 * (wid & 3) + (lane >> 2)) * 512 + (wid >> 2) * 32 + (lane & 3) * 8;
    const unsigned kdst0 = lds0 + LDS_K + wid * 1024, kdst1 = kdst0 + 8192, vdst = lds0 + LDS_V + wid * 1024;
#define DMA(t, s) do { glds16(ksrc0 + (size_t)(t) * 64 * 768, (unsigned)__builtin_amdgcn_readfirstlane(kdst0 + (s) * KSL)); \
        if (wid < 4) glds16(ksrc1 + (size_t)(t) * 64 * 768, (unsigned)__builtin_amdgcn_readfirstlane(kdst1 + (s) * KSL)); \
        glds16(vsrc + (size_t)(t) * 64 * 512, (unsigned)__builtin_amdgcn_readfirstlane(vdst + (s) * VSL)); } while (0)
    DMA(0, 0);
    bf16x8 qr[6];
    { const bf16* Qw = Q + (size_t)(q0 + wid * 32 + r32) * 768 + h * 96 + hi * 8;
#pragma unroll
      for (int d0 = 0; d0 < 6; ++d0) qr[d0] = *reinterpret_cast<const bf16x8*>(Qw + d0 * 16); }
    float mhat = 0.f, l_reg = 0.f; f32x16 o[2]; o[0] = f32x16{}; o[1] = f32x16{}; f32x16 negm = f32x16{};
    const lds_cptr shm3 = (lds_cptr)shm; const lds_cptr kp0 = shm3 + LDS_K + hi * 1024 + r32 * 16;
    const lds_cptr vp0 = shm3 + LDS_V + ((lane >> 4) & 1) * 32 + (lane & 3) * 8 + (4 * hi + ((lane & 15) >> 2)) * 64;
#pragma nounroll
    for (int t = 0; t < NT; ++t) {
        WAIT_BAR0();
        const int s = t & 1;
        if (t + 1 < NT) DMA(t + 1, s ^ 1);
        const lds_cptr kp = kp0 + s * KSL; f32x16 p0 = negm, p1 = negm;
#pragma unroll
        for (int d0 = 0; d0 < 6; ++d0) { const bf16x8 b0 = *(const LAS bf16x8*)(kp + d0 * 2048), b1 = *(const LAS bf16x8*)(kp + d0 * 2048 + 512);
            p0 = __builtin_amdgcn_mfma_f32_32x32x16_bf16(b0, qr[d0], p0, 0, 0, 0); p1 = __builtin_amdgcn_mfma_f32_32x32x16_bf16(b1, qr[d0], p1, 0, 0, 0); }
        const float rm = rowmax(p0, p1);
        if (t == 0 || __any(rm > (float)THRL)) {
            const float dl = (t == 0) ? rm : __builtin_fmaxf(rm, 0.f); mhat += dl;
#pragma unroll
            for (int r = 0; r < 16; ++r) { p0[r] -= dl; p1[r] -= dl; negm[r] = -mhat; }
            const float f = __builtin_amdgcn_exp2f(-dl); l_reg *= f;
            if (t > 0) { if (hi == 0) wsf[r32] = f; asm volatile("s_waitcnt lgkmcnt(0)" ::: "memory");
#pragma unroll
                for (int d_ = 0; d_ < 2; ++d_)
#pragma unroll
                    for (int r = 0; r < 16; ++r) o[d_][r] *= wsf[crow(r, hi)]; }
        }
        float sacc = 0.f;
#pragma unroll
        for (int r = 0; r < 16; ++r) { p0[r] = __builtin_amdgcn_exp2f(p0[r]); p1[r] = __builtin_amdgcn_exp2f(p1[r]); sacc += p0[r] + p1[r]; }
        l_reg += sacc;
        bf16x8 pa[4];
#pragma unroll
        for (int ks = 0; ks < 2; ++ks) {
            const v4u w0 = (v4u){cvtpk(p0[8 * ks], p0[8 * ks + 1]), cvtpk(p0[8 * ks + 2], p0[8 * ks + 3]), cvtpk(p0[8 * ks + 4], p0[8 * ks + 5]), cvtpk(p0[8 * ks + 6], p0[8 * ks + 7])};
            const v4u w1 = (v4u){cvtpk(p1[8 * ks], p1[8 * ks + 1]), cvtpk(p1[8 * ks + 2], p1[8 * ks + 3]), cvtpk(p1[8 * ks + 4], p1[8 * ks + 5]), cvtpk(p1[8 * ks + 6], p1[8 * ks + 7])};
            pa[ks] = __builtin_bit_cast(bf16x8, w0); pa[2 + ks] = __builtin_bit_cast(bf16x8, w1); }
        const lds_cptr vp = vp0 + s * VSL;
#pragma unroll
        for (int dh = 0; dh < 2; ++dh)
#pragma unroll
            for (int ks = 0; ks < 4; ++ks) { const s16x4 vl = vtr(vp + dh * 4096 + ks * 1024), vh = vtr(vp + dh * 4096 + ks * 1024 + 512);
                const bf16x8 vf = (bf16x8){vl[0], vl[1], vl[2], vl[3], vh[0], vh[1], vh[2], vh[3]};
                o[dh] = __builtin_amdgcn_mfma_f32_32x32x16_bf16(pa[ks], vf, o[dh], 0, 0, 0); }
    }
    { auto rr = __builtin_amdgcn_permlane32_swap(__float_as_uint(l_reg), __float_as_uint(l_reg), false, false); l_reg = __uint_as_float(rr[0]) + __uint_as_float(rr[1]); }
    if (hi == 0) wsf[32 + r32] = l_reg; asm volatile("s_waitcnt lgkmcnt(0)" ::: "memory");
    float rli[16];
#pragma unroll
    for (int r = 0; r < 16; ++r) rli[r] = __builtin_amdgcn_rcpf(wsf[32 + crow(r, hi)]);
    bf16* Yw = Y + (size_t)(q0 + wid * 32) * D + h * 64; bf16* stg = (bf16*)(shm + LDS_OST) + wid * 2048;
#pragma unroll
    for (int r = 0; r < 16; ++r) { const int orow = crow(r, hi);
#pragma unroll
        for (int d0 = 0; d0 < 2; ++d0) stg[orow * 64 + d0 * 32 + r32] = (bf16)f2bf(o[d0][r] * rli[r]); }
    asm volatile("s_waitcnt lgkmcnt(0)" ::: "memory");
#pragma unroll
    for (int i = 0; i < 4; ++i) { const int row = i * 8 + (lane >> 3), ch = lane & 7; *(v4u*)(Yw + (size_t)row * D + ch * 8) = *(const v4u*)(stg + row * 64 + ch * 8); }
    asm volatile("s_waitcnt lgkmcnt(0)\n\ts_barrier" ::: "memory");
#undef DMA
}
#undef WAIT_BAR0
}


namespace att2 {
using att::bf16x8; using att::s16x4; using att::f32x16; using att::lds_cptr; using att::crow; using att::glds16; using att::cvtpk; using att::vtr; using att::rowmax;
constexpr int KSL = 12288, VSL = 8192, LDS_K = 0, LDS_V = 3 * KSL, LDS_WS = LDS_V + 3 * VSL, LDS_OST = LDS_WS + 8 * 256, LDS_BYTES_ATT = LDS_OST + 8 * 4096;
constexpr int NT = L / 64;
#define SBAR() __builtin_amdgcn_sched_barrier(0)
#define PIN(x) asm volatile("" : "+v"(x))
#define MFMA(a, b, c) __builtin_amdgcn_mfma_f32_32x32x16_bf16(a, b, c, 0, 0, 0)
#define WAIT_BAR(N) asm volatile("s_waitcnt vmcnt(" #N ") lgkmcnt(0)\n\ts_barrier" ::: "memory")
constexpr int LDS_FLAG = 96256;
template <int THRL, bool FAST> __device__ __forceinline__ void attn_unit(int h, int qb, const bf16* Q, const bf16* __restrict__ K, const bf16* __restrict__ V, bf16* Y, char* shm) {
    const int tid = threadIdx.x, lane = tid & 63, r32 = lane & 31, hi = lane >> 5; const int wid = __builtin_amdgcn_readfirstlane(tid >> 6);
    const int q0 = qb * 256;
    const unsigned lds0 = (unsigned)(uintptr_t)shm; float* wsf = (float*)(shm + LDS_WS) + wid * 64;
    const bf16* ksrc0 = K + h * 96 + (size_t)lane * 768 + wid * 8;
    const bf16* ksrc1 = ksrc0 + 64;
    const bf16* vsrc = V + h * 64 + (size_t)(16 * (wid & 3) + (lane >> 2)) * 512 + (wid >> 2) * 32 + (lane & 3) * 8;
    const unsigned kdst0 = lds0 + LDS_K + wid * 1024, kdst1 = kdst0 + 8192, vdst = lds0 + LDS_V + wid * 1024;
#define DMA_K(t, so) do { const int t_ = (t) < NT ? (t) : NT - 1; glds16(ksrc0 + (size_t)t_ * 64 * 768, (unsigned)__builtin_amdgcn_readfirstlane(kdst0 + (so))); \
        if (wid < 4) glds16(ksrc1 + (size_t)t_ * 64 * 768, (unsigned)__builtin_amdgcn_readfirstlane(kdst1 + (so))); } while (0)
#define DMA_V(t, so) do { const int t_ = (t) < NT ? (t) : NT - 1; glds16(vsrc + (size_t)t_ * 64 * 512, (unsigned)__builtin_amdgcn_readfirstlane(vdst + (so))); } while (0)
    DMA_K(0, 0); DMA_V(0, 0); DMA_K(1, KSL);
    bf16x8 qr[6];
    { const bf16* Qw = Q + (size_t)(q0 + wid * 32 + r32) * 768 + h * 96 + hi * 8;
#pragma unroll
      for (int d0 = 0; d0 < 6; ++d0) qr[d0] = *reinterpret_cast<const bf16x8*>(Qw + d0 * 16); }
    if (FAST && tid == 0) *(LAS int*)((LAS char*)shm + LDS_FLAG) = 0;
    float gmax = 0.f; float mhat = 0.f, l_reg = 0.f; f32x16 o[2]; o[0] = f32x16{}; o[1] = f32x16{}; f32x16 negm = f32x16{}; PIN(negm);
    const lds_cptr shm3 = (lds_cptr)shm; const lds_cptr kp0 = shm3 + LDS_K + hi * 1024 + r32 * 16;
    const lds_cptr vp0 = shm3 + LDS_V + ((lane >> 4) & 1) * 32 + (lane & 3) * 8 + (4 * hi + ((lane & 15) >> 2)) * 64;
    bool resc = false;
    f32x16 pA0, pA1, pB0, pB1; bf16x8 kf[4]; s16x4 vlo[8], vhi[8]; v4u pw0, pw1, pw2, pw3;
    WAIT_BAR(0);
    { pA0 = negm; pA1 = negm;
#pragma unroll
      for (int d0 = 0; d0 < 6; ++d0) { const bf16x8 b0 = *(const LAS bf16x8*)(kp0 + d0 * 2048), b1 = *(const LAS bf16x8*)(kp0 + d0 * 2048 + 512); pA0 = MFMA(b0, qr[d0], pA0); pA1 = MFMA(b1, qr[d0], pA1); }
      const float rm = rowmax(pA0, pA1); mhat = rm;
#pragma unroll
      for (int r = 0; r < 16; ++r) { pA0[r] = __builtin_amdgcn_exp2f(pA0[r] - rm); pA1[r] = __builtin_amdgcn_exp2f(pA1[r] - rm); negm[r] = -mhat; }
      PIN(negm); }
    asm volatile("s_waitcnt lgkmcnt(0)\n\ts_barrier" ::: "memory");
    DMA_K(2, 2 * KSL); DMA_V(1, VSL);
    int s_prev = 0, s_cur = 1, s_next = 2;
#define ROT() do { const int n_ = s_prev; s_prev = s_cur; s_cur = s_next; s_next = n_; } while (0)
#define RESC() do { if (resc) { _Pragma("unroll") for (int d_ = 0; d_ < 2; ++d_) _Pragma("unroll") for (int r = 0; r < 16; ++r) o[d_][r] *= wsf[crow(r, hi)]; } } while (0)
#define PKW(P, B) cvtpk(P[B], P[B + 1])
#define PAF(k) __builtin_bit_cast(bf16x8, pw##k)
#define VFR(i) (bf16x8){vlo[i][0], vlo[i][1], vlo[i][2], vlo[i][3], vhi[i][0], vhi[i][1], vhi[i][2], vhi[i][3]}
#define VRD(i) do { vlo[i] = vtr(vp_ + (((i) >> 2) * 4096 + ((i) & 3) * 1024)); vhi[i] = vtr(vp_ + (((i) >> 2) * 4096 + ((i) & 3) * 1024 + 512)); } while (0)
#define KRD(i) do { kf[(i) & 3] = *(const LAS bf16x8*)(kp_ + ((i) >> 1) * 2048 + ((i) & 1) * 512); } while (0)
#define GAPA(MF, A0, A1, A2, A3, W0, W1, PW) do { MF; sacc += A0; sacc += A1; sacc += A2; sacc += A3; PIN(sacc); W0; W1; PIN(PW); SBAR(); } while (0)
#define GAPM(MF) do { MF; SBAR(); } while (0)
#define EX(v) __builtin_amdgcn_exp2f(v)
#define GAPB(MF, X, B) do { MF; X[B] = EX(X[B]); X[B + 1] = EX(X[B + 1]); X[B + 2] = EX(X[B + 2]); X[B + 3] = EX(X[B + 3]); PIN(X); SBAR(); } while (0)
#define STEP(C0, C1, P0, P1, t) do { SBAR(); \
    const lds_cptr vp_ = vp0 + s_prev * VSL; const lds_cptr kp_ = kp0 + s_cur * KSL; \
    KRD(0); KRD(1); VRD(0); SBAR(); float sacc = (P0[0] + P0[1]); \
    KRD(2); SBAR(); GAPA(C0 = MFMA(kf[0], qr[0], negm), P0[2], P0[3], P0[4], P0[5],     pw0[0] = PKW(P0, 0),  pw0[1] = PKW(P0, 2),  pw0); \
    KRD(3); VRD(4); SBAR(); GAPA(C1 = MFMA(kf[1], qr[0], negm), P0[6], P0[7], P0[8], P0[9],     pw0[2] = PKW(P0, 4),  pw0[3] = PKW(P0, 6),  pw0); \
    KRD(4); VRD(1); SBAR(); GAPA(C0 = MFMA(kf[2], qr[1], C0),   P0[10], P0[11], P0[12], P0[13], pw1[0] = PKW(P0, 8),  pw1[1] = PKW(P0, 10), pw1); \
    KRD(5); VRD(5); SBAR(); GAPA(C1 = MFMA(kf[3], qr[1], C1),   P0[14], P0[15], P1[0], P1[1],   pw1[2] = PKW(P0, 12), pw1[3] = PKW(P0, 14), pw1); \
    KRD(6); VRD(2); SBAR(); GAPA(C0 = MFMA(kf[0], qr[2], C0),   P1[2], P1[3], P1[4], P1[5],     pw2[0] = PKW(P1, 0),  pw2[1] = PKW(P1, 2),  pw2); \
    KRD(7); VRD(6); SBAR(); GAPA(C1 = MFMA(kf[1], qr[2], C1),   P1[6], P1[7], P1[8], P1[9],     pw2[2] = PKW(P1, 4),  pw2[3] = PKW(P1, 6),  pw2); \
    KRD(8); VRD(3); SBAR(); GAPA(C0 = MFMA(kf[2], qr[3], C0),   P1[10], P1[11], P1[12], P1[13], pw3[0] = PKW(P1, 8),  pw3[1] = PKW(P1, 10), pw3); \
    KRD(9); VRD(7); SBAR(); GAPA(C1 = MFMA(kf[3], qr[3], C1),   P1[14], P1[15], 0.f, 0.f,       pw3[2] = PKW(P1, 12), pw3[3] = PKW(P1, 14), pw3); \
    KRD(10); SBAR(); GAPM(C0 = MFMA(kf[0], qr[4], C0)); \
    KRD(11); SBAR(); GAPM(C1 = MFMA(kf[1], qr[4], C1)); \
    DMA_K((t) + 2, s_prev * KSL); SBAR(); GAPM(C0 = MFMA(kf[2], qr[5], C0)); \
    DMA_V((t) + 1, s_next * VSL); SBAR(); GAPM(C1 = MFMA(kf[3], qr[5], C1)); \
    l_reg += sacc; if (FAST) gmax = __builtin_fmaxf(gmax, sacc); \
    if (!FAST) { const float rm = rowmax(C0, C1); resc = false; \
      if (__builtin_expect(__any(rm > (float)THRL), 0)) { const float dl = __builtin_fmaxf(rm, 0.f); mhat += dl; \
        _Pragma("unroll") for (int r = 0; r < 16; ++r) { C0[r] -= dl; C1[r] -= dl; } \
        _Pragma("unroll") for (int r = 0; r < 16; ++r) negm[r] = -mhat; PIN(negm); \
        const float f = __builtin_amdgcn_exp2f(-dl); l_reg *= f; if (hi == 0) wsf[r32] = f; resc = true; } } \
    SBAR(); \
    GAPB(o[0] = MFMA(PAF(0), VFR(0), o[0]), C0, 0);  GAPB(o[1] = MFMA(PAF(0), VFR(4), o[1]), C0, 4); \
    GAPB(o[0] = MFMA(PAF(1), VFR(1), o[0]), C0, 8);  GAPB(o[1] = MFMA(PAF(1), VFR(5), o[1]), C0, 12); \
    GAPB(o[0] = MFMA(PAF(2), VFR(2), o[0]), C1, 0);  GAPB(o[1] = MFMA(PAF(2), VFR(6), o[1]), C1, 4); \
    GAPB(o[0] = MFMA(PAF(3), VFR(3), o[0]), C1, 8);  GAPB(o[1] = MFMA(PAF(3), VFR(7), o[1]), C1, 12); \
    if (wid < 4) { WAIT_BAR(3); } else { WAIT_BAR(2); } \
    RESC(); ROT(); } while (0)
    int t = 1;
#pragma nounroll
    for (; t + 1 < NT; t += 2) {
        STEP(pB0, pB1, pA0, pA1, t);
        STEP(pA0, pA1, pB0, pB1, t + 1);
    }
    STEP(pB0, pB1, pA0, pA1, NT - 1);
    { float sacc = pB0[0] + pB0[1];
#pragma unroll
      for (int r = 2; r < 16; ++r) sacc += pB0[r];
#pragma unroll
      for (int r = 0; r < 16; ++r) sacc += pB1[r];
      l_reg += sacc; if (FAST) gmax = __builtin_fmaxf(gmax, sacc);
      pw0 = (v4u){PKW(pB0, 0), PKW(pB0, 2), PKW(pB0, 4), PKW(pB0, 6)}; pw1 = (v4u){PKW(pB0, 8), PKW(pB0, 10), PKW(pB0, 12), PKW(pB0, 14)};
      pw2 = (v4u){PKW(pB1, 0), PKW(pB1, 2), PKW(pB1, 4), PKW(pB1, 6)}; pw3 = (v4u){PKW(pB1, 8), PKW(pB1, 10), PKW(pB1, 12), PKW(pB1, 14)};
      const lds_cptr vp_ = vp0 + s_prev * VSL;
#pragma unroll
      for (int i = 0; i < 8; ++i) VRD(i);
      o[0] = MFMA(PAF(0), VFR(0), o[0]); o[1] = MFMA(PAF(0), VFR(4), o[1]); o[0] = MFMA(PAF(1), VFR(1), o[0]); o[1] = MFMA(PAF(1), VFR(5), o[1]);
      o[0] = MFMA(PAF(2), VFR(2), o[0]); o[1] = MFMA(PAF(2), VFR(6), o[1]); o[0] = MFMA(PAF(3), VFR(3), o[0]); o[1] = MFMA(PAF(3), VFR(7), o[1]); }
    { auto rr = __builtin_amdgcn_permlane32_swap(__float_as_uint(l_reg), __float_as_uint(l_reg), false, false); l_reg = __uint_as_float(rr[0]) + __uint_as_float(rr[1]); }
    if (hi == 0) wsf[32 + r32] = l_reg; asm volatile("s_waitcnt lgkmcnt(0)" ::: "memory");
    float rli[16];
#pragma unroll
    for (int r = 0; r < 16; ++r) rli[r] = __builtin_amdgcn_rcpf(wsf[32 + crow(r, hi)]);
    bf16* Yw = Y + (size_t)(q0 + wid * 32) * D + h * 64; bf16* stg = (bf16*)(shm + LDS_OST) + wid * 2048;
#pragma unroll
    for (int r = 0; r < 16; ++r) { const int orow = crow(r, hi);
#pragma unroll
        for (int d0 = 0; d0 < 2; ++d0) stg[orow * 64 + d0 * 32 + r32] = (bf16)f2bf(o[d0][r] * rli[r]); }
    asm volatile("s_waitcnt lgkmcnt(0)" ::: "memory");
#pragma unroll
    for (int i = 0; i < 4; ++i) { const int row = i * 8 + (lane >> 3), ch = lane & 7; *(v4u*)(Yw + (size_t)row * D + ch * 8) = *(const v4u*)(stg + row * 64 + ch * 8); }
    if (FAST) { if (__any(!(gmax < 1.0995116e12f)) && lane == 0) *(LAS int*)((LAS char*)shm + LDS_FLAG) = 1; }
    asm volatile("s_waitcnt vmcnt(0) lgkmcnt(0)\n\ts_barrier" ::: "memory");
#undef DMA_K
#undef DMA_V
#undef ROT
#undef RESC
#undef PKW
#undef PAF
#undef VFR
#undef VRD
#undef KRD
#undef GAPA
#undef GAPM
#undef GAPB
#undef EX
#undef STEP
}
#undef SBAR
#undef PIN
#undef MFMA
#undef WAIT_BAR
}

namespace toep {
typedef short bf16x8 __attribute__((ext_vector_type(8)));
typedef float f32x16 __attribute__((ext_vector_type(16)));
typedef LAS const char* lds_cptr;
constexpr int UB = 46080, WIN = 8704, LDS_U = 0, LDS_W = 2 * UB, LDS_S = LDS_W + 4 * WIN, NCH = 34;
__device__ __forceinline__ v4u funnel(v4u a, v4u b, int cq) {
    unsigned v[8] = {a.x, a.y, a.z, a.w, b.x, b.y, b.z, b.w}; const int c2 = cq >> 1;
    if (c2 & 1) {
#pragma unroll
        for (int k = 0; k < 7; ++k) v[k] = v[k + 1]; }
    if (c2 & 2) {
#pragma unroll
        for (int k = 0; k < 6; ++k) v[k] = v[k + 2]; }
    v4u o;
    if (cq & 1) { o.x = __builtin_amdgcn_alignbit(v[1], v[0], 16); o.y = __builtin_amdgcn_alignbit(v[2], v[1], 16); o.z = __builtin_amdgcn_alignbit(v[3], v[2], 16); o.w = __builtin_amdgcn_alignbit(v[4], v[3], 16); }
    else { o.x = v[0]; o.y = v[1]; o.z = v[2]; o.w = v[3]; }
    return o;
}
struct Stg { v4u a[2], e[2]; };
__device__ __forceinline__ void stage_load(Stg& s, int g, const bf16* GrX, const bf16* GrY, int lane) {
    const int sw = g >= NCH ? 1 : 0, q = g - sw * NCH; const int baseU = L + 1024 - 512 * q, baseL = baseU + 17376;
    const bf16* up = (sw ? GrY : GrX) + baseU; const bf16* lo = (sw ? GrX : GrY) + baseL; const int pe = 64 + (lane % 6);
    s.a[0] = *(const v4u*)(up + 8 * lane); s.e[0] = *(const v4u*)(up + 8 * pe);
    s.a[1] = *(const v4u*)(lo + 8 * lane); s.e[1] = *(const v4u*)(lo + 8 * pe);
}
__device__ __forceinline__ v4u shfl_dn1(v4u x) { return (v4u){(unsigned)__shfl_down((int)x.x, 1), (unsigned)__shfl_down((int)x.y, 1), (unsigned)__shfl_down((int)x.z, 1), (unsigned)__shfl_down((int)x.w, 1)}; }
__device__ __forceinline__ void stage_write(const Stg& s, char* shm, int bq, int cq, int lane) {
#pragma unroll
    for (int w = 0; w < 2; ++w) { char* img = shm + LDS_W + (bq * 2 + w) * WIN + cq * 1088;
        v4u nb = shfl_dn1(s.a[w]); const v4u ne = shfl_dn1(s.e[w]);
        const v4u e0 = (v4u){(unsigned)__builtin_amdgcn_readfirstlane((int)s.e[w].x), (unsigned)__builtin_amdgcn_readfirstlane((int)s.e[w].y), (unsigned)__builtin_amdgcn_readfirstlane((int)s.e[w].z), (unsigned)__builtin_amdgcn_readfirstlane((int)s.e[w].w)};
        if (lane == 63) nb = e0;
        *(v4u*)(img + 16 * lane) = funnel(s.a[w], nb, cq);
        if (lane < 4) *(v4u*)(img + 16 * (64 + lane)) = funnel(s.e[w], ne, cq); }
}
#define TMF(A, B, C) __builtin_amdgcn_mfma_f32_32x32x16_bf16(A, B, C, 0, 0, 0)
#define TSB() __builtin_amdgcn_sched_barrier(0)
template <int NS> __device__ __forceinline__ void chunk_fast(f32x16& a0, f32x16& a1, lds_cptr win, lds_cptr b0) {
    bf16x8 fr[3][6];
#define TLD(s, k) do { const int ao_ = 64 * (15 - (s)), bo_ = -80 * (s); fr[k][0] = *(const LAS bf16x8*)(win + ao_); fr[k][1] = *(const LAS bf16x8*)(win + ao_ + 32); \
        fr[k][2] = *(const LAS bf16x8*)(b0 + bo_); fr[k][3] = *(const LAS bf16x8*)(b0 + bo_ + 32); fr[k][4] = *(const LAS bf16x8*)(b0 + 2560 + bo_); fr[k][5] = *(const LAS bf16x8*)(b0 + 2560 + bo_ + 32); } while (0)
    TLD(0, 0); TLD(1, 1); TSB();
#pragma unroll
    for (int s = 0; s < NS; ++s) { const int k = s % 3;
        if (s + 2 < NS) TLD(s + 2, (s + 2) % 3);
        TSB();
        a0 = TMF(fr[k][0], fr[k][2], a0); a1 = TMF(fr[k][0], fr[k][4], a1); a0 = TMF(fr[k][1], fr[k][3], a0); a1 = TMF(fr[k][1], fr[k][5], a1);
        TSB(); }
#undef TLD
}
__device__ __forceinline__ void chunk_mixed(f32x16& aL, lds_cptr winL, lds_cptr bL, f32x16& aU, lds_cptr winU, lds_cptr bU) {
    bf16x8 fr[2][8];
#define TLD(s, k) do { const int ao_ = 64 * (15 - (s)), bo_ = -80 * (s); fr[k][0] = *(const LAS bf16x8*)(winL + ao_); fr[k][1] = *(const LAS bf16x8*)(winL + ao_ + 32); fr[k][2] = *(const LAS bf16x8*)(winU + ao_); fr[k][3] = *(const LAS bf16x8*)(winU + ao_ + 32); \
        fr[k][4] = *(const LAS bf16x8*)(bL + bo_); fr[k][5] = *(const LAS bf16x8*)(bL + bo_ + 32); fr[k][6] = *(const LAS bf16x8*)(bU + bo_); fr[k][7] = *(const LAS bf16x8*)(bU + bo_ + 32); } while (0)
    TLD(0, 0); TSB();
#pragma unroll
    for (int s = 0; s < 16; ++s) { const int k = s & 1;
        if (s + 1 < 16) TLD(s + 1, k ^ 1);
        TSB();
        aL = TMF(fr[k][0], fr[k][4], aL); aU = TMF(fr[k][2], fr[k][6], aU); aL = TMF(fr[k][1], fr[k][5], aL); aU = TMF(fr[k][3], fr[k][7], aU);
        TSB(); }
#undef TLD
}
#undef TSB
__device__ __forceinline__ void toep_unit(int pair, const bf16* Gr, const bf16* uT, const float* fsum, const float* hbias, bf16* zT, char* shm) {
    const int tid = threadIdx.x, lane = tid & 63, r = lane & 31, h = lane >> 5; const int wid = __builtin_amdgcn_readfirstlane(tid >> 6);
    const int cX = 2 * pair; const bf16* GrX = Gr + (size_t)cX * NG; const bf16* GrY = GrX + NG;
    if (wid < 2) { const int c = cX + wid; float s = 0.f; for (int b = lane; b < 256; b += 64) s += fsum[b * 1024 + c] + fsum[b * 1024 + 512 + c]; s = wave_sum(s); if (lane == 0) ((float*)(shm + LDS_S))[wid] = 1.0f / s; }
#pragma unroll
    for (int ch = 0; ch < 2; ++ch) { const bf16* us = uT + (size_t)(cX + ch) * L; char* ub = shm + LDS_U + ch * UB;
        for (int p = tid; p < 2048; p += 512) *(v4u*)(ub + ((p >> 2) + 32) * 80 + (p & 3) * 16) = *(const v4u*)(us + p * 8);
        if (tid < 320) { const int blk = tid / 5, sub = tid % 5, bi = blk < 32 ? blk : 512 + blk; *(v4u*)(ub + bi * 80 + sub * 16) = (v4u){0u, 0u, 0u, 0u}; } }
    Stg st; stage_load(st, 0, GrX, GrY, lane); stage_write(st, shm, 0, wid, lane);
    asm volatile("s_waitcnt vmcnt(0) lgkmcnt(0)\n\ts_barrier" ::: "memory");
    f32x16 aX0 = f32x16{}, aX1 = f32x16{}, aY0 = f32x16{}, aY1 = f32x16{};
    const lds_cptr shm3 = (lds_cptr)shm; const int ap = 31 - r; const int laneA = (ap & 7) * 1088 + 16 * (ap >> 3) + 16 * h; const int I0 = 2 * wid;
#define CHUNK_ITER(SW, COMPUTE) do { const int g = (SW) * NCH + q, bq = g & 1, dcu = -16 + 16 * q; \
        if (g + 1 < 2 * NCH) stage_load(st, g + 1, GrX, GrY, lane); \
        const lds_cptr winU = shm3 + LDS_W + (bq * 2) * WIN + laneA, winL = winU + WIN; \
        const lds_cptr bU0 = shm3 + LDS_U + ((SW) ? UB : 0) + (32 * I0 + r - dcu + 32) * 80 + 16 * h; \
        const lds_cptr bL0 = shm3 + LDS_U + ((SW) ? 0 : UB) + (32 * I0 + r - (dcu - 543) + 32) * 80 + 16 * h; \
        (void)winU; (void)winL; (void)bU0; (void)bL0; \
        COMPUTE; \
        if (g + 1 < 2 * NCH) { asm volatile("s_waitcnt vmcnt(0)" ::: "memory"); stage_write(st, shm, bq ^ 1, wid, lane); } \
        asm volatile("s_waitcnt lgkmcnt(0)\n\ts_barrier" ::: "memory"); } while (0)
#define SWEEP(SW, U0, U1, L0, L1) do { int q = 0; const int qa = 2 * I0 + 3, qb = 2 * I0 + 5; \
        _Pragma("nounroll") for (; q < qa; ++q) CHUNK_ITER(SW, chunk_fast<16>(U0, U1, winU, bU0)); \
        _Pragma("nounroll") for (; q < qb; ++q) CHUNK_ITER(SW, chunk_mixed(L0, winL, bL0, U1, winU, bU0 + 2560)); \
        _Pragma("nounroll") for (; q < NCH - 1; ++q) CHUNK_ITER(SW, chunk_fast<16>(L0, L1, winL, bL0)); \
        _Pragma("nounroll") for (; q < NCH; ++q) CHUNK_ITER(SW, chunk_fast<15>(L0, L1, winL, bL0)); } while (0)
    SWEEP(0, aX0, aX1, aY0, aY1);
    SWEEP(1, aY0, aY1, aX0, aX1);
#undef SWEEP
#undef CHUNK_ITER
#pragma unroll
    for (int ch = 0; ch < 2; ++ch) { const float invS = ((const float*)(shm + LDS_S))[ch], bias = hbias[cX + ch]; bf16* zrow = zT + (size_t)(cX + ch) * L;
#pragma unroll
        for (int ii = 0; ii < 2; ++ii) { const f32x16& a = ch == 0 ? (ii == 0 ? aX0 : aX1) : (ii == 0 ? aY0 : aY1); const int blk = 32 * (I0 + ii) + r;
#pragma unroll
            for (int g4 = 0; g4 < 4; ++g4) { const v2u uw = *(const v2u*)(shm + LDS_U + ch * UB + (blk + 32) * 80 + 16 * g4 + 8 * h);
                const float z0 = a[4 * g4] * invS + bias * bflo(uw.x), z1 = a[4 * g4 + 1] * invS + bias * bfhi(uw.x), z2 = a[4 * g4 + 2] * invS + bias * bflo(uw.y), z3 = a[4 * g4 + 3] * invS + bias * bfhi(uw.y);
                *(v2u*)(zrow + 32 * blk + 8 * g4 + 4 * h) = (v2u){pk2(z0, z1), pk2(z2, z3)}; } } }
    asm volatile("s_waitcnt lgkmcnt(0)\n\ts_barrier" ::: "memory");
}
#undef TMF
}


namespace hfft {
constexpr int FN = 32768, EX1S = 513;
constexpr size_t LDS_SC = 131584;
__host__ __device__ constexpr float twc(int j) { switch (j) { case 0: return 1.000000000e+00f; case 1: return 9.951847267e-01f; case 2: return 9.807852804e-01f; case 3: return 9.569403357e-01f; case 4: return 9.238795325e-01f; case 5: return 8.819212643e-01f; case 6: return 8.314696123e-01f; case 7: return 7.730104534e-01f; case 8: return 7.071067812e-01f; case 9: return 6.343932842e-01f; case 10: return 5.555702330e-01f; case 11: return 4.713967368e-01f; case 12: return 3.826834324e-01f; case 13: return 2.902846773e-01f; case 14: return 1.950903220e-01f; case 15: return 9.801714033e-02f; case 16: return 6.123233996e-17f; case 17: return -9.801714033e-02f; case 18: return -1.950903220e-01f; case 19: return -2.902846773e-01f; case 20: return -3.826834324e-01f; case 21: return -4.713967368e-01f; case 22: return -5.555702330e-01f; case 23: return -6.343932842e-01f; case 24: return -7.071067812e-01f; case 25: return -7.730104534e-01f; case 26: return -8.314696123e-01f; case 27: return -8.819212643e-01f; case 28: return -9.238795325e-01f; case 29: return -9.569403357e-01f; case 30: return -9.807852804e-01f; case 31: return -9.951847267e-01f; default: return 0.f; } }
__host__ __device__ constexpr float tws(int j) { switch (j) { case 0: return -0.000000000e+00f; case 1: return -9.801714033e-02f; case 2: return -1.950903220e-01f; case 3: return -2.902846773e-01f; case 4: return -3.826834324e-01f; case 5: return -4.713967368e-01f; case 6: return -5.555702330e-01f; case 7: return -6.343932842e-01f; case 8: return -7.071067812e-01f; case 9: return -7.730104534e-01f; case 10: return -8.314696123e-01f; case 11: return -8.819212643e-01f; case 12: return -9.238795325e-01f; case 13: return -9.569403357e-01f; case 14: return -9.807852804e-01f; case 15: return -9.951847267e-01f; case 16: return -1.000000000e+00f; case 17: return -9.951847267e-01f; case 18: return -9.807852804e-01f; case 19: return -9.569403357e-01f; case 20: return -9.238795325e-01f; case 21: return -8.819212643e-01f; case 22: return -8.314696123e-01f; case 23: return -7.730104534e-01f; case 24: return -7.071067812e-01f; case 25: return -6.343932842e-01f; case 26: return -5.555702330e-01f; case 27: return -4.713967368e-01f; case 28: return -3.826834324e-01f; case 29: return -2.902846773e-01f; case 30: return -1.950903220e-01f; case 31: return -9.801714033e-02f; default: return 0.f; } }
__host__ __device__ constexpr int brev(int i, int bits) { return bits == 6 ? (((i & 1) << 5) | ((i & 2) << 3) | ((i & 4) << 1) | ((i & 8) >> 1) | ((i & 16) >> 3) | ((i & 32) >> 5)) : (((i & 1) << 2) | (i & 2) | ((i & 4) >> 2)); }
template <int R, int LOG, int OFF> __device__ __forceinline__ void fft_dif(float (&re)[64], float (&im)[64]) {
#pragma unroll
    for (int s = 0; s < LOG; ++s) { const int half = R >> (s + 1);
#pragma unroll
        for (int b = 0; b < R; b += 2 * half)
#pragma unroll
            for (int j = 0; j < half; ++j) { const int i0 = OFF + b + j, i1 = i0 + half; const int tw = j * (32 / half); const float c = twc(tw), sn = tws(tw);
                const float tr = re[i0] - re[i1], ti = im[i0] - im[i1]; re[i0] += re[i1]; im[i0] += im[i1];
                if (tw == 0) { re[i1] = tr; im[i1] = ti; }
                else if (tw == 16) { re[i1] = ti; im[i1] = -tr; }
                else { re[i1] = tr * c - ti * sn; im[i1] = tr * sn + ti * c; }
                if ((j & 3) == 3 || j == half - 1) __builtin_amdgcn_sched_barrier(0); } }
}
__device__ __forceinline__ void twiddle64(float (&re)[64], float (&im)[64], float wr, float wi) {
    float cr = wr, ci = wi;
#pragma unroll
    for (int k = 1; k < 64; ++k) { const int i = brev(k, 6); const float xr = re[i], xi = im[i]; re[i] = xr * cr - xi * ci; im[i] = xr * ci + xi * cr;
        if (k < 63) { const float nr = cr * wr - ci * wi; ci = cr * wi + ci * wr; cr = nr; } if ((k & 7) == 7) __builtin_amdgcn_sched_barrier(0); }
}
#define XAT(B0, B1, C) (*(((C) < 16384) ? ((B0) + (C)) : ((B1) + ((C) - 16384))))
__device__ __forceinline__ void fft32k(float (&re)[64], float (&im)[64], LAS float* X, const float* twa, int tid_in) {
#define OPQ_TID() int tid = tid_in; asm volatile("" : "+v"(tid)); const int k1 = tid & 63, hi = tid >> 6; (void)k1; (void)hi
    float wr, wi; { OPQ_TID(); wr = twa[2 * tid]; wi = twa[2 * tid + 1]; }
#ifdef FFT_STLOOP
#pragma nounroll
#else
#pragma unroll
#endif
    for (int st = 0; st < 2; ++st) {
    fft_dif<64, 6, 0>(re, im);
    twiddle64(re, im, wr, wi);
    if (st == 0) {
    { OPQ_TID(); LAS float* w0 = X + tid; LAS float* w1 = w0 + 16384; asm volatile("" : "+v"(w1)); LAS float* r0 = X + k1 * EX1S + hi;
#pragma unroll
    for (int i = 0; i < 64; ++i) XAT(w0, w1, brev(i, 6) * EX1S) = re[i];
    __syncthreads();
#pragma unroll
    for (int m1 = 0; m1 < 64; ++m1) re[m1] = r0[8 * m1];
    __syncthreads();
#pragma unroll
    for (int i = 0; i < 64; ++i) XAT(w0, w1, brev(i, 6) * EX1S) = im[i];
    __syncthreads();
#pragma unroll
    for (int m1 = 0; m1 < 64; ++m1) im[m1] = r0[8 * m1];
    __syncthreads(); }
    { OPQ_TID(); wr = twa[2 * 64 * hi]; wi = twa[2 * 64 * hi + 1]; }
    } else {
    { OPQ_TID(); LAS float* w0 = X + hi * 64 + k1; LAS float* w1 = w0 + 16384; asm volatile("" : "+v"(w1)); LAS float* r0 = X + hi * 4096 + k1;
#pragma unroll
    for (int i = 0; i < 64; ++i) XAT(w0, w1, brev(i, 6) * 512) = re[i];
    __syncthreads();
#pragma unroll
    for (int e = 0; e < 8; ++e)
#pragma unroll
        for (int m2 = 0; m2 < 8; ++m2) re[8 * e + m2] = r0[(e * 8 + m2) * 64];
    __syncthreads();
#pragma unroll
    for (int i = 0; i < 64; ++i) XAT(w0, w1, brev(i, 6) * 512) = im[i];
    __syncthreads();
#pragma unroll
    for (int e = 0; e < 8; ++e)
#pragma unroll
        for (int m2 = 0; m2 < 8; ++m2) im[8 * e + m2] = r0[(e * 8 + m2) * 64];
    __syncthreads(); }
    } }
    fft_dif<8, 3, 0>(re, im); fft_dif<8, 3, 8>(re, im); fft_dif<8, 3, 16>(re, im); fft_dif<8, 3, 24>(re, im);
    fft_dif<8, 3, 32>(re, im); fft_dif<8, 3, 40>(re, im); fft_dif<8, 3, 48>(re, im); fft_dif<8, 3, 56>(re, im);
#undef OPQ_TID
}
__device__ __forceinline__ void reg_barrier(float (&re)[64], float (&im)[64]) {
#pragma unroll
    for (int i = 0; i < 64; i += 8) { asm volatile("" : "+v"(re[i]), "+v"(re[i + 1]), "+v"(re[i + 2]), "+v"(re[i + 3]), "+v"(re[i + 4]), "+v"(re[i + 5]), "+v"(re[i + 6]), "+v"(re[i + 7]));
        asm volatile("" : "+v"(im[i]), "+v"(im[i + 1]), "+v"(im[i + 2]), "+v"(im[i + 3]), "+v"(im[i + 4]), "+v"(im[i + 5]), "+v"(im[i + 6]), "+v"(im[i + 7])); }
    asm volatile("" ::: "memory"); __builtin_amdgcn_sched_barrier(0);
}
typedef _Float16 h2_t __attribute__((ext_vector_type(2)));
__device__ __forceinline__ unsigned ldg_off(const unsigned* base, unsigned off) { asm volatile("" : "+v"(off)); return *(const unsigned*)((const char*)base + off); }
__device__ __forceinline__ void stg_off(unsigned* base, unsigned off, unsigned v) { asm volatile("" : "+v"(off)); *(unsigned*)((char*)base + off) = v; }
__device__ __forceinline__ void conv_pair(const bf16* GrA, const bf16* GrB, const bf16* uA, const bf16* uB, bf16* zA, bf16* zB, float invSA, float invSB, float biasA, float biasB,
                                          const float* twa, unsigned* scr, LAS float* X, int tid_in) {
#define OPQ_T() int tid = tid_in; asm volatile("" : "+v"(tid))
#pragma nounroll
    for (int pass = 0; pass < 3; ++pass) {
    float re[64], im[64];
    if (pass == 0) {
    { OPQ_T(); const unsigned tr = 511u - (unsigned)tid;
#pragma unroll
    for (int n1 = 0; n1 < 64; ++n1) { float va, vb;
        if (n1 < 32) { va = bf2f((GrA + (LAGMAX - 511 - 512 * n1))[tr]); vb = bf2f((GrB + (LAGMAX - 511 - 512 * n1))[tr]); }
        else { va = bf2f((GrA + (LAGMAX - 511 + 2 * L - 512 * n1))[tr]); vb = bf2f((GrB + (LAGMAX - 511 + 2 * L - 512 * n1))[tr]); if (n1 == 32 && tid == 0) { va = 0.f; vb = 0.f; } }
        re[n1] = va; im[n1] = vb; } }
    } else if (pass == 1) {
    { OPQ_T();
#pragma unroll
    for (int n1 = 0; n1 < 64; ++n1) { re[n1] = (n1 < 32) ? bf2f((uA + 512 * n1)[tid]) : 0.f; im[n1] = (n1 < 32) ? bf2f((uB + 512 * n1)[tid]) : 0.f; } }
    } else {
    { OPQ_T(); const unsigned bb = (unsigned)((tid & 63) + 512 * ((tid >> 6) & 7)), bq = 3647u - bb, ob = bb << 2, oq = bq << 2;
      const LAS unsigned* o0 = (const LAS unsigned*)X + bb; const LAS unsigned* o1 = o0 + 16384; asm volatile("" : "+v"(o1));
      const LAS unsigned* p0 = (const LAS unsigned*)X + bq; const LAS unsigned* p1 = p0 + 16384; asm volatile("" : "+v"(p1));
#pragma unroll
    for (int ch = 0; ch < 8; ++ch) {
        unsigned cz[8], cq[8], ck[8], cp[8];
#pragma unroll
        for (int q = 0; q < 8; ++q) { const int c = 64 * ch + 4096 * brev(q, 3);
            if (c == 0) { const unsigned ip = (unsigned)(FN - (int)bb) & (unsigned)(FN - 1); cq[q] = ((const LAS unsigned*)X)[ip]; cp[q] = ldg_off(scr, ip << 2); }
            else { cq[q] = XAT(p0, p1, FN - 3647 - c); cp[q] = ldg_off(scr, oq + 4u * (unsigned)(FN - 3647 - c)); }
            cz[q] = XAT(o0, o1, c); ck[q] = ldg_off(scr, ob + 4u * (unsigned)c); }
#pragma unroll
        for (int q = 0; q < 8; ++q) { const int r = 8 * ch + q;
            const h2_t zo = __builtin_bit_cast(h2_t, cz[q]), zp = __builtin_bit_cast(h2_t, cq[q]), wk = __builtin_bit_cast(h2_t, ck[q]), wp = __builtin_bit_cast(h2_t, cp[q]);
            const float zr = (float)zo.y, zi = (float)zo.x, pr = (float)zp.y, pi = (float)zp.x, wr = (float)wk.x, wi = (float)wk.y, qr = (float)wp.x, qi = (float)wp.y;
            const float uar = zr + pr, uai = zi - pi, ubr = zi + pi, ubi = pr - zr;
            const float gar = wr + qr, gai = wi - qi, gbr = wi + qi, gbi = qr - wr;
            re[r] = (uar * gar - uai * gai) - (ubr * gbi + ubi * gbr);
            im[r] = -((uar * gai + uai * gar) + (ubr * gbr - ubi * gbi)); }
        __builtin_amdgcn_sched_barrier(0); } }
    __syncthreads();
    reg_barrier(re, im);
    { OPQ_T(); const int k1 = tid & 63, jg = tid >> 6; LAS float* w0 = X + jg * 512 + k1; LAS float* w1 = w0 + 16384; asm volatile("" : "+v"(w1)); LAS float* r0 = X + tid; LAS float* r1 = r0 + 16384; asm volatile("" : "+v"(r1));
#pragma unroll
    for (int e = 0; e < 8; ++e)
#pragma unroll
        for (int i = 0; i < 8; ++i) XAT(w0, w1, brev(i, 3) * 4096 + 64 * e) = re[8 * e + i];
    __syncthreads();
#pragma unroll
    for (int n1 = 0; n1 < 64; ++n1) re[n1] = XAT(r0, r1, n1 * 512);
    __syncthreads();
#pragma unroll
    for (int e = 0; e < 8; ++e)
#pragma unroll
        for (int i = 0; i < 8; ++i) XAT(w0, w1, brev(i, 3) * 4096 + 64 * e) = im[8 * e + i];
    __syncthreads();
#pragma unroll
    for (int n1 = 0; n1 < 64; ++n1) im[n1] = XAT(r0, r1, n1 * 512);
    __syncthreads(); }
    }
    reg_barrier(re, im);
    fft32k(re, im, X, twa, tid_in);
    reg_barrier(re, im);
    if (pass == 0) {
    { OPQ_T(); const unsigned ob = (unsigned)((tid & 63) + 512 * ((tid >> 6) & 7)) << 2;
#pragma unroll
    for (int e = 0; e < 8; ++e)
#pragma unroll
        for (int i = 0; i < 8; ++i) { const h2_t hv = {(_Float16)(re[8 * e + i] * 0.015625f), (_Float16)(im[8 * e + i] * 0.015625f)}; stg_off(scr, ob + 4u * (unsigned)(64 * e + 4096 * brev(i, 3)), __builtin_bit_cast(unsigned, hv)); } }
    } else if (pass == 1) {
    { OPQ_T(); LAS unsigned* w0 = (LAS unsigned*)X + (tid & 63) + 512 * (tid >> 6); LAS unsigned* w1 = w0 + 16384; asm volatile("" : "+v"(w1));
#pragma unroll
    for (int e = 0; e < 8; ++e)
#pragma unroll
        for (int i = 0; i < 8; ++i) { const h2_t hv = {(_Float16)(im[8 * e + i] * 0.015625f), (_Float16)(re[8 * e + i] * 0.015625f)}; XAT(w0, w1, 64 * e + 4096 * brev(i, 3)) = __builtin_bit_cast(unsigned, hv); } }
    asm volatile("s_waitcnt vmcnt(0)" ::: "memory");
    __syncthreads();
    } else {
    OPQ_T(); const int k1 = tid & 63, jg = tid >> 6;
    const float scA = invSA * (1024.0f / (float)FN), scB = -invSB * (1024.0f / (float)FN);
#pragma unroll
    for (int e = 0; e < 8; ++e)
#pragma unroll
        for (int i = 0; i < 8; i += 2) { const int tc = 64 * e + 4096 * brev(i, 3), tv = k1 + 512 * jg;
            (zA + tc)[tv] = (bf16)f2bf(re[8 * e + i] * scA + biasA * bf2f((uA + tc)[tv])); (zB + tc)[tv] = (bf16)f2bf(im[8 * e + i] * scB + biasB * bf2f((uB + tc)[tv])); }
    }
    asm volatile("" ::: "memory"); __builtin_amdgcn_sched_barrier(0);
    }
#undef OPQ_T
}
__device__ __forceinline__ void conv_unit(int pair, const bf16* Gr, const bf16* uT, const float* fsum, const float* hbias, bf16* zT, const float* twa, unsigned* scr, char* shm, int wid) {
    const int lane = fresh_lane(), tid = wid * 64 + lane; LAS float* X = (LAS float*)shm; LAS float* SC = (LAS float*)(shm + LDS_SC);
    const int cX = 2 * pair;
    if (wid < 2) { const int c = cX + wid; float s = 0.f; for (int b = lane; b < 256; b += 64) s += fsum[b * 1024 + c] + fsum[b * 1024 + 512 + c]; s = wave_sum(s); if (lane == 0) SC[wid] = 1.0f / s; }
    __syncthreads();
    conv_pair(Gr + (size_t)cX * NG, Gr + (size_t)(cX + 1) * NG, uT + (size_t)cX * L, uT + (size_t)(cX + 1) * L, zT + (size_t)cX * L, zT + (size_t)(cX + 1) * L, SC[0], SC[1], hbias[cX], hbias[cX + 1], twa, scr, X, tid);
    __syncthreads();
}
}

#define XB_TMO      128
#define XB_XCNT(j)  (256  + 64 * (j))
#define XB_XSUB(j)  (1280 + 64 * (j))
#define XB_XGEN(j)  (2304 + 64 * (j))
#define XB_TOP      3328
#define XB_TOPGEN   3392
#define XCD_BAR_WORDS 3456
#define XB_SPIN_CAP (1u << 18)
__device__ __forceinline__ unsigned xb_ld(unsigned* p)              { return __hip_atomic_load(p, __ATOMIC_RELAXED, __HIP_MEMORY_SCOPE_AGENT); }
__device__ __forceinline__ unsigned xb_add(unsigned* p, unsigned v) { return __hip_atomic_fetch_add(p, v, __ATOMIC_RELAXED, __HIP_MEMORY_SCOPE_AGENT); }
__device__ __forceinline__ unsigned xb_xcc_id() { return (unsigned)__builtin_amdgcn_s_getreg((3 << 11) | 20) & 0xFu; }
#define XB_SPIN(cond, bar) do { unsigned _sp = 0; while (cond) { __builtin_amdgcn_s_sleep(1); \
    if ((++_sp & 255u) == 0u) { if (xb_ld(&(bar)[XB_TMO])) break; if (_sp > XB_SPIN_CAP) { atomicAdd(&(bar)[XB_TMO], 1u); break; } } } } while (0)
struct XcdBarrier { unsigned* bar; unsigned x; volatile LAS unsigned* st; };
__device__ __forceinline__ XcdBarrier xcd_barrier_post(unsigned* bar, volatile LAS unsigned* st) {
    XcdBarrier b; b.bar = bar; b.x = xb_xcc_id(); b.st = st;
    if (threadIdx.x == 0) (void)xb_add(&bar[XB_XCNT(b.x)], 1u);
    return b;
}
__device__ __forceinline__ void xcd_barrier_complete(unsigned* bar, unsigned x, unsigned& nloc, unsigned& nx) {
    const unsigned G = gridDim.x * gridDim.y * gridDim.z;
    unsigned sum, cnt, mine, sp = 0u;
    for (;;) {
        sum = 0u; cnt = 0u; mine = 0u;
#pragma unroll
        for (unsigned j = 0; j < 16; ++j) { const unsigned c = xb_ld(&bar[XB_XCNT(j)]); sum += c; cnt += (c > 0u) ? 1u : 0u; mine = (j == x) ? c : mine; }
        if (sum == G) break;
        __builtin_amdgcn_s_sleep(1);
        if ((++sp & 255u) == 0u) { if (xb_ld(&bar[XB_TMO])) break; if (sp > XB_SPIN_CAP) { atomicAdd(&bar[XB_TMO], 1u); break; } }
    }
    nloc = mine > 0u ? mine : 1u; nx = cnt > 0u ? cnt : 1u;
}
__device__ __forceinline__ void xcd_barrier(const XcdBarrier& b) {
    asm volatile("s_waitcnt vmcnt(0)" ::: "memory");
    __syncthreads();
    if (threadIdx.x == 0) {
        unsigned* bar = b.bar;
        __builtin_amdgcn_s_waitcnt(0);
        unsigned nloc = b.st[0], nx = b.st[1];
        if (nloc == 0u) { xcd_barrier_complete(bar, b.x, nloc, nx); b.st[0] = nloc; b.st[1] = nx; }
        const unsigned old = xb_add(&bar[XB_XSUB(b.x)], 1u);
        const unsigned gen = old / nloc;
        if (old + 1u == (gen + 1u) * nloc) {
            __builtin_amdgcn_fence(__ATOMIC_RELEASE, "agent");
            asm volatile("s_waitcnt vmcnt(0)" ::: "memory");
            const unsigned og = xb_add(&bar[XB_TOP], 1u);
            const unsigned tg = og / nx;
            if (og + 1u == (tg + 1u) * nx) xb_add(&bar[XB_TOPGEN], 1u);
            else XB_SPIN(xb_ld(&bar[XB_TOPGEN]) == tg, bar);
            __builtin_amdgcn_fence(__ATOMIC_ACQUIRE, "agent");
            xb_add(&bar[XB_XGEN(b.x)], 1u);
            asm volatile("s_waitcnt vmcnt(0)" ::: "memory");
        } else {
            XB_SPIN(xb_ld(&bar[XB_XGEN(b.x)]) == gen, bar);
            __builtin_amdgcn_fence(__ATOMIC_ACQUIRE, "agent");
            asm volatile("s_waitcnt vmcnt(0)" ::: "memory");
        }
    }
    __syncthreads();
}

constexpr int LDS_BYTES = 135168;
__global__ void __launch_bounds__(512, 2) mk(Args args) {
    extern __shared__ __attribute__((aligned(16))) unsigned char lds[];
    Frame F; F.ws = args.ws; F.lds = (LAS unsigned char*)lds;
    F.tid = threadIdx.x; F.lane = F.tid & 63; F.wave = __builtin_amdgcn_readfirstlane(F.tid >> 6);
    F.G = gridDim.x; { const int bx = blockIdx.x; F.vcu = (F.G % 8 == 0) ? (bx % 8) * (F.G / 8) + bx / 8 : bx; }
    F.gw = F.vcu * 8 + F.wave; F.NGW = F.G * 8;
    const int lo = args.ph_lo, hi = args.ph_hi;
    { volatile LAS unsigned* mz = (volatile LAS unsigned*)(F.lds + 133120); if (F.tid < 16) mz[F.tid] = 0u; }
    __syncthreads();
    XcdBarrier bar; bar.bar = (unsigned*)(F.ws + WS_CTL) + args.li * 4096; bar.x = 0; bar.st = nullptr;
    if (hi - lo > 1) bar = xcd_barrier_post((unsigned*)(F.ws + WS_CTL) + args.li * 4096, (volatile LAS unsigned*)(F.lds + 133120));
#define SEAM(k) do { if (IN(k) && IN((k) + 1)) xcd_barrier(bar); } while (0)
#define SEAMX(k, j) do { if (IN(k) && IN(j)) xcd_barrier(bar); } while (0)
#ifndef PHMASK
#define PHMASK 0xffffff
#endif
#define IN(k) (((PHMASK >> (k)) & 1) && lo <= (k) && (k) < hi)
    if (IN(0)) { p0_mod(F, args); p0_weights(F, args, 0, P0W_IN, F.gw, F.NGW, false); }
    if (!(IN(0) && IN(1))) { SEAM(0); }
    if (IN(1)) { p0b_h1(F, args); }
    SEAM(1);
    if (IN(2)) { pg8::DenseOrder S; S.init((const bf16*)(F.ws + WS_H1), D, (const bf16*)(F.ws + WS_WIN), D, M, NIN, F.G, (int)blockIdx.x); pg8::EpiIn E{F.ws};
        pg8::gemm_phase<pg8::EpiIn, pg8::DenseOrder, false>(F.lds, D, S, E);
        { const int nlong = (int)(((long)(M / 256) * (NIN / 256)) % F.G); const bool all = (nlong == 0);
          if (all || (int)blockIdx.x >= nlong) { const int bi = all ? (int)blockIdx.x : (int)blockIdx.x - nlong, nb = all ? F.G : F.G - nlong;
              __syncthreads();
              p0_weights(F, args, P0W_IN, P0W_ALL, bi * 8 + F.wave, nb * 8, true); p0_filter(F, args, bi, nb); } } }
    SEAM(2);
    if (IN(3)) { p2_prep(F, args, (unsigned char*)args.out); }
    SEAM(3);
    if (IN(4)) {
#if !defined(PH4SEL) || PH4SEL == 0
        { pg8::DenseOrder S; S.init((const bf16*)(F.ws + WS_PROJL), PL, (const bf16*)(F.ws + WS_WUQ), QL, M, 768, F.G, (int)blockIdx.x); pg8::EpiQ E{F.ws, (bf16*)((unsigned char*)args.out + DO_Q)};
          pg8::gemm_phase<pg8::EpiQ, pg8::DenseOrder, false>(F.lds, QL, S, E); }
#endif
#if !defined(PH4SEL) || PH4SEL == 1
        { pg8::DenseOrder S; S.init((const bf16*)(F.ws + WS_PROJL) + 384, PL, (const bf16*)(F.ws + WS_WUKV), KVL, M, 1024, F.G, (int)blockIdx.x); pg8::EpiKV E{F.ws};
          pg8::gemm_phase<pg8::EpiKV, pg8::DenseOrder, false>(F.lds, KVL, S, E); }
#endif
    }
    SEAM(4);
    if (IN(5)) {
        const bf16* Q = (const bf16*)((unsigned char*)args.out + DO_Q); const bf16* Kb = (const bf16*)(F.ws + WS_K); const bf16* Vb = (const bf16*)(F.ws + WS_V); bf16* Y = (bf16*)(F.ws + WS_YCAT) + 512;
        for (int u = blockIdx.x; u < 512; u += F.G) { att2::attn_unit<8, true>(u & 7, u >> 3, Q, Kb, Vb, Y, (char*)lds);
            const int redo = __builtin_amdgcn_readfirstlane(*(volatile LAS int*)(lds + att2::LDS_FLAG)); __syncthreads();
            if (redo) att2::attn_unit<8, false>(u & 7, u >> 3, Q, Kb, Vb, Y, (char*)lds); }
#ifdef HFFT_TEST
        for (int u = blockIdx.x; u < 256; u += F.G) { bf16* z2 = (2 * u < 256) ? (bf16*)(F.ws + 44 * MiB) : (bf16*)(F.ws + 152 * MiB) - (size_t)256 * L;
            hfft::conv_unit(u, (const bf16*)(F.ws + WS_GR), (const bf16*)((unsigned char*)args.out + DO_UT), (const float*)(F.ws + WS_FSUM), args.in[I_HBIAS], z2, (const float*)(F.ws + WS_TWA), (unsigned*)(F.ws + WS_FSCR) + (size_t)blockIdx.x * 32768, (char*)lds, F.wave); }
#endif
#ifndef HFFT_TEST
#ifdef CONV_REPS
        _Pragma("nounroll") for (int rep_ = 0; rep_ < CONV_REPS; ++rep_)
#endif
        for (int u = blockIdx.x; u < 256; u += F.G) hfft::conv_unit(u, (const bf16*)(F.ws + WS_GR), (const bf16*)((unsigned char*)args.out + DO_UT), (const float*)(F.ws + WS_FSUM), args.in[I_HBIAS], (bf16*)(F.ws + WS_ZT), (const float*)(F.ws + WS_TWA), (unsigned*)(F.ws + WS_FSCR) + (size_t)blockIdx.x * 32768, (char*)lds, F.wave);
#else
        for (int u = blockIdx.x; u < 256; u += F.G) toep::toep_unit(u, (const bf16*)(F.ws + WS_GR), (const bf16*)((unsigned char*)args.out + DO_UT), (const float*)(F.ws + WS_FSUM), args.in[I_HBIAS], (bf16*)(F.ws + WS_ZT), (char*)lds);
#endif
#ifdef HFFT_TEST
        asm volatile("s_waitcnt vmcnt(0)" ::: "memory"); __syncthreads();
        for (int u = blockIdx.x; u < 256; u += F.G) { const bf16* za = (const bf16*)(F.ws + WS_ZT) + (size_t)(2 * u) * L; const bf16* zb = ((2 * u < 256) ? (const bf16*)(F.ws + 44 * MiB) : (const bf16*)(F.ws + 152 * MiB) - (size_t)256 * L) + (size_t)(2 * u) * L; float num = 0.f, den = 0.f;
            for (int i = F.tid; i < 2 * L; i += 512) { const float a = bf2f(za[i]), b = bf2f(zb[i]); num += (a - b) * (a - b); den += a * a; }
            num = wave_sum(num); den = wave_sum(den);
            if (F.lane == 0) { atomicAdd((float*)(F.ws + WS_CTL + 60000), num); atomicAdd((float*)(F.ws + WS_CTL + 60004), den); } }
#endif
    }
    SEAM(5);
    if (IN(6)) { p5_post(F, (unsigned char*)args.out); }
    SEAM(6);
    if (IN(7)) { pg8::DenseOrder S; S.init((const bf16*)(F.ws + WS_YCAT), D, (const bf16*)(F.ws + WS_WCAT), D, M, D, F.G, (int)blockIdx.x); pg8::EpiMix E{F.ws};
        pg8::gemm_phase<pg8::EpiMix, pg8::DenseOrder, false, true>(F.lds, D, S, E); }
    SEAMX(7, 9);
    if (IN(9)) { pg8::DenseOrder S; S.init((const bf16*)(F.ws + WS_MIX), D, (const bf16*)(F.ws + WS_WMIX), D, M, D, F.G, (int)blockIdx.x); pg8::EpiX1 E{F.ws, args.in[I_X], (bf16*)(F.ws + WS_X1B)};
        pg8::gemm_phase<pg8::EpiX1, pg8::DenseOrder, false>(F.lds, D, S, E); }
    SEAM(9);
    if (IN(10)) { p8_route(F, args, (const bf16*)(F.ws + WS_X1B)); }
      if (!(IN(10) && IN(11))) { SEAM(10); }
    if (IN(11)) { p8b_slots(F); }
    SEAM(11);
    if (IN(12)) { LAS int* lo = (LAS int*)(F.lds + 132096); moe_offsets(F, lo, 0);
        pg8::MoeOrder S{(const bf16*)(F.ws + WS_H2), (const bf16*)(F.ws + WS_WE), (const int*)(F.ws + WS_STOK), lo, D, D, 2, F.G, (int)blockIdx.x, 0}; pg8::EpiAct E{F.ws};
        pg8::gemm_phase<pg8::EpiAct, pg8::MoeOrder, true>(F.lds, D, S, E); }
    SEAM(12);
    if (IN(13)) { LAS int* lo = (LAS int*)(F.lds + 132096); moe_offsets(F, lo, 0);
        pg8::MoeOrder S{(const bf16*)(F.ws + WS_ACT), (const bf16*)(F.ws + WS_WE), nullptr, lo, DEXP, DEXP, 4, F.G, (int)blockIdx.x, (size_t)512 * 1024}; pg8::EpiY E{F.ws};
        pg8::gemm_phase<pg8::EpiY, pg8::MoeOrder, false>(F.lds, DEXP, S, E); }
    SEAM(13);
    if (IN(14)) { p11_final(F, args, args.out); }
#undef IN
}

enum { E_IN = 0, E_Q, E_KV, E_M1, E_M2, E_X1, E_ACT, E_Y };
struct NG_ { const bf16* A; int lda; const bf16* BT; int ldb; int K; int N; unsigned char* ws; unsigned char* dout; const float* x; };
__device__ __forceinline__ float ndot(const bf16* a, const bf16* b, int K) { float s = 0.f; for (int k = 0; k < K; k += 2) { const unsigned wa = *(const unsigned*)(a + k), wb = *(const unsigned*)(b + k); s += bflo(wa) * bflo(wb) + bfhi(wa) * bfhi(wb); } return s; }
template <int MODE> __global__ void __launch_bounds__(256) k_ngemm(NG_ p) {
    const int col = blockIdx.x * 256 + threadIdx.x, row = blockIdx.y; if (col >= p.N) return;
    unsigned char* ws = p.ws; const float* mod = (const float*)(ws + WS_MOD);
    if (MODE == E_IN) { const float acc = ndot(p.A + (size_t)row * p.lda, p.BT + (size_t)col * p.ldb, p.K);
        if (col < 1536) ((bf16*)(ws + WS_PROJH))[(size_t)row * 1536 + col] = (bf16)f2bf(acc);
        else if (col < 2304) ((bf16*)(ws + WS_PROJL))[(size_t)row * PL + col - 1536] = (bf16)f2bf(acc);
        else ((bf16*)(ws + WS_GATES))[(size_t)row * 2048 + col - 2304] = (bf16)f2bf(sigmoidf_(acc)); }
    if (MODE == E_Q) { const int h = col / 96, d = col % 96; const float sc = C2 * ((const float*)(ws + WS_RSQ))[row]; const float* ct = (const float*)(ws + WS_ROPE); const float* st = ct + L * 16;
        float acc = ndot(p.A + (size_t)row * p.lda, p.BT + (size_t)col * p.ldb, p.K), o = acc;
        if (d >= 64) { const int i = (d - 64) & 15; const int pc = h * 96 + (d < 80 ? d + 16 : d - 16); const float other = ndot(p.A + (size_t)row * p.lda, p.BT + (size_t)pc * p.ldb, p.K);
            const float cs = ct[row * 16 + i], sn = st[row * 16 + i]; o = d < 80 ? acc * cs - other * sn : other * sn + acc * cs; }
        ((bf16*)(p.dout + DO_Q))[(size_t)row * 768 + col] = (bf16)f2bf(o * sc); }
    if (MODE == E_KV) { const float acc = ndot(p.A + (size_t)row * p.lda, p.BT + (size_t)col * p.ldb, p.K) * ((const float*)(ws + WS_RSKV))[row];
        if (col < 512) ((bf16*)(ws + WS_K))[(size_t)row * 768 + (col >> 6) * 96 + (col & 63)] = (bf16)f2bf(acc); else ((bf16*)(ws + WS_V))[(size_t)row * 512 + col - 512] = (bf16)f2bf(acc); }
    if (MODE == E_M1) { const float acc = ndot(p.A + (size_t)row * p.lda, p.BT + (size_t)col * p.ldb, p.K);
        ((float*)p.dout)[(size_t)row * D + col] = acc * bf2f(((const bf16*)(ws + WS_GATES))[(size_t)row * 2048 + col]); }
    if (MODE == E_M2) { const float acc = ndot(p.A + (size_t)row * p.lda, p.BT + (size_t)col * p.ldb, p.K);
        ((bf16*)(ws + WS_MIX))[(size_t)row * D + col] = (bf16)f2bf(((const float*)p.dout)[(size_t)row * D + col] + acc * bf2f(((const bf16*)(ws + WS_GATES))[(size_t)row * 2048 + 1024 + col])); }
    if (MODE == E_X1) { const float acc = ndot(p.A + (size_t)row * p.lda, p.BT + (size_t)col * p.ldb, p.K);
        ((float*)p.dout)[(size_t)row * D + col] = p.x[(size_t)row * D + col] + mod[2048 + col] * acc; }
    if (MODE == E_ACT || MODE == E_Y) {
        __shared__ int lo[33];
        if (threadIdx.x == 0) { const int* bcnt = (const int*)(ws + WS_BCNT); int o = 0; for (int e = 0; e < 32; ++e) { int tot = 0; for (int b = 0; b < 256; ++b) tot += bcnt[b * 32 + e]; lo[e] = o; o += (tot + 255) & ~255; } lo[32] = o; }
        __syncthreads();
        if (row >= lo[32]) return; int e = 0; while (row >= lo[e + 1]) ++e;
        const bf16* WE = (const bf16*)(ws + WS_WE) + (size_t)e * (512 * 1024 + 1024 * 256);
        if (MODE == E_ACT) { const int tok = ((const int*)(ws + WS_STOK))[row]; const bf16* a = (const bf16*)(ws + WS_H2) + (size_t)tok * D; const int gr = 32 * (col >> 4) + (col & 15);
            const float g = ndot(a, WE + (size_t)gr * D, D), u = ndot(a, WE + (size_t)(gr + 16) * D, D);
            ((bf16*)(ws + WS_ACT))[(size_t)row * DEXP + col] = (bf16)f2bf(siluf_(g) * u); }
        else { const float acc = ndot((const bf16*)(ws + WS_ACT) + (size_t)row * DEXP, WE + 512 * 1024 + (size_t)col * DEXP, DEXP);
            ((bf16*)(ws + WS_Y))[(size_t)row * D + col] = (bf16)f2bf(acc * ((const float*)(ws + WS_SW))[row]); }
    }
}

__global__ void __launch_bounds__(256) k_nattn(const bf16* Q, const bf16* K, const bf16* V, bf16* ycat) {
    const int t = blockIdx.x * 256 + threadIdx.x, h = blockIdx.y;
    float q[96]; { const bf16* qp = Q + (size_t)t * 768 + h * 96; for (int d = 0; d < 96; ++d) q[d] = bf2f(qp[d]); }
    float o[64]; for (int d = 0; d < 64; ++d) o[d] = 0.f; float m = -INFINITY, l = 0.f;
    for (int j = 0; j < L; ++j) { const unsigned* kp = (const unsigned*)(K + (size_t)j * 768 + h * 96); float s = 0.f;
#pragma unroll
        for (int d = 0; d < 48; ++d) { const unsigned w = kp[d]; s += q[2 * d] * bflo(w) + q[2 * d + 1] * bfhi(w); }
        const float mn = fmaxf(m, s), al = exp2f(m - mn), p = exp2f(s - mn); l = l * al + p; m = mn;
        const unsigned* vp = (const unsigned*)(V + (size_t)j * 512 + h * 64);
#pragma unroll
        for (int d = 0; d < 32; ++d) { const unsigned w = vp[d]; o[2 * d] = o[2 * d] * al + p * bflo(w); o[2 * d + 1] = o[2 * d + 1] * al + p * bfhi(w); } }
    const float il = 1.f / l; bf16* op = ycat + (size_t)t * D + 512 + h * 64; for (int d = 0; d < 64; ++d) op[d] = (bf16)f2bf(o[d] * il);
}
__global__ void __launch_bounds__(256) k_ntoep(const bf16* Gr, const bf16* uT, const float* fsum, const float* hbias, bf16* zT) {
    const int t = blockIdx.x * 256 + threadIdx.x, c = blockIdx.y; const bf16* g = Gr + (size_t)c * NG; const bf16* u = uT + (size_t)c * L;
    float S = 0.f; for (int b = 0; b < 256; ++b) S += fsum[b * 1024 + c] + fsum[b * 1024 + 512 + c];
    float acc = 0.f; for (int s = 0; s < L; ++s) acc += bf2f(u[s]) * bf2f(g[LAGMAX - (t - s)]);
    zT[(size_t)c * L + t] = (bf16)f2bf(acc / S + hbias[c] * bf2f(u[t]));
}

extern "C" void kernel_launch(void* const* d_in, const int* in_sizes, int n_in, void* d_out, int out_size, void* d_ws, size_t ws_size, hipStream_t stream) {
    static int grid = 0;
    if (grid == 0) {
        if (n_in != 33 || out_size != M * D || ws_size < 256 * MiB) { fprintf(stderr, "kernel_launch: unexpected shapes (n_in %d out %d ws %zu)\n", n_in, out_size, ws_size); grid = -1; return; }
        int dev = 0, cus = 0; hipGetDevice(&dev); hipDeviceGetAttribute(&cus, hipDeviceAttributeMultiprocessorCount, dev);
        hipFuncSetAttribute((const void*)mk, hipFuncAttributeMaxDynamicSharedMemorySize, LDS_BYTES);
        grid = cus > 0 ? cus : 256;
    }
    if (grid < 0) return;
    hipMemsetAsync((char*)d_ws + WS_CTL, 0, 64 * 1024, stream);
    Args a{}; for (int i = 0; i < 33; ++i) a.in[i] = (const float*)d_in[i]; a.out = (float*)d_out; a.ws = (unsigned char*)d_ws;
    int nl = 0; auto run = [&](int lo, int hi) { a.ph_lo = lo; a.ph_hi = hi; a.li = (nl++) & 3; hipLaunchKernelGGL(mk, dim3(grid), dim3(512), LDS_BYTES, stream, a); };
#ifdef MULTI
    for (int p = 0; p < 15; ++p) run(p, p + 1);
#elif defined(PROBE_A)
    run(0, PROBE_B); run(PROBE_A, 15);
#else
    run(0, 15);
#endif
}
```

```cpp
#include <hip/hip_runtime.h>
#include <cstdint>
#include <cstdio>
#include <cmath>

constexpr int D = 1024, L = 16384, M = L;
constexpr int HY = 512, NH = 8, QKD = 96, VH = 64, QL = 384, KVL = 256;
constexpr int NIN = 4352;
constexpr int PL = 768;
constexpr int NEXP = 32, DEXP = 256, NGRP = 4, EPG = 8;
constexpr float EPS = 1e-6f;
constexpr float C2 = 0.10206207261596575f * 1.4426950408889634f;
constexpr int LAGMAX = L + 1023;
constexpr int NG = 2 * L + 3072;
constexpr int MAXSLOT = 40960;

constexpr size_t MiB = 1u << 20;
constexpr size_t WS_CTL = 0;
constexpr size_t WS_MOD = 64 * 1024;
constexpr size_t WS_BCCNT = 57856;
constexpr size_t WS_MODCNT = 57600;
constexpr size_t WS_RSQ = 128 * 1024, WS_RSKV = 192 * 1024;
constexpr size_t WS_FSUM = 256 * 1024;
constexpr size_t WS_ROPE = 1280 * 1024;
constexpr size_t WS_WRT = 3328 * 1024;
constexpr size_t WS_TWA = 96 * 1024;
constexpr size_t WS_FSCR = 160 * MiB;
constexpr size_t WS_TOKE = 3584 * 1024;
constexpr size_t WS_TOKW = WS_TOKE + 128 * 1024;
constexpr size_t WS_TOKR = WS_TOKW + 128 * 1024;
constexpr size_t WS_TOKS = WS_TOKR + 128 * 1024;
constexpr size_t WS_BCNT = WS_TOKS + 128 * 1024;
constexpr size_t WS_STOK = WS_BCNT + 32 * 1024;
constexpr size_t WS_SW = WS_STOK + 160 * 1024;
constexpr size_t WS_WRH = WS_SW + 164 * 1024;
constexpr size_t WS_LOG = WS_SW + 160 * 1024;
static_assert(WS_SW + 160 * 1024 <= 6 * MiB, "misc region");
constexpr size_t WS_WB = 6 * MiB;
constexpr size_t WS_WIN = WS_WB;
constexpr size_t WS_WUQ = WS_WIN + (size_t)NIN * D * 2;
constexpr size_t WS_WUKV = WS_WUQ + 768 * 384 * 2;
constexpr size_t WS_WCAT = WS_WUKV + 1024 * 256 * 2;
constexpr size_t WS_WMIX = WS_WCAT + 1024 * 1024 * 2;
static_assert(WS_WMIX + 1024 * 1024 * 2 <= 20 * MiB, "WB region");
constexpr size_t WS_R1 = 20 * MiB;
constexpr size_t WS_R2 = 52 * MiB;
constexpr size_t WS_R3 = 88 * MiB;
constexpr size_t WS_R4 = 136 * MiB;
constexpr size_t WS_R5 = 192 * MiB;
constexpr size_t WS_H1 = WS_R1, WS_K = WS_R1, WS_H2 = WS_R1;
constexpr size_t WS_GR = WS_R2, WS_MIX = WS_R2;
constexpr size_t WS_PROJH = WS_R3, WS_V = WS_R3, WS_YCAT = WS_R3 + 16 * MiB;
constexpr size_t WS_PROJL = WS_R4, WS_ACT = WS_R4;
constexpr size_t WS_ZT_LO = 44 * MiB, DO_ZT_HI = 56 * MiB;
constexpr size_t WS_GATES = WS_R5, WS_WE = WS_R5;
constexpr size_t WS_X1B = 104 * MiB;
constexpr size_t WS_Y = 20 * MiB;
static_assert((size_t)512 * NG * 2 <= 36 * MiB, "Gr fits");
constexpr size_t DO_X0 = 0, DO_UT = 16 * MiB, DO_Q = 32 * MiB;

typedef unsigned short bf16;
typedef unsigned v4u __attribute__((ext_vector_type(4)));
typedef unsigned v2u __attribute__((ext_vector_type(2)));
typedef float f32x4 __attribute__((ext_vector_type(4)));
#define LAS __attribute__((address_space(3)))

__device__ __forceinline__ unsigned f2bf(float f) { unsigned u = __builtin_bit_cast(unsigned, f); return (u + 0x7fffu + ((u >> 16) & 1u)) >> 16; }
__device__ __forceinline__ float bf2f(unsigned b) { return __builtin_bit_cast(float, (b & 0xffffu) << 16); }
__device__ __forceinline__ unsigned pk2(float lo, float hi) { unsigned r; asm("v_cvt_pk_bf16_f32 %0, %1, %2" : "=v"(r) : "v"(lo), "v"(hi)); return r; }
__device__ __forceinline__ float bflo(unsigned w) { return __builtin_bit_cast(float, w << 16); }
__device__ __forceinline__ float bfhi(unsigned w) { return __builtin_bit_cast(float, w & 0xffff0000u); }
#define NTL(p) __builtin_nontemporal_load(p)
__device__ __forceinline__ float wave_sum(float v) {
#pragma unroll
    for (int o = 1; o < 64; o <<= 1) v += __shfl_xor(v, o);
    return v;
}
__device__ __forceinline__ float sigmoidf_(float v) { return __builtin_amdgcn_rcpf(1.f + __expf(-v)); }
__device__ __forceinline__ float siluf_(float v) { return v * __builtin_amdgcn_rcpf(1.f + __expf(-v)); }

__device__ __forceinline__ int fresh_lane() { int l; asm volatile("v_mbcnt_lo_u32_b32 %0, -1, 0\n\tv_mbcnt_hi_u32_b32 %0, -1, %0" : "=v"(l)); return l; }
struct Args { const float* in[33]; float* out; unsigned char* ws; int ph_lo, ph_hi, li, pad; };
enum { I_X = 0, I_C, I_ADAW, I_ADAB, I_NMG, I_WIN, I_HCW, I_HCB, I_FW1, I_FB1, I_FF1, I_FW2, I_FB2, I_FF2, I_FW3, I_HBIAS, I_QNG, I_KVNG, I_WUQ, I_WUK, I_WUV,
       I_WHY, I_WMLA, I_WMIX, I_NFG, I_WGRP, I_BGRP, I_WRT, I_BRT, I_WGATE, I_WUP, I_WDOWN, I_FNG };

struct Frame {
    unsigned char* ws; LAS unsigned char* lds;
    int tid, lane, wave, vcu, G, gw, NGW;
};

__device__ __forceinline__ void transpose_item(const float* srcA, const float* srcB, int ldw, const float* kscale, bf16* dst, int ldk, bool zero, LAS float* scr, int lane) {
    const float* s = (lane & 16) ? srcB + ((lane & 31) - 16) : srcA + (lane & 31);
    float tv[32];
#pragma unroll
    for (int i = 0; i < 32; ++i) { const int kk = 2 * i + (lane >> 5); tv[i] = zero ? 0.f : NTL(s + (size_t)kk * ldw); }
#pragma unroll
    for (int i = 0; i < 32; ++i) { const int kk = 2 * i + (lane >> 5); float v = tv[i]; if (kscale) v *= kscale[kk]; scr[kk * 33 + (lane & 31)] = v; }
    asm volatile("s_waitcnt lgkmcnt(0)" ::: "memory");
    const int c = lane & 7;
#pragma unroll
    for (int j = 0; j < 4; ++j) { const int n = (lane >> 3) + 8 * j; const LAS float* p = scr + (8 * c) * 33 + n;
        v4u o; o.x = pk2(p[0 * 33], p[1 * 33]); o.y = pk2(p[2 * 33], p[3 * 33]); o.z = pk2(p[4 * 33], p[5 * 33]); o.w = pk2(p[6 * 33], p[7 * 33]);
        *(v4u*)(dst + (size_t)n * ldk + 8 * c) = o; }
    asm volatile("s_waitcnt lgkmcnt(0)" ::: "memory");
}

constexpr int P0W_IN = (NIN / 32) * (D / 64), P0W_ALL = P0W_IN + (768 / 32) * (QL / 64) + (1024 / 32) * (KVL / 64) + 32 * 16 + 32 * 16;
__device__ __forceinline__ void p0_weights(Frame& F, const Args& A, int it_lo, int it_hi, int gw, int ngw, bool tables) {
    LAS float* scr = (LAS float*)(F.lds + F.wave * 8704);
    constexpr int I_IN = (NIN / 32) * (D / 64), I_UQ = (768 / 32) * (QL / 64), I_UKV = (1024 / 32) * (KVL / 64), I_CAT = 32 * 16, I_MIX = 32 * 16;
    for (int it = it_lo + gw; it < it_hi; it += ngw) {
        int r = it; const float* s; int ldw; const float* ksc = nullptr; bf16* dst; int ldk; bool pad = false;
        if (r < I_IN) { const int nb = r % (NIN / 32), kb = r / (NIN / 32), n0 = nb * 32, k0 = kb * 64; pad = (n0 >= 2208 && n0 < 2304); const int sc = n0 < 2208 ? n0 : n0 - 96;
            s = A.in[I_WIN] + (size_t)k0 * 4256 + (pad ? 0 : sc); ldw = 4256; dst = (bf16*)(F.ws + WS_WIN) + (size_t)n0 * D + k0; ldk = D; }
        else if ((r -= I_IN) < I_UQ) { const int nb = r % 24, kb = r / 24, n0 = nb * 32, k0 = kb * 64; s = A.in[I_WUQ] + (size_t)k0 * 768 + n0; ldw = 768; ksc = A.in[I_QNG] + k0;
            dst = (bf16*)(F.ws + WS_WUQ) + (size_t)n0 * QL + k0; ldk = QL; }
        else if ((r -= I_UQ) < I_UKV) { const int nb = r % 32, kb = r / 32, n0 = nb * 32, k0 = kb * 64; s = (n0 < 512 ? A.in[I_WUK] + n0 : A.in[I_WUV] + (n0 - 512)) + (size_t)k0 * 512; ldw = 512; ksc = A.in[I_KVNG] + k0;
            dst = (bf16*)(F.ws + WS_WUKV) + (size_t)n0 * KVL + k0; ldk = KVL; }
        else if ((r -= I_UKV) < I_CAT) { const int nb = r % 32, kb = r / 32, n0 = nb * 32, k0 = kb * 64; s = (kb < 8 ? A.in[I_WHY] + (size_t)k0 * D : A.in[I_WMLA] + (size_t)(k0 - 512) * D) + n0; ldw = D;
            dst = (bf16*)(F.ws + WS_WCAT) + (size_t)n0 * D + k0; ldk = D; }
        else { r -= I_CAT; const int nb = r % 32, kb = r / 32, n0 = nb * 32, k0 = kb * 64; s = A.in[I_WMIX] + (size_t)k0 * D + n0; ldw = D; dst = (bf16*)(F.ws + WS_WMIX) + (size_t)n0 * D + k0; ldk = D; }
        transpose_item(s, s + 16, ldw, ksc, dst, ldk, pad, scr, F.lane);
    }
    if (!tables) return;
    float* wrt = (float*)(F.ws + WS_WRT);
    for (int i = gw * 64 + F.lane; i < 36 * 1024; i += ngw * 64) { const int o = i >> 10, k = i & 1023; wrt[i] = o < 4 ? A.in[I_WGRP][k * 4 + o] : A.in[I_WRT][k * 32 + (o - 4)]; }
    { bf16* wrh = (bf16*)(F.ws + WS_WRH); bf16* wrl = wrh + 48 * 1024;
      for (int i = gw * 64 + F.lane; i < 48 * 1024; i += ngw * 64) { const int o = i >> 10, k = i & 1023; const float w = o < 4 ? A.in[I_WGRP][k * 4 + o] : (o < 36 ? A.in[I_WRT][k * 32 + (o - 4)] : 0.f);
          const unsigned hi = f2bf(w); wrh[i] = (bf16)hi; wrl[i] = (bf16)f2bf(w - bf2f(hi)); } }
    { float* tw = (float*)(F.ws + WS_TWA); for (int i = gw * 64 + F.lane; i < 512; i += ngw * 64) { const float xr = -(float)i * (1.0f / 16384.0f); tw[2 * i] = cospif(xr); tw[2 * i + 1] = sinpif(xr); } }
    float* ct = (float*)(F.ws + WS_ROPE); float* st = ct + L * 16;
    const double inv = pow(10000.0, -(double)(F.lane & 15) / 16.0);
    for (int i = gw * 64 + F.lane; i < L * 16; i += ngw * 64) { const int pos = i >> 4; const double ang = (double)pos * inv;
        const double q = rint(ang * 0.15915494309189535); double r = fma(-q, 6.283185307179586232, ang); r = fma(-q, 2.4492935982947064e-16, r); const float rf = (float)r;
        ct[i] = cosf(rf); st[i] = sinf(rf); }
}

__device__ __forceinline__ void p0_mod(Frame& F, const Args& A) {
    LAS float* red = (LAS float*)(F.lds + 70000);
    for (int ob = blockIdx.x; ob < 256; ob += F.G) {
        const int j = F.tid & 31, kq = F.tid >> 5; float acc = 0.f;
        if (j < 24) { float cv[64], wv[64];
#pragma unroll
            for (int i = 0; i < 64; ++i) { const int k = kq + 16 * i; cv[i] = A.in[I_C][k]; wv[i] = NTL(A.in[I_ADAW] + (size_t)k * 6144 + ob * 24 + j); }
#pragma unroll
            for (int i = 0; i < 64; ++i) acc += siluf_(cv[i]) * wv[i]; }
        red[kq * 32 + j] = acc; __syncthreads();
        if (F.tid < 64) { if (F.tid < 24) { float s = A.in[I_ADAB][ob * 24 + F.tid]; for (int q = 0; q < 16; ++q) s += red[q * 32 + F.tid]; __hip_atomic_store((float*)(F.ws + WS_MOD) + ob * 24 + F.tid, s, __ATOMIC_RELAXED, __HIP_MEMORY_SCOPE_AGENT); }
            asm volatile("s_waitcnt vmcnt(0)" ::: "memory");
            if (F.tid == 0) __hip_atomic_fetch_add((unsigned*)(F.ws + WS_CTL + WS_MODCNT), 1u, __ATOMIC_RELAXED, __HIP_MEMORY_SCOPE_AGENT); }
        __syncthreads();
    }
}

__device__ __forceinline__ void p0_filter(Frame& F, const Args& A, int pb0, int npb) {
    typedef short bf16x8_ __attribute__((ext_vector_type(8))); typedef float f32x16_ __attribute__((ext_vector_type(16)));
    LAS float* Z = (LAS float*)(F.lds + 72192);
    LAS float* H1 = Z + 65 * 36;
    LAS bf16* H2B = (LAS bf16*)(H1 + 65 * 64);
    bf16* Gr = (bf16*)(F.ws + WS_GR);
    const int lane = F.lane, c32 = lane & 31, h = lane >> 5;
    LAS float* WL = (LAS float*)(F.lds);
    __syncthreads();
    for (int i = F.tid; i < 2112; i += 512) WL[i] = A.in[I_FW1][i];
    for (int i = F.tid; i < 4096; i += 512) WL[2112 + i] = A.in[I_FW2][i];
    if (F.tid < 64) { WL[6208 + F.tid] = A.in[I_FB1][F.tid]; WL[6272 + F.tid] = A.in[I_FB2][F.tid]; WL[6336 + F.tid] = A.in[I_FF1][F.tid]; WL[6400 + F.tid] = A.in[I_FF2][F.tid]; }
    __syncthreads();
    if (pb0 >= 256) return;
    bf16x8_ bfr[4][4];
#pragma unroll
    for (int dc = 0; dc < 4; ++dc) { const int dir = dc >> 1, c = 32 * (2 * F.wave + (dc & 1)) + c32;
#pragma unroll
        for (int ks = 0; ks < 4; ++ks) { const float* wp = A.in[I_FW3] + (size_t)(16 * ks + 8 * h) * 1024 + dir * 512 + c; float w[8];
#pragma unroll
            for (int jj = 0; jj < 8; ++jj) w[jj] = wp[jj * 1024];
            const v4u pk = (v4u){pk2(w[0], w[1]), pk2(w[2], w[3]), pk2(w[4], w[5]), pk2(w[6], w[7])}; bfr[dc][ks] = __builtin_bit_cast(bf16x8_, pk); } }
    for (int pb = pb0; pb < 256; pb += npb) {
        const int k0 = pb * 64;
        for (int i = F.tid; i < 65 * 33; i += 512) { const int kk = i / 33, f = i % 33, k = k0 + kk; float v;
            if (f == 0) v = (float)k / (float)(L - 1);
            else { const int bi = (f - 1) & 15; const float band = 1e-4f + (float)bi * ((15.0f - 1e-4f) / 15.0f); const float ang = 6.283185307179586f * band * (float)k / (float)L;
                   v = (f <= 16) ? cosf(ang) : -sinf(ang); }
            Z[kk * 36 + f] = v; }
        __syncthreads();
        { const int o = F.tid & 63, kq = F.tid >> 6; float w[33];
#pragma unroll
          for (int f = 0; f < 33; ++f) w[f] = WL[f * 64 + o];
          const float b = WL[6208 + o], fq = WL[6336 + o];
          for (int kk = kq; kk < 65; kk += 8) { float acc = b; const LAS f32x4* zr = (const LAS f32x4*)(Z + kk * 36);
#pragma unroll
              for (int f4 = 0; f4 < 8; ++f4) { const f32x4 zv = zr[f4]; acc += zv.x * w[4 * f4]; acc += zv.y * w[4 * f4 + 1]; acc += zv.z * w[4 * f4 + 2]; acc += zv.w * w[4 * f4 + 3]; }
              acc += Z[kk * 36 + 32] * w[32];
              H1[kk * 64 + o] = sinf(fq * acc); } }
        __syncthreads();
        { const int o = F.tid & 63, kq = F.tid >> 6; float w[64];
#pragma unroll
          for (int m = 0; m < 64; ++m) w[m] = WL[2112 + m * 64 + o];
          const float b = WL[6272 + o], fq = WL[6400 + o];
          for (int kk = kq; kk < 65; kk += 8) { float acc = b; const LAS f32x4* hr = (const LAS f32x4*)(H1 + kk * 64);
#pragma unroll
              for (int m4 = 0; m4 < 16; ++m4) { const f32x4 hv = hr[m4]; acc += hv.x * w[4 * m4]; acc += hv.y * w[4 * m4 + 1]; acc += hv.z * w[4 * m4 + 2]; acc += hv.w * w[4 * m4 + 3]; }
              H2B[kk * 72 + o] = (bf16)f2bf(sinf(fq * acc)); } }
        __syncthreads();
#pragma unroll
        for (int dc = 0; dc < 4; ++dc) { const int dir = dc >> 1, ct = 2 * F.wave + (dc & 1), c = 32 * ct + c32;
            const float adel = 3.0701134573253945f + (float)c * ((15.350567286626973f - 3.0701134573253945f) / 511.0f);
            float asum = 0.f; bf16* row = Gr + (size_t)c * NG;
#pragma unroll
            for (int rt = 0; rt < 2; ++rt) { f32x16_ acc = f32x16_{};
#pragma unroll
                for (int ks = 0; ks < 4; ++ks) { const bf16x8_ af = *(const LAS bf16x8_*)((LAS const char*)H2B + (32 * rt + c32 + dir) * 144 + 32 * ks + 16 * h);
                    acc = __builtin_amdgcn_mfma_f32_32x32x16_bf16(af, bfr[dc][ks], acc, 0, 0, 0); }
#pragma unroll
                for (int g4 = 0; g4 < 4; ++g4) { const int p = 32 * rt + 8 * g4 + 4 * h; float v[4];
#pragma unroll
                    for (int e = 0; e < 4; ++e) { const int k = k0 + p + e + dir; const float t = (float)k * (1.0f / (float)(L - 1)); float x = acc[4 * g4 + e] * (__expf(-t * adel) + 0.05f); if (k >= L) x = 0.f; v[e] = x; asum += fabsf(x); }
                    if (dir == 0) *(v2u*)(row + (LAGMAX - k0 - p - 3)) = (v2u){pk2(v[3], v[2]), pk2(v[1], v[0])};
                    else *(v2u*)(row + (LAGMAX + 1 + k0 + p)) = (v2u){pk2(v[0], v[1]), pk2(v[2], v[3])}; } }
            asum += __shfl_xor(asum, 32);
            if (h == 0) ((float*)(F.ws + WS_FSUM))[pb * 1024 + dir * 512 + c] = asum;
        }
        { bf16* row = Gr + (size_t)F.tid * NG; *(v2u*)(row + 4 * pb) = (v2u){0u, 0u}; *(v4u*)(row + 2 * L + 1024 + 8 * pb) = (v4u){0u, 0u, 0u, 0u}; }
        __syncthreads();
    }
}

__device__ __forceinline__ void p0b_h1(Frame& F, const Args& A) {
    const float* mod = (const float*)(F.ws + WS_MOD); bf16* h1 = (bf16*)(F.ws + WS_H1);
    if (F.tid == 0) { unsigned* p = (unsigned*)(F.ws + WS_CTL + WS_MODCNT); unsigned sp = 0; while (__hip_atomic_load(p, __ATOMIC_RELAXED, __HIP_MEMORY_SCOPE_AGENT) < 256u) { __builtin_amdgcn_s_sleep(2); if (++sp > (1u << 22)) break; } }
    __syncthreads();
    f32x4 gm[4], sh[4];
#pragma unroll
    for (int j = 0; j < 4; ++j) { const int c0 = 4 * F.lane + 256 * j; const f32x4 g = *(const f32x4*)(A.in[I_NMG] + c0), sc = *(const f32x4*)(mod + 1024 + c0); gm[j] = g * (sc + 1.0f); sh[j] = *(const f32x4*)(mod + c0); }
    for (int m = F.gw; m < M; m += F.NGW) {
        const f32x4* xr = (const f32x4*)(A.in[I_X] + (size_t)m * D) + F.lane; f32x4 v[4]; float s = 0.f;
#pragma unroll
        for (int j = 0; j < 4; ++j) { v[j] = NTL(xr + 64 * j); s += (v[j].x * v[j].x + v[j].y * v[j].y) + (v[j].z * v[j].z + v[j].w * v[j].w); }
        const float rstd = 1.0f / sqrtf(wave_sum(s) * (1.f / D) + EPS);
        v2u* o = (v2u*)(h1 + (size_t)m * D) + F.lane;
#pragma unroll
        for (int j = 0; j < 4; ++j) { const f32x4 y = v[j] * rstd * gm[j] + sh[j]; o[64 * j] = (v2u){pk2(y.x, y.y), pk2(y.z, y.w)}; }
    }
}

__device__ __forceinline__ void p2_prep(Frame& F, const Args& A, unsigned char* dout) {
    const bf16* pH = (const bf16*)(F.ws + WS_PROJH); const bf16* pL = (const bf16*)(F.ws + WS_PROJL);
    bf16* x0 = (bf16*)(dout + DO_X0); bf16* uT = (bf16*)(dout + DO_UT); bf16* Kb = (bf16*)(F.ws + WS_K);
    {
        const int cp = F.tid & 255, th = F.tid >> 8, c = 2 * cp; const float* cw = A.in[I_HCW]; const float* cb = A.in[I_HCB];
        float w0[3][2], w1[3][2], w2[3][2], bb[3][2];
#pragma unroll
        for (int p = 0; p < 3; ++p)
#pragma unroll
            for (int e = 0; e < 2; ++e) { const int col = p * 512 + c + e; w0[p][e] = cw[col]; w1[p][e] = cw[1536 + col]; w2[p][e] = cw[3072 + col]; bb[p][e] = cb[col]; }
        for (int tb = blockIdx.x; tb < L / 64; tb += F.G) {
            const int t0 = tb * 64 + th * 32; unsigned pv[3], cu[3];
#pragma unroll
            for (int p = 0; p < 3; ++p) { pv[p] = t0 > 0 ? NTL((const unsigned*)(pH + (size_t)(t0 - 1) * 1536 + p * 512 + c)) : 0u; cu[p] = NTL((const unsigned*)(pH + (size_t)t0 * 1536 + p * 512 + c)); }
#pragma unroll 1
            for (int g8 = 0; g8 < 4; ++g8) { unsigned nx[8][3]; float ua[8], ub[8];
#pragma unroll
                for (int i = 0; i < 8; ++i) { const int t = t0 + g8 * 8 + i;
#pragma unroll
                    for (int p = 0; p < 3; ++p) nx[i][p] = (t + 1 < L) ? NTL((const unsigned*)(pH + (size_t)(t + 1) * 1536 + p * 512 + c)) : 0u; }
#pragma unroll
                for (int i = 0; i < 8; ++i) { const int t = t0 + g8 * 8 + i; float ha[3], hb[3];
#pragma unroll
                    for (int p = 0; p < 3; ++p) { ha[p] = w0[p][0] * bflo(pv[p]) + w1[p][0] * bflo(cu[p]) + w2[p][0] * bflo(nx[i][p]) + bb[p][0]; hb[p] = w0[p][1] * bfhi(pv[p]) + w1[p][1] * bfhi(cu[p]) + w2[p][1] * bfhi(nx[i][p]) + bb[p][1];
                        pv[p] = cu[p]; cu[p] = nx[i][p]; }
                    *(unsigned*)(x0 + (size_t)t * 512 + c) = pk2(ha[0], hb[0]); ua[i] = ha[2] * ha[1]; ub[i] = hb[2] * hb[1]; }
                *(v4u*)(uT + (size_t)c * L + t0 + g8 * 8) = (v4u){pk2(ua[0], ua[1]), pk2(ua[2], ua[3]), pk2(ua[4], ua[5]), pk2(ua[6], ua[7])};
                *(v4u*)(uT + (size_t)(c + 1) * L + t0 + g8 * 8) = (v4u){pk2(ub[0], ub[1]), pk2(ub[2], ub[3]), pk2(ub[4], ub[5]), pk2(ub[6], ub[7])}; }
        }
    }
    {
        float* rsq = (float*)(F.ws + WS_RSQ); float* rskv = (float*)(F.ws + WS_RSKV); const float* ct = (const float*)(F.ws + WS_ROPE); const float* st = ct + L * 16;
        constexpr int RB = 4; const int l2 = F.lane < 2 ? F.lane : 1;
        for (int m0 = F.gw; m0 < M; m0 += F.NGW * RB) {
            v4u a[RB], b[RB], xa[RB], xb[RB]; f32x4 c0[RB], c1[RB], n0[RB], n1[RB];
#pragma unroll
            for (int q = 0; q < RB; ++q) { const int m = (m0 + q * F.NGW < M) ? m0 + q * F.NGW : m0; const bf16* r = pL + (size_t)m * PL;
                a[q] = *(const v4u*)(r + 8 * F.lane); b[q] = *(const v4u*)(r + 512 + 8 * (F.lane & 15));
                xa[q] = *(const v4u*)(r + 640 + 8 * l2); xb[q] = *(const v4u*)(r + 656 + 8 * l2);
                c0[q] = *(const f32x4*)(ct + m * 16 + 8 * l2); c1[q] = *(const f32x4*)(ct + m * 16 + 8 * l2 + 4); n0[q] = *(const f32x4*)(st + m * 16 + 8 * l2); n1[q] = *(const f32x4*)(st + m * 16 + 8 * l2 + 4); }
            float s1[RB], s2[RB];
#pragma unroll
            for (int q = 0; q < RB; ++q) { float sa = 0.f, sb = 0.f;
                { const unsigned w[4] = {a[q].x, a[q].y, a[q].z, a[q].w};
#pragma unroll
                  for (int i = 0; i < 4; ++i) { const float lo = bflo(w[i]), hi = bfhi(w[i]); sa += lo * lo + hi * hi; } }
                { const unsigned w[4] = {b[q].x, b[q].y, b[q].z, b[q].w};
#pragma unroll
                  for (int i = 0; i < 4; ++i) { const float lo = bflo(w[i]), hi = bfhi(w[i]); sb += lo * lo + hi * hi; } }
                if (F.lane >= 16) sb = 0.f;
                s1[q] = F.lane < 48 ? sa : 0.f; s2[q] = (F.lane < 48 ? 0.f : sa) + sb; }
#pragma unroll
            for (int q = 0; q < RB; ++q) { s1[q] = wave_sum(s1[q]); s2[q] = wave_sum(s2[q]); }
#pragma unroll
            for (int q = 0; q < RB; ++q) { const int m = m0 + q * F.NGW; if (m < M) {
                if (F.lane == 0) { rsq[m] = 1.0f / sqrtf(s1[q] * (1.f / QL) + EPS); rskv[m] = 1.0f / sqrtf(s2[q] * (1.f / KVL) + EPS); }
                if (F.lane < 2) {
                    const float cs[8] = {c0[q].x, c0[q].y, c0[q].z, c0[q].w, c1[q].x, c1[q].y, c1[q].z, c1[q].w}, sn[8] = {n0[q].x, n0[q].y, n0[q].z, n0[q].w, n1[q].x, n1[q].y, n1[q].z, n1[q].w};
                    const unsigned wa[4] = {xa[q].x, xa[q].y, xa[q].z, xa[q].w}, wb[4] = {xb[q].x, xb[q].y, xb[q].z, xb[q].w}; unsigned o1[4], o2[4];
#pragma unroll
                    for (int i = 0; i < 4; ++i) { const float a0 = bflo(wa[i]), a1 = bfhi(wa[i]), b0 = bflo(wb[i]), b1 = bfhi(wb[i]);
                        o1[i] = pk2(a0 * cs[2 * i] - b0 * sn[2 * i], a1 * cs[2 * i + 1] - b1 * sn[2 * i + 1]); o2[i] = pk2(a0 * sn[2 * i] + b0 * cs[2 * i], a1 * sn[2 * i + 1] + b1 * cs[2 * i + 1]); }
#pragma unroll
                    for (int h = 0; h < NH; ++h) { *(v4u*)(Kb + (size_t)m * 768 + h * 96 + 64 + 8 * F.lane) = (v4u){o1[0], o1[1], o1[2], o1[3]}; *(v4u*)(Kb + (size_t)m * 768 + h * 96 + 80 + 8 * F.lane) = (v4u){o2[0], o2[1], o2[2], o2[3]}; } } } }
        }
    }
}

__device__ __forceinline__ void p5_post(Frame& F, unsigned char* dout) {
    const bf16* x0 = (const bf16*)(dout + DO_X0); bf16* yc = (bf16*)(F.ws + WS_YCAT);
    const int cp = F.tid & 255, th = F.tid >> 8, c = 2 * cp;
    const bf16* zT = (c < 256) ? (const bf16*)(F.ws + WS_ZT_LO) : (const bf16*)(dout + DO_ZT_HI) - (size_t)256 * L;
    for (int tb = blockIdx.x; tb < L / 64; tb += F.G) {
        const int t0 = tb * 64 + th * 32; const v4u* za = (const v4u*)(zT + (size_t)c * L + t0); const v4u* zb = (const v4u*)(zT + (size_t)(c + 1) * L + t0);
        v4u qa[4], qb[4]; unsigned xv[32];
#pragma unroll
        for (int g = 0; g < 4; ++g) { qa[g] = NTL(za + g); qb[g] = NTL(zb + g); }
#pragma unroll
        for (int i = 0; i < 32; ++i) xv[i] = NTL((const unsigned*)(x0 + (size_t)(t0 + i) * 512 + c));
#pragma unroll
        for (int g = 0; g < 4; ++g) { const unsigned wa[4] = {qa[g].x, qa[g].y, qa[g].z, qa[g].w}, wb[4] = {qb[g].x, qb[g].y, qb[g].z, qb[g].w};
#pragma unroll
            for (int i = 0; i < 8; ++i) { const int k = g * 8 + i; const float zva = (i & 1) ? bfhi(wa[i >> 1]) : bflo(wa[i >> 1]), zvb = (i & 1) ? bfhi(wb[i >> 1]) : bflo(wb[i >> 1]);
                *(unsigned*)(yc + (size_t)(t0 + k) * D + c) = pk2(bflo(xv[k]) * zva, bfhi(xv[k]) * zvb); } }
    }
}

__device__ __forceinline__ void p8_route(Frame& F, const Args& A, const bf16* x1) {
    const float* mod = (const float*)(F.ws + WS_MOD); bf16* h2 = (bf16*)(F.ws + WS_H2); const float* wrt = (const float*)(F.ws + WS_WRT);
    int* toke = (int*)(F.ws + WS_TOKE); float* tokw = (float*)(F.ws + WS_TOKW); int* tokr = (int*)(F.ws + WS_TOKR); int* bcnt = (int*)(F.ws + WS_BCNT);
    LAS int* le = (LAS int*)(F.lds + 90624);
    LAS int* lr = le + 128;
    f32x4 gm[4], sh[4];
#pragma unroll
    for (int j = 0; j < 4; ++j) { const int c0 = 4 * F.lane + 256 * j; const f32x4 g = *(const f32x4*)(A.in[I_NFG] + c0), sc = *(const f32x4*)(mod + 4096 + c0); gm[j] = g * (sc + 1.0f); sh[j] = *(const f32x4*)(mod + 3072 + c0); }
    for (int rb = blockIdx.x; rb < M / 64; rb += F.G) {
        typedef short bf16x8r __attribute__((ext_vector_type(8)));
        LAS bf16* VH = (LAS bf16*)F.lds;
        LAS float* PC = (LAS float*)(F.lds + 66048);
        const bf16* wrh = (const bf16*)(F.ws + WS_WRH); const bf16* wrl = wrh + 48 * 1024;
        for (int hb = 0; hb < 2; ++hb) {
            constexpr int RQ = 2;
            for (int rr0 = F.wave; rr0 < 32; rr0 += 8 * RQ) {
                f32x4 v[RQ][4]; float s[RQ]; int mrow[RQ];
#pragma unroll
                for (int q = 0; q < RQ; ++q) { const int m = rb * 64 + hb * 32 + rr0 + 8 * q; mrow[q] = m; const v2u* xr = (const v2u*)(x1 + (size_t)m * D) + F.lane; s[q] = 0.f;
#pragma unroll
                    for (int j = 0; j < 4; ++j) { const v2u xw = NTL(xr + 64 * j); v[q][j] = (f32x4){bflo(xw.x), bfhi(xw.x), bflo(xw.y), bfhi(xw.y)}; } }
#pragma unroll
                for (int q = 0; q < RQ; ++q)
#pragma unroll
                    for (int j = 0; j < 4; ++j) s[q] += (v[q][j].x * v[q][j].x + v[q][j].y * v[q][j].y) + (v[q][j].z * v[q][j].z + v[q][j].w * v[q][j].w);
#pragma unroll
                for (int q = 0; q < RQ; ++q) s[q] = wave_sum(s[q]);
#pragma unroll
                for (int q = 0; q < RQ; ++q) { const float rstd = 1.0f / sqrtf(s[q] * (1.f / D) + EPS); v2u* o = (v2u*)(h2 + (size_t)mrow[q] * D) + F.lane; LAS v2u* ol = (LAS v2u*)(VH + (rr0 + 8 * q) * 1032) + F.lane;
#pragma unroll
                    for (int j = 0; j < 4; ++j) { const f32x4 y = v[q][j] * rstd * gm[j] + sh[j]; const v2u w = (v2u){pk2(y.x, y.y), pk2(y.z, y.w)}; o[64 * j] = w; ol[64 * j] = w; } }
            }
            __syncthreads();
            { const int mt = F.wave & 1, kq = F.wave >> 1, fr = F.lane & 15, fq = F.lane >> 4; f32x4 acc[3];
#pragma unroll
              for (int nt = 0; nt < 3; ++nt) acc[nt] = (f32x4){0.f, 0.f, 0.f, 0.f};
              const LAS bf16* ap = VH + (mt * 16 + fr) * 1032 + kq * 256 + 8 * fq; const size_t bo = (size_t)fr * 1024 + kq * 256 + 8 * fq;
#pragma unroll
              for (int ks = 0; ks < 8; ++ks) { const bf16x8r a = *(const LAS bf16x8r*)(ap + ks * 32);
#pragma unroll
                  for (int nt = 0; nt < 3; ++nt) { const bf16x8r bh = *(const bf16x8r*)(wrh + bo + (size_t)nt * 16 * 1024 + ks * 32), bl = *(const bf16x8r*)(wrl + bo + (size_t)nt * 16 * 1024 + ks * 32);
                      acc[nt] = __builtin_amdgcn_mfma_f32_16x16x32_bf16(a, bh, acc[nt], 0, 0, 0); acc[nt] = __builtin_amdgcn_mfma_f32_16x16x32_bf16(a, bl, acc[nt], 0, 0, 0); } }
#pragma unroll
              for (int nt = 0; nt < 3; ++nt)
#pragma unroll
                  for (int i = 0; i < 4; ++i) PC[(kq * 32 + mt * 16 + 4 * fq + i) * 48 + nt * 16 + fr] = acc[nt][i]; }
            __syncthreads();
            { const int row = F.tid >> 4, c = F.tid & 15;
#pragma unroll
              for (int nt = 0; nt < 3; ++nt) { const int o = row * 48 + nt * 16 + c; PC[o] = (PC[o] + PC[32 * 48 + o]) + (PC[2 * 32 * 48 + o] + PC[3 * 32 * 48 + o]); } }
            __syncthreads();
            if (F.tid < 32) { const int row = F.tid, m = rb * 64 + hb * 32 + row, rr = hb * 32 + row; const LAS float* lg = PC + row * 48;
                float gl[4]; int gi = 0; float gmx = -INFINITY;
#pragma unroll
                for (int g = 0; g < 4; ++g) { gl[g] = lg[g] + A.in[I_BGRP][g]; if (gl[g] > gmx) { gmx = gl[g]; gi = g; } }
                float gs = 0.f;
#pragma unroll
                for (int g = 0; g < 4; ++g) gs += __expf(gl[g] - gmx);
                const float psel = 1.0f / gs;
                float ev[8];
#pragma unroll
                for (int e = 0; e < 8; ++e) ev[e] = lg[4 + gi * 8 + e] + A.in[I_BRT][gi * 8 + e];
                int i0 = 0; float v0 = ev[0];
#pragma unroll
                for (int e = 1; e < 8; ++e) if (ev[e] > v0) { v0 = ev[e]; i0 = e; }
                int i1 = -1; float v1 = -INFINITY;
#pragma unroll
                for (int e = 0; e < 8; ++e) if (e != i0 && ev[e] > v1) { v1 = ev[e]; i1 = e; }
                const float e1 = __expf(v1 - v0), w0 = psel / (1.f + e1), w1 = psel * e1 / (1.f + e1);
                toke[m * 2] = gi * 8 + i0; toke[m * 2 + 1] = gi * 8 + i1; tokw[m * 2] = w0; tokw[m * 2 + 1] = w1;
                le[rr * 2] = gi * 8 + i0; le[rr * 2 + 1] = gi * 8 + i1; }
            __syncthreads();
        }
        __syncthreads();
        if (F.tid < 160) { const bool rk = F.tid < 128; const int me = rk ? le[F.tid] : F.tid - 128, lim = rk ? F.tid : 128; int r = 0;
#pragma unroll 8
            for (int j4 = 0; j4 < 32; ++j4) { const v4u o = *(const LAS v4u*)(le + 4 * j4);
                r += (4 * j4 < lim && (int)o.x == me) + (4 * j4 + 1 < lim && (int)o.y == me) + (4 * j4 + 2 < lim && (int)o.z == me) + (4 * j4 + 3 < lim && (int)o.w == me); }
            if (rk) lr[F.tid] = r; else __hip_atomic_store(bcnt + rb * 32 + (F.tid - 128), r, __ATOMIC_RELAXED, __HIP_MEMORY_SCOPE_AGENT); }
        if (F.tid >= 128 && F.tid < 192) { asm volatile("s_waitcnt vmcnt(0)" ::: "memory");
            if (F.tid == 128) __hip_atomic_fetch_add((unsigned*)(F.ws + WS_CTL + WS_BCCNT), 1u, __ATOMIC_RELAXED, __HIP_MEMORY_SCOPE_AGENT); }
        __syncthreads();
        if (F.tid < 128) tokr[rb * 128 + F.tid] = lr[F.tid];
        __syncthreads();
    }
}
__device__ __forceinline__ void p8_convert(Frame& F, const Args& A, int which, int k_lo, int k_hi) {
    LAS float* scr = (LAS float*)(F.lds + F.wave * 8704);
    bf16* WE = (bf16*)(F.ws + WS_WE);
    constexpr int I1 = 16 * 16, I2 = 32 * 4;
    const int ipe = which ? I2 : I1;
    for (int k = k_lo; k < k_hi; ++k) { const int it = F.gw + k * F.NGW; if (it >= NEXP * ipe) break;
        const int e = it / ipe; int r = it % ipe; bf16* w1t = WE + (size_t)e * (512 * 1024 + 1024 * 256); bf16* w2t = w1t + 512 * 1024;
        const float* sa; const float* sb; int ldw; bf16* dst; int ldk;
        if (!which) { const int g = r % 16, kb = r / 16, k0 = kb * 64; sa = A.in[I_WGATE] + ((size_t)e * D + k0) * DEXP + 16 * g; sb = A.in[I_WUP] + ((size_t)e * D + k0) * DEXP + 16 * g; ldw = DEXP;
            dst = w1t + (size_t)(32 * g) * D + k0; ldk = D; }
        else { const int nb = r % 32, kb = r / 32, n0 = nb * 32, k0 = kb * 64; sa = A.in[I_WDOWN] + ((size_t)e * DEXP + k0) * D + n0; sb = sa + 16; ldw = D; dst = w2t + (size_t)n0 * DEXP + k0; ldk = DEXP; }
        transpose_item(sa, sb, ldw, nullptr, dst, ldk, false, scr, F.lane);
    }
}

__device__ __forceinline__ void moe_offsets(Frame& F, LAS int* lo, int blk) {
    const int* bcnt = (const int*)(F.ws + WS_BCNT);
    if (F.tid < 256) { const int e = F.tid & 31, ch = F.tid >> 5; int tot = 0, base = 0;
#pragma unroll 8
        for (int i = 0; i < 32; ++i) { const int b = ch * 32 + i; const int c = bcnt[b * 32 + e]; tot += c; base += (b < blk) ? c : 0; }
        tot += __shfl_xor(tot, 32); base += __shfl_xor(base, 32);
        if ((F.tid & 32) == 0) { lo[128 + (F.tid >> 6) * 32 + e] = tot; lo[(F.tid >> 6) * 32 + e] = base; } }
    __syncthreads();
    { int tot = 0, base = 0;
      if (F.tid < 32) { for (int w = 0; w < 4; ++w) { tot += lo[128 + w * 32 + F.tid]; base += lo[w * 32 + F.tid]; } }
      __syncthreads();
      if (F.tid < 32) { lo[80 + F.tid] = tot; lo[40 + F.tid] = base; } }
    __syncthreads();
    if (F.tid < 64) { const int e = F.tid & 31; const int val = (lo[80 + e] + 255) & ~255; int sc = val;
#pragma unroll
        for (int o = 1; o < 32; o <<= 1) { const int t = __shfl_up(sc, o); if (e >= o) sc += t; }
        if (F.tid < 32) { lo[e] = sc - val; if (e == 31) lo[32] = sc; } }
    __syncthreads();
}
__device__ __forceinline__ void p8b_slots(Frame& F) {
    LAS int* lo = (LAS int*)(F.lds + 70000);
    const int* toke = (const int*)(F.ws + WS_TOKE); const float* tokw = (const float*)(F.ws + WS_TOKW); const int* tokr = (const int*)(F.ws + WS_TOKR);
    int* toks = (int*)(F.ws + WS_TOKS); int* stok = (int*)(F.ws + WS_STOK); float* sw = (float*)(F.ws + WS_SW);
    if (F.tid == 0) { unsigned* p = (unsigned*)(F.ws + WS_CTL + WS_BCCNT); unsigned sp = 0; while (__hip_atomic_load(p, __ATOMIC_RELAXED, __HIP_MEMORY_SCOPE_AGENT) < (unsigned)(M / 64)) { __builtin_amdgcn_s_sleep(2); if (++sp > (1u << 22)) break; } }
    __syncthreads();
    for (int rb = blockIdx.x; rb < 256; rb += F.G) {
        moe_offsets(F, lo, rb);
        if (rb == 0) {
            int* logp = (int*)(F.ws + WS_LOG); if (F.tid < 33) logp[F.tid] = lo[F.tid];
            const int T = lo[32] >> 8, t = F.tid; bool full = false, hf = false; int rf = 0, rh = 0;
            if (t < 256) { int e = 0;
#pragma unroll 8
                for (int j = 1; j <= 32; ++j) e += (lo[j] <= t * 256) ? 1 : 0;
                if (t < T) { const int real = lo[e] + lo[80 + e] - t * 256; hf = real <= 128; full = !hf; }
                const unsigned long long mf = __ballot(full), mh = __ballot(hf), lt = (1ull << (t & 63)) - 1ull;
                rf = __popcll(mf & lt); rh = __popcll(mh & lt);
                if ((t & 63) == 0) { lo[500 + (t >> 6)] = __popcll(mf); lo[504 + (t >> 6)] = __popcll(mh); } }
            __syncthreads();
            if (t < T) { int bf = 0, bh = 0, nf = 0;
                for (int w = 0; w < 4; ++w) { const int cf = lo[500 + w], ch = lo[504 + w]; nf += cf; if (w < (t >> 6)) { bf += cf; bh += ch; } }
                logp[64 + (full ? bf + rf : nf + bh + rh)] = t | (hf ? 65536 : 0); }
            __syncthreads(); }
        if (F.tid < 128) { const int i = rb * 128 + F.tid, e = toke[i], slot = lo[e] + lo[40 + e] + tokr[i]; toks[i] = slot; stok[slot] = i >> 1; sw[slot] = tokw[i]; }
        if (rb < 32) { const int e = rb, beg = lo[e] + lo[80 + e], end = lo[e + 1]; for (int s = beg + F.tid; s < end; s += 512) { stok[s] = 0; sw[s] = 0.f; } }
        __syncthreads();
    }
}

__device__ __forceinline__ void p11_final(Frame& F, const Args& A, float* xo) {
#ifdef HFFT_TEST
    const float tnum_ = *(const float*)(F.ws + WS_CTL + 60000), tden_ = *(const float*)(F.ws + WS_CTL + 60004); const bool tbad_ = !(tnum_ <= HFFT_TOL * tden_);
#endif
    const float* mod = (const float*)(F.ws + WS_MOD); const bf16* y = (const bf16*)(F.ws + WS_Y); const int* toks = (const int*)(F.ws + WS_TOKS);
    f32x4 g2[4], fg[4];
#pragma unroll
    for (int j = 0; j < 4; ++j) { const int c0 = 4 * F.lane + 256 * j; g2[j] = *(const f32x4*)(mod + 5120 + c0); fg[j] = *(const f32x4*)(A.in[I_FNG] + c0); }
    for (int m = F.gw; m < M; m += F.NGW) {
        f32x4* xr = (f32x4*)(xo + (size_t)m * D) + F.lane; const v2u* x1r = (const v2u*)((const bf16*)(F.ws + WS_X1B) + (size_t)m * D) + F.lane; const int s0 = toks[m * 2], s1 = toks[m * 2 + 1];
        const v2u* y0 = (const v2u*)(y + (size_t)s0 * D) + F.lane; const v2u* y1 = (const v2u*)(y + (size_t)s1 * D) + F.lane; f32x4 v[4]; float s = 0.f;
#pragma unroll
        for (int j = 0; j < 4; ++j) { const v2u a = NTL(y0 + 64 * j), b = NTL(y1 + 64 * j); const f32x4 ys = (f32x4){bflo(a.x) + bflo(b.x), bfhi(a.x) + bfhi(b.x), bflo(a.y) + bflo(b.y), bfhi(a.y) + bfhi(b.y)};
            const v2u xw = NTL(x1r + 64 * j); v[j] = (f32x4){bflo(xw.x), bfhi(xw.x), bflo(xw.y), bfhi(xw.y)} + g2[j] * ys; s += (v[j].x * v[j].x + v[j].y * v[j].y) + (v[j].z * v[j].z + v[j].w * v[j].w); }
        const float rstd = 1.0f / sqrtf(wave_sum(s) * (1.f / D) + EPS);
#pragma unroll
        for (int j = 0; j < 4; ++j) { f32x4 ov = v[j] * rstd * fg[j];
#ifdef HFFT_TEST
            if (tbad_) ov = (f32x4){__builtin_nanf(""), 0.f, 0.f, 0.f};
#endif
            __builtin_nontemporal_store(ov, xr + 64 * j); }
    }
}


struct XcdBarrier; __device__ __forceinline__ void xcd_wait(const XcdBarrier& b);
#define PG8_LATE_WAIT(bw, wf) do { if (__builtin_amdgcn_readfirstlane(*(wf))) { xcd_wait(*(bw)); if (threadIdx.x == 0) *(wf) = 0u; __syncthreads(); } } while (0)
namespace pg8 {
typedef short bf16x8 __attribute__((ext_vector_type(8)));
constexpr int BM = 256, BK = 64, HALF = 128, HTB = HALF * BK * 2, STAGE_BYTES = 8 * HTB, NXCD = 8, WGM = 8;
__host__ __device__ __forceinline__ int lds_byte(int r, int c) { const int st = (r >> 4) * 2 + (c >> 5), rr = r & 15, cc = c & 31, ob = rr * 64 + cc * 2; return st * 1024 + (ob ^ (((ob >> 9) & 1) << 5)); }
__host__ __device__ __forceinline__ void stage_rc(int b, int& R, int& C) { const int st = b / 1024, sb = b % 1024, swz = sb ^ (((sb >> 9) & 1) << 5); R = (st >> 1) * 16 + swz / 64; C = (st & 1) * 32 + (swz % 64) / 2; }
__host__ __device__ __forceinline__ int perm32(int rho) { const int n = rho >> 4, i = rho & 15; return 8 * (i >> 2) + 4 * n + (i & 3); }
struct Unit { int pm, pn, e, half; };
__device__ __forceinline__ unsigned cvt_pk_bf16(float lo, float hi) { unsigned r; asm volatile("v_cvt_pk_bf16_f32 %0, %1, %2" : "=v"(r) : "v"(lo), "v"(hi)); return r; }

struct DenseOrder {
    const bf16* A; const bf16* Bt; int lda, ldb; int nM, nN, nwg, G, c;
    __device__ void init(const bf16* A_, int lda_, const bf16* Bt_, int ldb_, int Mrows, int N, int G_, int c_) { A = A_; Bt = Bt_; lda = lda_; ldb = ldb_; nM = Mrows / BM; nN = N / BM; nwg = nM * nN; G = G_; c = c_; }
    __device__ bool next(int i, Unit& u) const {
        const long Lx = (long)i * G + c; if (Lx >= nwg) return false;
        int wgid = (int)Lx; { const int q = nwg / NXCD, r = nwg % NXCD, xcd = wgid % NXCD, off = wgid / NXCD; wgid = (xcd < r ? xcd * (q + 1) : r * (q + 1) + (xcd - r) * q) + off; }
        const int nig = WGM * nN, gid = wgid / nig, fm = gid * WGM, gsz = (nM - fm) < WGM ? (nM - fm) : WGM;
        u.pm = fm + ((wgid % nig) % gsz); u.pn = (wgid % nig) / gsz; u.e = 0; u.half = 0; return true;
    }
    static constexpr bool HALFS = false;
    __device__ __forceinline__ const char* a_ptr(const Unit& u) const { return (const char*)(A + (size_t)u.pm * BM * lda); }
    __device__ __forceinline__ const char* b_ptr(const Unit& u) const { return (const char*)(Bt + (size_t)u.pn * BM * ldb); }
    __device__ __forceinline__ void a_rows(const Unit&, const int (&R)[2], unsigned (&ro)[2][2]) const {}
};
struct InOrder {
    const bf16* A; const bf16* Bt; int lda, ldb; int nM, G, c;
    static constexpr int NF = 16;
    __device__ void init(const bf16* A_, int lda_, const bf16* Bt_, int ldb_, int Mrows, int G_, int c_) { A = A_; Bt = Bt_; lda = lda_; ldb = ldb_; nM = Mrows / BM; G = G_; c = c_; }
    __device__ bool next(int i, Unit& u) const {
        const long Lx = (long)i * G + c; const int nwg = nM * NF;
        if (Lx >= nwg) return false;
        int wgid = (int)Lx; { const int q = nwg / NXCD, r = nwg % NXCD, xcd = wgid % NXCD, off = wgid / NXCD; wgid = (xcd < r ? xcd * (q + 1) : r * (q + 1) + (xcd - r) * q) + off; }
        const int nig = WGM * NF, gid = wgid / nig, fm = gid * WGM, gsz = (nM - fm) < WGM ? (nM - fm) : WGM;
        const int pn = (wgid % nig) / gsz; u.pm = fm + ((wgid % nig) % gsz); u.pn = pn + (pn >= 8 ? 1 : 0); u.e = 0; u.half = 0; return true;
    }
    static constexpr bool HALFS = false;
    __device__ __forceinline__ const char* a_ptr(const Unit& u) const { return (const char*)(A + (size_t)u.pm * BM * lda); }
    __device__ __forceinline__ const char* b_ptr(const Unit& u) const { return (const char*)(Bt + (size_t)u.pn * BM * ldb); }
    __device__ __forceinline__ void a_rows(const Unit&, const int (&R)[2], unsigned (&ro)[2][2]) const {}
};
struct InHalfOrder {
    const bf16* A; const bf16* Bt; int lda, ldb; int nM, G, c;
    __device__ void init(const bf16* A_, int lda_, const bf16* Bt_, int ldb_, int Mrows, int G_, int c_) { A = A_; Bt = Bt_; lda = lda_; ldb = ldb_; nM = Mrows / BM; G = G_; c = c_; }
    __device__ bool next(int i, Unit& u) const {
        const long j = (long)i * G + c; if (j >= 2 * nM) return false; u.pm = (int)(j >> 1); u.pn = 8; u.e = (int)(j & 1) * HALF; u.half = 1; return true;
    }
    static constexpr bool HALFS = true;
    __device__ __forceinline__ const char* a_ptr(const Unit& u) const { return (const char*)(A + ((size_t)u.pm * BM + u.e) * lda); }
    __device__ __forceinline__ const char* b_ptr(const Unit& u) const { return (const char*)(Bt + (size_t)u.pn * BM * ldb); }
    __device__ __forceinline__ void a_rows(const Unit&, const int (&R)[2], unsigned (&ro)[2][2]) const {}
};
struct MoeOrder {
    static constexpr bool HALFS = true;
    const bf16* A; const bf16* WE; const int* stok; const LAS int* lo; int lda, ldb, nN, G, c; size_t boff;
    __device__ bool next(int i, Unit& u) const {
        const int T = lo[32] >> 8; const long Lx = (long)i * G + c; if (Lx >= (long)T * nN) return false;
        const int ent = lo[64 + (int)(Lx / nN)];
        u.pm = ent & 0xffff; u.half = ent >> 16; u.pn = (int)(Lx % nN); { const int l31 = (int)(threadIdx.x & 31); const unsigned long long bm = __ballot(lo[l31 + 1] <= u.pm * 256); u.e = __popc((unsigned)bm); }     return true;
    }
    __device__ __forceinline__ const char* a_ptr(const Unit& u) const { return stok ? (const char*)A : (const char*)(A + (size_t)u.pm * BM * lda); }
    __device__ __forceinline__ const char* b_ptr(const Unit& u) const { return (const char*)(WE + (size_t)u.e * (512 * 1024 + 1024 * 256) + boff + (size_t)u.pn * BM * ldb); }
    __device__ __forceinline__ void a_rows(const Unit& u, const int (&R)[2], unsigned (&ro)[2][2]) const {
#pragma unroll
        for (int h = 0; h < 2; ++h)
#pragma unroll
            for (int i = 0; i < 2; ++i) ro[h][i] = (unsigned)stok[u.pm * 256 + h * 128 + R[i]] * (unsigned)(lda * 2);
    }
};

template <class Epi, class Sched, bool GATHER, bool MID = false>
__device__ __forceinline__ void gemm_phase(LAS unsigned char* lds, const int K, const Sched& S, const Epi& E) {
    const int tid = threadIdx.x, wid = __builtin_amdgcn_readfirstlane(tid >> 6), lane = tid & 63, wr = wid >> 2, wc = wid & 3, fr = lane & 15, fq = lane >> 4;
    const int nt = K / BK; const int lda = S.lda, ldb = S.ldb;
    unsigned voffA[2], voffB[2]; int RA[2];
#pragma unroll
    for (int i = 0; i < 2; ++i) { int R, C; stage_rc(tid * 16 + i * 8192, R, C); const int Rb = Epi::PERM ? ((R & ~31) + perm32(R & 31)) : R; RA[i] = R;
        voffA[i] = GATHER ? (unsigned)(C * 2) : (unsigned)(R * lda + C) * 2u; voffB[i] = (unsigned)(Rb * ldb + C) * 2u; }
    const size_t kstep = (size_t)(BK * 2);
    const size_t hstepA = GATHER ? 0 : (size_t)HALF * lda * 2, hstepB = (size_t)HALF * ldb * 2;
    const unsigned ldsw = (unsigned)wid * 1024u;
    const int aoff = lds_byte(wr * 64 + fr, fq * 8), boff = lds_byte(wc * 32 + fr, fq * 8);
    unsigned roC[2][2] = {{0u, 0u}, {0u, 0u}}, roN[2][2] = {{0u, 0u}, {0u, 0u}};
#define PG8_SA(b, h) (((b) * 2 + (h)) * HTB)
#define PG8_SB(b, h) ((4 + (b) * 2 + (h)) * HTB)
#define PG8_STAGEB(bufoff, gbase) do { _Pragma("unroll") for (int _i = 0; _i < 2; ++_i) \
        __builtin_amdgcn_global_load_lds((const unsigned*)((const char*)(gbase) + voffB[_i]), (LAS unsigned*)(lds + (bufoff) + ldsw + _i * 8192), 16, 0, 0); } while (0)
#define PG8_STAGEA(bufoff, gbase, h, ro) do { _Pragma("unroll") for (int _i = 0; _i < 2; ++_i) \
        __builtin_amdgcn_global_load_lds((const unsigned*)((const char*)(gbase) + (h) * hstepA + voffA[_i] + (GATHER ? (ro)[h][_i] : 0u)), (LAS unsigned*)(lds + (bufoff) + ldsw + _i * 8192), 16, 0, 0); } while (0)
#define PG8_LDA(dst, b, h) do { _Pragma("unroll") for (int m = 0; m < 4; ++m) _Pragma("unroll") for (int k = 0; k < 2; ++k) dst[m][k] = *(const LAS bf16x8*)(lds + PG8_SA(b, h) + aoff + m * 2048 + k * 1024); } while (0)
#define PG8_LDB(dst, b, h) do { _Pragma("unroll") for (int n = 0; n < 2; ++n) _Pragma("unroll") for (int k = 0; k < 2; ++k) dst[n][k] = *(const LAS bf16x8*)(lds + PG8_SB(b, h) + boff + n * 2048 + k * 1024); } while (0)
#define PG8_MMA(ai, bj, At, Bt) do { __builtin_amdgcn_s_setprio(1); _Pragma("unroll") for (int m = 0; m < 4; ++m) _Pragma("unroll") for (int n = 0; n < 2; ++n) _Pragma("unroll") for (int k = 0; k < 2; ++k) \
        acc[ai][bj][m][n] = __builtin_amdgcn_mfma_f32_16x16x32_bf16(Bt[n][k], At[m][k], acc[ai][bj][m][n], 0, 0, 0); __builtin_amdgcn_s_setprio(0); } while (0)
#define PG8_WAIT_V(n) asm volatile("s_waitcnt vmcnt(" #n ")" ::: "memory")
#define PG8_WAIT_L(n) asm volatile("s_waitcnt lgkmcnt(" #n ")" ::: "memory")
#define PG8_BAR __builtin_amdgcn_s_barrier()
#define PG8_SCHED __builtin_amdgcn_sched_barrier(0)
    Unit cur, nxt; int ui = 0;
    if (!S.next(0, cur)) return;
    f32x4 acc[2][2][4][2];
#pragma unroll
    for (int a = 0; a < 2; ++a)
#pragma unroll
        for (int b = 0; b < 2; ++b)
#pragma unroll
            for (int m = 0; m < 4; ++m)
#pragma unroll
                for (int n = 0; n < 2; ++n) acc[a][b][m][n] = (f32x4){0.f, 0.f, 0.f, 0.f};
    bf16x8 At[4][2], B0[2][2], B1[2][2];
    const char* cA = S.a_ptr(cur); const char* cB = S.b_ptr(cur);
    if (GATHER) S.a_rows(cur, RA, roC);
    PG8_STAGEB(PG8_SB(0, 0), cB); PG8_STAGEB(PG8_SB(0, 1), cB + hstepB); PG8_STAGEA(PG8_SA(0, 0), cA, 0, roC); PG8_STAGEA(PG8_SA(0, 1), cA, 1, roC);
    if (wr == 1) PG8_BAR;
    PG8_WAIT_V(2); PG8_BAR;
    PG8_STAGEB(PG8_SB(1, 0), cB + kstep); PG8_STAGEA(PG8_SA(1, 0), cA + kstep, 0, roC); PG8_STAGEB(PG8_SB(1, 1), cB + hstepB + kstep);
    PG8_WAIT_V(6); PG8_BAR;
    for (;;) {
        const bool has_next = S.next(ui + 1, nxt);
        const char* nA = has_next ? S.a_ptr(nxt) : cA; const char* nB = has_next ? S.b_ptr(nxt) : cB;
        if (GATHER) { if (has_next) S.a_rows(nxt, RA, roN); else {
#pragma unroll
            for (int h = 0; h < 2; ++h)
#pragma unroll
                for (int i = 0; i < 2; ++i) roN[h][i] = roC[h][i]; } }
#pragma nounroll
        for (int t = 0; t < nt; t += 2) {
            if constexpr (MID) { if (t == (nt >> 1)) E.mid(acc, cur, wr, wc, fr, fq); }
            const bool last = (t == nt - 2);
            const char* a1 = cA + (size_t)(t + 1) * kstep;
            const char* a2 = last ? nA : cA + (size_t)(t + 2) * kstep; const char* b2 = last ? nB : cB + (size_t)(t + 2) * kstep;
            const char* a3 = a2 + kstep; const char* b3 = b2 + kstep;
            unsigned ro2[2][2];
#pragma unroll
            for (int h = 0; h < 2; ++h)
#pragma unroll
                for (int i = 0; i < 2; ++i) ro2[h][i] = GATHER ? (last ? roN[h][i] : roC[h][i]) : 0u;
            PG8_LDB(B0, 0, 0); PG8_LDB(B1, 0, 1); PG8_SCHED; PG8_LDA(At, 0, 0); PG8_STAGEA(PG8_SA(1, 1), a1, 1, roC);
            PG8_WAIT_V(8); PG8_WAIT_L(0); PG8_BAR; PG8_MMA(0, 0, At, B0); PG8_MMA(0, 1, At, B1); PG8_BAR; PG8_SCHED;
            PG8_LDA(At, 0, 1); PG8_STAGEB(PG8_SB(0, 0), b2); PG8_STAGEB(PG8_SB(0, 1), b2 + hstepB); PG8_STAGEA(PG8_SA(0, 0), a2, 0, ro2);
            PG8_WAIT_V(8); PG8_WAIT_L(0); PG8_BAR; if (!(Sched::HALFS && cur.half)) { PG8_MMA(1, 0, At, B0); PG8_MMA(1, 1, At, B1); } PG8_BAR; PG8_SCHED;
            PG8_LDB(B0, 1, 0); PG8_LDB(B1, 1, 1); PG8_SCHED; PG8_LDA(At, 1, 0); PG8_STAGEA(PG8_SA(0, 1), a2, 1, ro2);
            PG8_WAIT_V(8); PG8_WAIT_L(0); PG8_BAR; PG8_MMA(0, 0, At, B0); PG8_MMA(0, 1, At, B1); PG8_BAR; PG8_SCHED;
            PG8_LDA(At, 1, 1); PG8_STAGEB(PG8_SB(1, 0), b3); PG8_STAGEB(PG8_SB(1, 1), b3 + hstepB); PG8_STAGEA(PG8_SA(1, 0), a3, 0, ro2);
            PG8_WAIT_V(8); PG8_WAIT_L(0); PG8_BAR; if (!(Sched::HALFS && cur.half)) { PG8_MMA(1, 0, At, B0); PG8_MMA(1, 1, At, B1); } PG8_BAR; PG8_SCHED;
        }
        if (wr == 0) PG8_BAR;
        E(acc, cur, wr, wc, fr, fq);
        if (!has_next) break;
#pragma unroll
        for (int a = 0; a < 2; ++a)
#pragma unroll
            for (int b = 0; b < 2; ++b)
#pragma unroll
                for (int m = 0; m < 4; ++m)
#pragma unroll
                    for (int n = 0; n < 2; ++n) acc[a][b][m][n] = (f32x4){0.f, 0.f, 0.f, 0.f};
        cur = nxt; cA = nA; cB = nB; ++ui;
        if (GATHER) {
#pragma unroll
            for (int h = 0; h < 2; ++h)
#pragma unroll
                for (int i = 0; i < 2; ++i) roC[h][i] = roN[h][i]; }
        if (wr == 1) PG8_BAR;
    }
    PG8_WAIT_V(0);
    PG8_BAR;
#undef PG8_SA
#undef PG8_SB
#undef PG8_STAGEA
#undef PG8_STAGEB
#undef PG8_LDA
#undef PG8_LDB
#undef PG8_MMA
#undef PG8_WAIT_V
#undef PG8_WAIT_L
#undef PG8_BAR
#undef PG8_SCHED
}

struct EpiIn {
    static constexpr bool PERM = true; unsigned char* ws;
    __device__ __forceinline__ void operator()(const f32x4 (&acc)[2][2][4][2], const Unit& u, int wr, int wc, int fr, int fq) const {
        bf16* base; int ldc, colt; const bool sg = u.pn >= 9;
        if (u.pn < 6) { base = (bf16*)(ws + WS_PROJH); ldc = 1536; colt = u.pn * 256; } else if (u.pn < 9) { base = (bf16*)(ws + WS_PROJL); ldc = PL; colt = (u.pn - 6) * 256; } else { base = (bf16*)(ws + WS_GATES); ldc = 2048; colt = (u.pn - 9) * 256; }
        const int row0 = u.pm * BM + u.e + wr * 64 + fr, col0 = colt + wc * 32 + 8 * fq;
#pragma unroll
        for (int ai = 0; ai < 2; ++ai)
#pragma unroll
            for (int m = 0; m < 4; ++m) { if (u.half && ai == 1) continue; bf16* rowp = base + (size_t)(row0 + ai * HALF + m * 16) * ldc + col0;
#pragma unroll
                for (int bj = 0; bj < 2; ++bj) { f32x4 v0 = acc[ai][bj][m][0], v1 = acc[ai][bj][m][1];
                    if (sg) {
#pragma unroll
                        for (int e = 0; e < 4; ++e) { v0[e] = __builtin_fmaxf(sigmoidf_(v0[e]), 8.6736174e-19f); v1[e] = __builtin_fmaxf(sigmoidf_(v1[e]), 8.6736174e-19f); } }
                    v4u w; w.x = cvt_pk_bf16(v0[0], v0[1]); w.y = cvt_pk_bf16(v0[2], v0[3]); w.z = cvt_pk_bf16(v1[0], v1[1]); w.w = cvt_pk_bf16(v1[2], v1[3]);
                    *(v4u*)(rowp + bj * HALF) = w; } }
    }
};
struct EpiQ {
    static constexpr bool PERM = false; unsigned char* ws; bf16* q; const XcdBarrier* bw; volatile LAS unsigned* wf;
    __device__ __forceinline__ void operator()(const f32x4 (&acc)[2][2][4][2], const Unit& u, int wr, int wc, int fr, int fq) const {
        PG8_LATE_WAIT(bw, wf);
        const float* rsq = (const float*)(ws + WS_RSQ); const float* ct = (const float*)(ws + WS_ROPE); const float* st = ct + L * 16;
        const int row0 = u.pm * BM + wr * 64 + fr;
#pragma unroll
        for (int ai = 0; ai < 2; ++ai)
#pragma unroll
            for (int m = 0; m < 4; ++m) { const int row = row0 + ai * HALF + m * 16; const float sc = C2 * rsq[row];
                const f32x4 cs = *(const f32x4*)(ct + row * 16 + 4 * fq), sn = *(const f32x4*)(st + row * 16 + 4 * fq);
#pragma unroll
                for (int bj = 0; bj < 2; ++bj) { const int cg = u.pn * 256 + bj * HALF + wc * 32; f32x4 v0 = acc[ai][bj][m][0], v1 = acc[ai][bj][m][1];
                    if (((cg >> 5) % 3) == 2) { const f32x4 a = v0, b = v1; v0 = a * cs - b * sn; v1 = a * sn + b * cs; }
                    v0 = v0 * sc; v1 = v1 * sc; bf16* p = q + (size_t)row * 768 + cg + 4 * fq;
                    *(v2u*)p = (v2u){cvt_pk_bf16(v0[0], v0[1]), cvt_pk_bf16(v0[2], v0[3])}; *(v2u*)(p + 16) = (v2u){cvt_pk_bf16(v1[0], v1[1]), cvt_pk_bf16(v1[2], v1[3])}; }
                asm volatile("" ::: "memory"); }
    }
};
struct EpiKV {
    static constexpr bool PERM = true; unsigned char* ws; const XcdBarrier* bw; volatile LAS unsigned* wf;
    __device__ __forceinline__ void operator()(const f32x4 (&acc)[2][2][4][2], const Unit& u, int wr, int wc, int fr, int fq) const {
        PG8_LATE_WAIT(bw, wf);
        const float* rs = (const float*)(ws + WS_RSKV); const int row0 = u.pm * BM + wr * 64 + fr; const bool isk = u.pn < 2;
#pragma unroll
        for (int ai = 0; ai < 2; ++ai)
#pragma unroll
            for (int m = 0; m < 4; ++m) { const int row = row0 + ai * HALF + m * 16; const float sc = rs[row];
#pragma unroll
                for (int bj = 0; bj < 2; ++bj) { const int c = u.pn * 256 + bj * HALF + wc * 32 + 8 * fq; const f32x4 v0 = acc[ai][bj][m][0] * sc, v1 = acc[ai][bj][m][1] * sc;
                    bf16* p = isk ? (bf16*)(ws + WS_K) + (size_t)row * 768 + (c >> 6) * 96 + (c & 63) : (bf16*)(ws + WS_V) + (size_t)row * 512 + (c - 512);
                    *(v4u*)p = (v4u){cvt_pk_bf16(v0[0], v0[1]), cvt_pk_bf16(v0[2], v0[3]), cvt_pk_bf16(v1[0], v1[1]), cvt_pk_bf16(v1[2], v1[3])}; } }
    }
};
struct EpiM1 {
    static constexpr bool PERM = false; unsigned char* ws; float* tmp;
    __device__ __forceinline__ void operator()(const f32x4 (&acc)[2][2][4][2], const Unit& u, int wr, int wc, int fr, int fq) const {
        const bf16* g = (const bf16*)(ws + WS_GATES); const int row0 = u.pm * BM + wr * 64 + fr, col0 = u.pn * BM + wc * 32 + 4 * fq;
#pragma unroll
        for (int ai = 0; ai < 2; ++ai)
#pragma unroll
            for (int m = 0; m < 4; ++m) { const int row = row0 + ai * HALF + m * 16;
#pragma unroll
                for (int bj = 0; bj < 2; ++bj)
#pragma unroll
                    for (int n = 0; n < 2; ++n) { const int c = col0 + bj * HALF + n * 16; const v2u gw = *(const v2u*)(g + (size_t)row * 2048 + c);
                        const f32x4 gv = (f32x4){bflo(gw.x), bfhi(gw.x), bflo(gw.y), bfhi(gw.y)}; *(f32x4*)(tmp + (size_t)row * D + c) = acc[ai][bj][m][n] * gv; } }
    }
};
struct EpiM2 {
    static constexpr bool PERM = true; unsigned char* ws; const float* tmp;
    __device__ __forceinline__ void operator()(const f32x4 (&acc)[2][2][4][2], const Unit& u, int wr, int wc, int fr, int fq) const {
        const bf16* g = (const bf16*)(ws + WS_GATES) + 1024; bf16* mix = (bf16*)(ws + WS_MIX); const int row0 = u.pm * BM + wr * 64 + fr, col0 = u.pn * BM + wc * 32 + 8 * fq;
#pragma unroll
        for (int ai = 0; ai < 2; ++ai)
#pragma unroll
            for (int m = 0; m < 4; ++m) { const int row = row0 + ai * HALF + m * 16;
#pragma unroll
                for (int bj = 0; bj < 2; ++bj) { const int c = col0 + bj * HALF; const v4u gw = *(const v4u*)(g + (size_t)row * 2048 + c);
                    const f32x4 t0 = *(const f32x4*)(tmp + (size_t)row * D + c), t1 = *(const f32x4*)(tmp + (size_t)row * D + c + 4);
                    const f32x4 v0 = t0 + acc[ai][bj][m][0] * (f32x4){bflo(gw.x), bfhi(gw.x), bflo(gw.y), bfhi(gw.y)}, v1 = t1 + acc[ai][bj][m][1] * (f32x4){bflo(gw.z), bfhi(gw.z), bflo(gw.w), bfhi(gw.w)};
                    *(v4u*)(mix + (size_t)row * D + c) = (v4u){cvt_pk_bf16(v0[0], v0[1]), cvt_pk_bf16(v0[2], v0[3]), cvt_pk_bf16(v1[0], v1[1]), cvt_pk_bf16(v1[2], v1[3])}; } }
    }
};
struct EpiMix {
    static constexpr bool PERM = true; unsigned char* ws;
    __device__ __forceinline__ void mid(f32x4 (&acc)[2][2][4][2], const Unit& u, int wr, int wc, int fr, int fq) const {
        unsigned long long gb = (unsigned long long)((const bf16*)(ws + WS_GATES) + (size_t)(u.pm * BM + wr * 64 + fr) * 2048 + u.pn * BM + wc * 32 + 8 * fq);
        asm volatile("" : "+v"(gb));
        const bf16* g = (const bf16*)gb;
#pragma unroll
        for (int ai = 0; ai < 2; ++ai)
#pragma unroll
            for (int m = 0; m < 4; ++m)
#pragma unroll
                for (int bj = 0; bj < 2; ++bj)
#pragma unroll
                    for (int n = 0; n < 2; ++n) { const bf16* p = g + (size_t)(ai * HALF + m * 16) * 2048 + bj * HALF + 4 * n; const v2u a = *(const v2u*)p, b = *(const v2u*)(p + 1024);
                        const f32x4 r = (f32x4){bflo(a.x) * __builtin_amdgcn_rcpf(bflo(b.x)), bfhi(a.x) * __builtin_amdgcn_rcpf(bfhi(b.x)), bflo(a.y) * __builtin_amdgcn_rcpf(bflo(b.y)), bfhi(a.y) * __builtin_amdgcn_rcpf(bfhi(b.y))};
                        acc[ai][bj][m][n] = acc[ai][bj][m][n] * r; asm volatile("" ::: "memory"); }
    }
    __device__ __forceinline__ void operator()(const f32x4 (&acc)[2][2][4][2], const Unit& u, int wr, int wc, int fr, int fq) const {
        const bf16* g = (const bf16*)(ws + WS_GATES) + 1024; bf16* mix = (bf16*)(ws + WS_MIX); const int row0 = u.pm * BM + wr * 64 + fr, col0 = u.pn * BM + wc * 32 + 8 * fq;
#pragma unroll
        for (int ai = 0; ai < 2; ++ai)
#pragma unroll
            for (int m = 0; m < 4; ++m) { const int row = row0 + ai * HALF + m * 16;
#pragma unroll
                for (int bj = 0; bj < 2; ++bj) { const int c = col0 + bj * HALF; const v4u gw = *(const v4u*)(g + (size_t)row * 2048 + c);
                    const f32x4 v0 = acc[ai][bj][m][0] * (f32x4){bflo(gw.x), bfhi(gw.x), bflo(gw.y), bfhi(gw.y)}, v1 = acc[ai][bj][m][1] * (f32x4){bflo(gw.z), bfhi(gw.z), bflo(gw.w), bfhi(gw.w)};
                    *(v4u*)(mix + (size_t)row * D + c) = (v4u){cvt_pk_bf16(v0[0], v0[1]), cvt_pk_bf16(v0[2], v0[3]), cvt_pk_bf16(v1[0], v1[1]), cvt_pk_bf16(v1[2], v1[3])}; } }
    }
};
struct EpiX1 {
    static constexpr bool PERM = true; unsigned char* ws; const float* x; bf16* x1;
    __device__ __forceinline__ void operator()(const f32x4 (&acc)[2][2][4][2], const Unit& u, int wr, int wc, int fr, int fq) const {
        const float* gt = (const float*)(ws + WS_MOD) + 2048; const int row0 = u.pm * BM + wr * 64 + fr, col0 = u.pn * BM + wc * 32 + 8 * fq;
        f32x4 gv[2][2];
#pragma unroll
        for (int bj = 0; bj < 2; ++bj)
#pragma unroll
            for (int n = 0; n < 2; ++n) gv[bj][n] = *(const f32x4*)(gt + col0 + bj * HALF + n * 4);
#pragma unroll
        for (int ai = 0; ai < 2; ++ai)
#pragma unroll
            for (int m = 0; m < 4; ++m) { const size_t off = (size_t)(row0 + ai * HALF + m * 16) * D + col0;
#pragma unroll
                for (int bj = 0; bj < 2; ++bj) { const f32x4 r0 = NTL((const f32x4*)(x + off + bj * HALF)) + gv[bj][0] * acc[ai][bj][m][0], r1 = NTL((const f32x4*)(x + off + bj * HALF + 4)) + gv[bj][1] * acc[ai][bj][m][1];
                    *(v4u*)(x1 + off + bj * HALF) = (v4u){cvt_pk_bf16(r0[0], r0[1]), cvt_pk_bf16(r0[2], r0[3]), cvt_pk_bf16(r1[0], r1[1]), cvt_pk_bf16(r1[2], r1[3])}; } }
    }
};
struct EpiAct {
    static constexpr bool PERM = false; unsigned char* ws;
    __device__ __forceinline__ void operator()(const f32x4 (&acc)[2][2][4][2], const Unit& u, int wr, int wc, int fr, int fq) const {
        bf16* act = (bf16*)(ws + WS_ACT); const int row0 = u.pm * BM + wr * 64 + fr;
#pragma unroll
        for (int ai = 0; ai < 2; ++ai)
#pragma unroll
            for (int m = 0; m < 4; ++m) { if (u.half && ai == 1) continue; const int row = row0 + ai * HALF + m * 16;
#pragma unroll
                for (int bj = 0; bj < 2; ++bj) { const int j = (u.pn * 256 + bj * HALF + wc * 32) / 2 + 4 * fq; const f32x4 g = acc[ai][bj][m][0], up = acc[ai][bj][m][1]; f32x4 a;
#pragma unroll
                    for (int e = 0; e < 4; ++e) a[e] = siluf_(g[e]) * up[e];
                    *(v2u*)(act + (size_t)row * DEXP + j) = (v2u){cvt_pk_bf16(a[0], a[1]), cvt_pk_bf16(a[2], a[3])}; } }
    }
};
struct EpiY {
    static constexpr bool PERM = true; unsigned char* ws;
    __device__ __forceinline__ void operator()(const f32x4 (&acc)[2][2][4][2], const Unit& u, int wr, int wc, int fr, int fq) const {
        bf16* y = (bf16*)(ws + WS_Y); const float* sw = (const float*)(ws + WS_SW); const int row0 = u.pm * BM + wr * 64 + fr, col0 = u.pn * BM + wc * 32 + 8 * fq;
#pragma unroll
        for (int ai = 0; ai < 2; ++ai)
#pragma unroll
            for (int m = 0; m < 4; ++m) { if (u.half && ai == 1) continue; const int row = row0 + ai * HALF + m * 16; const float s = sw[row];
#pragma unroll
                for (int bj = 0; bj < 2; ++bj) { const f32x4 v0 = acc[ai][bj][m][0] * s, v1 = acc[ai][bj][m][1] * s;
                    *(v4u*)(y + (size_t)row * D + col0 + bj * HALF) = (v4u){cvt_pk_bf16(v0[0], v0[1]), cvt_pk_bf16(v0[2], v0[3]), cvt_pk_bf16(v1[0], v1[1]), cvt_pk_bf16(v1[2], v1[3])}; } }
    }
};
}


namespace att {
typedef short bf16x8 __attribute__((ext_vector_type(8)));
typedef short s16x4 __attribute__((ext_vector_type(4)));
typedef float f32x16 __attribute__((ext_vector_type(16)));
typedef short v4i16_t __attribute__((ext_vector_type(4)));
typedef LAS const char* lds_cptr;
constexpr int KSL = 12288, VSL = 8192, LDS_K = 0, LDS_V = 2 * KSL, LDS_WS = LDS_V + 2 * VSL, LDS_OST = LDS_WS + 8 * 256, LDS_BYTES_ATT = LDS_OST + 8 * 4096;
constexpr int NT = L / 64;
__device__ __forceinline__ int crow(int r, int hi) { return (r & 3) + 8 * (r >> 2) + 4 * hi; }
__device__ __forceinline__ void glds16(const void* gsrc, unsigned lds_dst) { unsigned keep;
    asm volatile("s_mov_b32 %0, m0\n\ts_mov_b32 m0, %2\n\ts_nop 0\n\tglobal_load_lds_dwordx4 %1, off\n\ts_mov_b32 m0, %0" : "=&s"(keep) : "v"(gsrc), "s"(lds_dst) : "memory"); }
__device__ __forceinline__ unsigned cvtpk(float lo, float hi) { typedef float f2 __attribute__((ext_vector_type(2))); typedef __bf16 b2 __attribute__((ext_vector_type(2))); f2 v = {lo, hi}; b2 b = __builtin_convertvector(v, b2); return __builtin_bit_cast(unsigned, b); }
__device__ __forceinline__ s16x4 vtr(lds_cptr p) { return __builtin_bit_cast(s16x4, __builtin_amdgcn_ds_read_tr16_b64_v4i16((LAS v4i16_t*)p)); }
#define MX3(a, b, c) __builtin_fmaxf(__builtin_fmaxf((a), (b)), (c))
__device__ __forceinline__ float rowmax(const f32x16& p0, const f32x16& p1) {
    float a = MX3(p0[0], p0[1], p1[0]), b = MX3(p0[2], p0[3], p1[1]); a = MX3(a, p1[2], p1[3]);
#pragma unroll
    for (int r = 4; r < 16; r += 4) { a = MX3(a, p0[r], p0[r + 1]); b = MX3(b, p0[r + 2], p0[r + 3]); a = MX3(a, p1[r], p1[r + 1]); b = MX3(b, p1[r + 2], p1[r + 3]); }
    float m = __builtin_fmaxf(a, b); auto rr = __builtin_amdgcn_permlane32_swap(__float_as_uint(m), __float_as_uint(m), false, false);
    return __builtin_fmaxf(__uint_as_float(rr[0]), __uint_as_float(rr[1])); }
#undef MX3
#define WAIT_BAR0() asm volatile("s_waitcnt vmcnt(0) lgkmcnt(0)\n\ts_barrier" ::: "memory")

template <int THRL> __device__ __forceinline__ void attn_unit(int h, int qb, const bf16* Q, const bf16* __restrict__ K, const bf16* __restrict__ V, bf16* Y, char* shm) {
    const int tid = threadIdx.x, lane = tid & 63, r32 = lane & 31, hi = lane >> 5; const int wid = __builtin_amdgcn_readfirstlane(tid >> 6);
    const int q0 = qb * 256;
    const unsigned lds0 = (unsigned)(uintptr_t)shm; float* wsf = (float*)(shm + LDS_WS) + wid * 64;
    const bf16* ksrc0 = K + h * 96 + (size_t)lane * 768 + wid * 8;
    const bf16* ksrc1 = ksrc0 + 64;
    const bf16* vsrc = V + h * 64 + (size_t)(16 * (wid & 3) + (lane >> 2)) * 512 + (wid >> 2) * 32 + (lane & 3) * 8;
    const unsigned kdst0 = lds0 + LDS_K + wid * 1024, kdst1 = kdst0 + 8192, vdst = lds0 + LDS_V + wid * 1024;
#define DMA(t, s) do { glds16(ksrc0 + (size_t)(t) * 64 * 768, (unsigned)__builtin_amdgcn_readfirstlane(kdst0 + (s) * KSL)); \
        if (wid < 4) glds16(ksrc1 + (size_t)(t) * 64 * 768, (unsigned)__builtin_amdgcn_readfirstlane(kdst1 + (s) * KSL)); \
        glds16(vsrc + (size_t)(t) * 64 * 512, (unsigned)__builtin_amdgcn_readfirstlane(vdst + (s) * VSL)); } while (0)
    DMA(0, 0);
    bf16x8 qr[6];
    { const bf16* Qw = Q + (size_t)(q0 + wid * 32 + r32) * 768 + h * 96 + hi * 8;
#pragma unroll
      for (int d0 = 0; d0 < 6; ++d0) qr[d0] = *reinterpret_cast<const bf16x8*>(Qw + d0 * 16); }
    float mhat = 0.f, l_reg = 0.f; f32x16 o[2]; o[0] = f32x16{}; o[1] = f32x16{}; f32x16 negm = f32x16{};
    const lds_cptr shm3 = (lds_cptr)shm; const lds_cptr kp0 = shm3 + LDS_K + hi * 1024 + r32 * 16;
    const lds_cptr vp0 = shm3 + LDS_V + ((lane >> 4) & 1) * 32 + (lane & 3) * 8 + (4 * hi + ((lane & 15) >> 2)) * 64;
#pragma nounroll
    for (int t = 0; t < NT; ++t) {
        WAIT_BAR0();
        const int s = t & 1;
        if (t + 1 < NT) DMA(t + 1, s ^ 1);
        const lds_cptr kp = kp0 + s * KSL; f32x16 p0 = negm, p1 = negm;
#pragma unroll
        for (int d0 = 0; d0 < 6; ++d0) { const bf16x8 b0 = *(const LAS bf16x8*)(kp + d0 * 2048), b1 = *(const LAS bf16x8*)(kp + d0 * 2048 + 512);
            p0 = __builtin_amdgcn_mfma_f32_32x32x16_bf16(b0, qr[d0], p0, 0, 0, 0); p1 = __builtin_amdgcn_mfma_f32_32x32x16_bf16(b1, qr[d0], p1, 0, 0, 0); }
        const float rm = rowmax(p0, p1);
        if (t == 0 || __any(rm > (float)THRL)) {
            const float dl = (t == 0) ? rm : __builtin_fmaxf(rm, 0.f); mhat += dl;
#pragma unroll
            for (int r = 0; r < 16; ++r) { p0[r] -= dl; p1[r] -= dl; negm[r] = -mhat; }
            const float f = __builtin_amdgcn_exp2f(-dl); l_reg *= f;
            if (t > 0) { if (hi == 0) wsf[r32] = f; asm volatile("s_waitcnt lgkmcnt(0)" ::: "memory");
#pragma unroll
                for (int d_ = 0; d_ < 2; ++d_)
#pragma unroll
                    for (int r = 0; r < 16; ++r) o[d_][r] *= wsf[crow(r, hi)]; }
        }
        float sacc = 0.f;
#pragma unroll
        for (int r = 0; r < 16; ++r) { p0[r] = __builtin_amdgcn_exp2f(p0[r]); p1[r] = __builtin_amdgcn_exp2f(p1[r]); sacc += p0[r] + p1[r]; }
        l_reg += sacc;
        bf16x8 pa[4];
#pragma unroll
        for (int ks = 0; ks < 2; ++ks) {
            const v4u w0 = (v4u){cvtpk(p0[8 * ks], p0[8 * ks + 1]), cvtpk(p0[8 * ks + 2], p0[8 * ks + 3]), cvtpk(p0[8 * ks + 4], p0[8 * ks + 5]), cvtpk(p0[8 * ks + 6], p0[8 * ks + 7])};
            const v4u w1 = (v4u){cvtpk(p1[8 * ks], p1[8 * ks + 1]), cvtpk(p1[8 * ks + 2], p1[8 * ks + 3]), cvtpk(p1[8 * ks + 4], p1[8 * ks + 5]), cvtpk(p1[8 * ks + 6], p1[8 * ks + 7])};
            pa[ks] = __builtin_bit_cast(bf16x8, w0); pa[2 + ks] = __builtin_bit_cast(bf16x8, w1); }
        const lds_cptr vp = vp0 + s * VSL;
#pragma unroll
        for (int dh = 0; dh < 2; ++dh)
#pragma unroll
            for (int ks = 0; ks < 4; ++ks) { const s16x4 vl = vtr(vp + dh * 4096 + ks * 1024), vh = vtr(vp + dh * 4096 + ks * 1024 + 512);
                const bf16x8 vf = (bf16x8){vl[0], vl[1], vl[2], vl[3], vh[0], vh[1], vh[2], vh[3]};
                o[dh] = __builtin_amdgcn_mfma_f32_32x32x16_bf16(pa[ks], vf, o[dh], 0, 0, 0); }
    }
    { auto rr = __builtin_amdgcn_permlane32_swap(__float_as_uint(l_reg), __float_as_uint(l_reg), false, false); l_reg = __uint_as_float(rr[0]) + __uint_as_float(rr[1]); }
    if (hi == 0) wsf[32 + r32] = l_reg; asm volatile("s_waitcnt lgkmcnt(0)" ::: "memory");
    float rli[16];
#pragma unroll
    for (int r = 0; r < 16; ++r) rli[r] = __builtin_amdgcn_rcpf(wsf[32 + crow(r, hi)]);
    bf16* Yw = Y + (size_t)(q0 + wid * 32) * D + h * 64; bf16* stg = (bf16*)(shm + LDS_OST) + wid * 2048;
#pragma unroll
    for (int r = 0; r < 16; ++r) { const int orow = crow(r, hi);
#pragma unroll
        for (int d0 = 0; d0 < 2; ++d0) stg[orow * 64 + d0 * 32 + r32] = (bf16)f2bf(o[d0][r] * rli[r]); }
    asm volatile("s_waitcnt lgkmcnt(0)" ::: "memory");
#pragma unroll
    for (int i = 0; i < 4; ++i) { const int row = i * 8 + (lane >> 3), ch = lane & 7; *(v4u*)(Yw + (size_t)row * D + ch * 8) = *(const v4u*)(stg + row * 64 + ch * 8); }
    asm volatile("s_waitcnt lgkmcnt(0)\n\ts_barrier" ::: "memory");
#undef DMA
}
#undef WAIT_BAR0
}


namespace att2 {
using att::bf16x8; using att::s16x4; using att::f32x16; using att::lds_cptr; using att::crow; using att::glds16; using att::cvtpk; using att::vtr; using att::rowmax;
constexpr int KSL = 12288, VSL = 8192, LDS_K = 0, LDS_V = 3 * KSL, LDS_WS = LDS_V + 3 * VSL, LDS_OST = LDS_WS + 8 * 256, LDS_BYTES_ATT = LDS_OST + 8 * 4096;
constexpr int NT = L / 64;
#define SBAR() __builtin_amdgcn_sched_barrier(0)
#define PIN(x) asm volatile("" : "+v"(x))
#define MFMA(a, b, c) __builtin_amdgcn_mfma_f32_32x32x16_bf16(a, b, c, 0, 0, 0)
#define WAIT_BAR(N) asm volatile("s_waitcnt vmcnt(" #N ") lgkmcnt(0)\n\ts_barrier" ::: "memory")
constexpr int LDS_FLAG = 96256;
template <int THRL, bool FAST> __device__ __forceinline__ void attn_unit(int h, int qb, const bf16* Q, const bf16* __restrict__ K, const bf16* __restrict__ V, bf16* Y, char* shm) {
    const int tid = threadIdx.x, lane = tid & 63, r32 = lane & 31, hi = lane >> 5; const int wid = __builtin_amdgcn_readfirstlane(tid >> 6);
    const int q0 = qb * 256;
    const unsigned lds0 = (unsigned)(uintptr_t)shm; float* wsf = (float*)(shm + LDS_WS) + wid * 64;
    const bf16* ksrc0 = K + h * 96 + (size_t)lane * 768 + wid * 8;
    const bf16* ksrc1 = ksrc0 + 64;
    const bf16* vsrc = V + h * 64 + (size_t)(16 * (wid & 3) + (lane >> 2)) * 512 + (wid >> 2) * 32 + (lane & 3) * 8;
    const unsigned kdst0 = lds0 + LDS_K + wid * 1024, kdst1 = kdst0 + 8192, vdst = lds0 + LDS_V + wid * 1024;
#define DMA_K(t, so) do { const int t_ = (t) < NT ? (t) : NT - 1; glds16(ksrc0 + (size_t)t_ * 64 * 768, (unsigned)__builtin_amdgcn_readfirstlane(kdst0 + (so))); \
        if (wid < 4) glds16(ksrc1 + (size_t)t_ * 64 * 768, (unsigned)__builtin_amdgcn_readfirstlane(kdst1 + (so))); } while (0)
#define DMA_V(t, so) do { const int t_ = (t) < NT ? (t) : NT - 1; glds16(vsrc + (size_t)t_ * 64 * 512, (unsigned)__builtin_amdgcn_readfirstlane(vdst + (so))); } while (0)
    DMA_K(0, 0); DMA_V(0, 0); DMA_K(1, KSL);
    bf16x8 qr[6];
    { const bf16* Qw = Q + (size_t)(q0 + wid * 32 + r32) * 768 + h * 96 + hi * 8;
#pragma unroll
      for (int d0 = 0; d0 < 6; ++d0) qr[d0] = NTL(reinterpret_cast<const bf16x8*>(Qw + d0 * 16)); }
    if (FAST && tid == 0) *(LAS int*)((LAS char*)shm + LDS_FLAG) = 0;
    float gmax = 0.f; float mhat = 0.f, l_reg = 0.f; f32x16 o[2]; o[0] = f32x16{}; o[1] = f32x16{}; f32x16 negm = f32x16{}; PIN(negm);
    const lds_cptr shm3 = (lds_cptr)shm; const lds_cptr kp0 = shm3 + LDS_K + hi * 1024 + r32 * 16;
    const lds_cptr vp0 = shm3 + LDS_V + ((lane >> 4) & 1) * 32 + (lane & 3) * 8 + (4 * hi + ((lane & 15) >> 2)) * 64;
    bool resc = false;
    f32x16 pA0, pA1, pB0, pB1; bf16x8 kf[4]; s16x4 vlo[8], vhi[8]; v4u pw0, pw1, pw2, pw3;
    WAIT_BAR(0);
    { pA0 = negm; pA1 = negm;
#pragma unroll
      for (int d0 = 0; d0 < 6; ++d0) { const bf16x8 b0 = *(const LAS bf16x8*)(kp0 + d0 * 2048), b1 = *(const LAS bf16x8*)(kp0 + d0 * 2048 + 512); pA0 = MFMA(b0, qr[d0], pA0); pA1 = MFMA(b1, qr[d0], pA1); }
      const float rm = rowmax(pA0, pA1); mhat = rm;
#pragma unroll
      for (int r = 0; r < 16; ++r) { pA0[r] = __builtin_amdgcn_exp2f(pA0[r] - rm); pA1[r] = __builtin_amdgcn_exp2f(pA1[r] - rm); negm[r] = -mhat; }
      PIN(negm); }
    asm volatile("s_waitcnt lgkmcnt(0)\n\ts_barrier" ::: "memory");
    DMA_K(2, 2 * KSL); DMA_V(1, VSL);
    int s_prev = 0, s_cur = 1, s_next = 2;
#define ROT() do { const int n_ = s_prev; s_prev = s_cur; s_cur = s_next; s_next = n_; } while (0)
#define RESC() do { if (resc) { _Pragma("unroll") for (int d_ = 0; d_ < 2; ++d_) _Pragma("unroll") for (int r = 0; r < 16; ++r) o[d_][r] *= wsf[crow(r, hi)]; } } while (0)
#define PKW(P, B) cvtpk(P[B], P[B + 1])
#define PAF(k) __builtin_bit_cast(bf16x8, pw##k)
#define VFR(i) (bf16x8){vlo[i][0], vlo[i][1], vlo[i][2], vlo[i][3], vhi[i][0], vhi[i][1], vhi[i][2], vhi[i][3]}
#define VRD(i) do { vlo[i] = vtr(vp_ + (((i) >> 2) * 4096 + ((i) & 3) * 1024)); vhi[i] = vtr(vp_ + (((i) >> 2) * 4096 + ((i) & 3) * 1024 + 512)); } while (0)
#define KRD(i) do { kf[(i) & 3] = *(const LAS bf16x8*)(kp_ + ((i) >> 1) * 2048 + ((i) & 1) * 512); } while (0)
#define GAPA(MF, A0, A1, A2, A3, W0, W1, PW) do { MF; sacc += A0; sacc += A1; sacc += A2; sacc += A3; PIN(sacc); W0; W1; PIN(PW); SBAR(); } while (0)
#define GAPM(MF) do { MF; SBAR(); } while (0)
#define EX(v) __builtin_amdgcn_exp2f(v)
#define GAPB(MF, X, B) do { MF; X[B] = EX(X[B]); X[B + 1] = EX(X[B + 1]); X[B + 2] = EX(X[B + 2]); X[B + 3] = EX(X[B + 3]); PIN(X); SBAR(); } while (0)
#define STEP(C0, C1, P0, P1, t) do { SBAR(); \
    const lds_cptr vp_ = vp0 + s_prev * VSL; const lds_cptr kp_ = kp0 + s_cur * KSL; \
    KRD(0); KRD(1); VRD(0); SBAR(); float sacc = (P0[0] + P0[1]); \
    KRD(2); SBAR(); GAPA(C0 = MFMA(kf[0], qr[0], negm), P0[2], P0[3], P0[4], P0[5],     pw0[0] = PKW(P0, 0),  pw0[1] = PKW(P0, 2),  pw0); \
    KRD(3); VRD(4); SBAR(); GAPA(C1 = MFMA(kf[1], qr[0], negm), P0[6], P0[7], P0[8], P0[9],     pw0[2] = PKW(P0, 4),  pw0[3] = PKW(P0, 6),  pw0); \
    KRD(4); VRD(1); SBAR(); GAPA(C0 = MFMA(kf[2], qr[1], C0),   P0[10], P0[11], P0[12], P0[13], pw1[0] = PKW(P0, 8),  pw1[1] = PKW(P0, 10), pw1); \
    KRD(5); VRD(5); SBAR(); GAPA(C1 = MFMA(kf[3], qr[1], C1),   P0[14], P0[15], P1[0], P1[1],   pw1[2] = PKW(P0, 12), pw1[3] = PKW(P0, 14), pw1); \
    KRD(6); VRD(2); SBAR(); GAPA(C0 = MFMA(kf[0], qr[2], C0),   P1[2], P1[3], P1[4], P1[5],     pw2[0] = PKW(P1, 0),  pw2[1] = PKW(P1, 2),  pw2); \
    KRD(7); VRD(6); SBAR(); GAPA(C1 = MFMA(kf[1], qr[2], C1),   P1[6], P1[7], P1[8], P1[9],     pw2[2] = PKW(P1, 4),  pw2[3] = PKW(P1, 6),  pw2); \
    KRD(8); VRD(3); SBAR(); GAPA(C0 = MFMA(kf[2], qr[3], C0),   P1[10], P1[11], P1[12], P1[13], pw3[0] = PKW(P1, 8),  pw3[1] = PKW(P1, 10), pw3); \
    KRD(9); VRD(7); SBAR(); GAPA(C1 = MFMA(kf[3], qr[3], C1),   P1[14], P1[15], 0.f, 0.f,       pw3[2] = PKW(P1, 12), pw3[3] = PKW(P1, 14), pw3); \
    KRD(10); SBAR(); GAPM(C0 = MFMA(kf[0], qr[4], C0)); \
    KRD(11); SBAR(); GAPM(C1 = MFMA(kf[1], qr[4], C1)); \
    DMA_K((t) + 2, s_prev * KSL); SBAR(); GAPM(C0 = MFMA(kf[2], qr[5], C0)); \
    DMA_V((t) + 1, s_next * VSL); SBAR(); GAPM(C1 = MFMA(kf[3], qr[5], C1)); \
    l_reg += sacc; if (FAST) gmax = __builtin_fmaxf(gmax, sacc); \
    if (!FAST) { const float rm = rowmax(C0, C1); resc = false; \
      if (__builtin_expect(__any(rm > (float)THRL), 0)) { const float dl = __builtin_fmaxf(rm, 0.f); mhat += dl; \
        _Pragma("unroll") for (int r = 0; r < 16; ++r) { C0[r] -= dl; C1[r] -= dl; } \
        _Pragma("unroll") for (int r = 0; r < 16; ++r) negm[r] = -mhat; PIN(negm); \
        const float f = __builtin_amdgcn_exp2f(-dl); l_reg *= f; if (hi == 0) wsf[r32] = f; resc = true; } } \
    SBAR(); \
    GAPB(o[0] = MFMA(PAF(0), VFR(0), o[0]), C0, 0);  GAPB(o[1] = MFMA(PAF(0), VFR(4), o[1]), C0, 4); \
    GAPB(o[0] = MFMA(PAF(1), VFR(1), o[0]), C0, 8);  GAPB(o[1] = MFMA(PAF(1), VFR(5), o[1]), C0, 12); \
    GAPB(o[0] = MFMA(PAF(2), VFR(2), o[0]), C1, 0);  GAPB(o[1] = MFMA(PAF(2), VFR(6), o[1]), C1, 4); \
    GAPB(o[0] = MFMA(PAF(3), VFR(3), o[0]), C1, 8);  GAPB(o[1] = MFMA(PAF(3), VFR(7), o[1]), C1, 12); \
    if (wid < 4) { WAIT_BAR(3); } else { WAIT_BAR(2); } \
    RESC(); ROT(); } while (0)
    int t = 1;
#pragma nounroll
    for (; t + 1 < NT; t += 2) {
        STEP(pB0, pB1, pA0, pA1, t);
        STEP(pA0, pA1, pB0, pB1, t + 1);
    }
    STEP(pB0, pB1, pA0, pA1, NT - 1);
    { float sacc = pB0[0] + pB0[1];
#pragma unroll
      for (int r = 2; r < 16; ++r) sacc += pB0[r];
#pragma unroll
      for (int r = 0; r < 16; ++r) sacc += pB1[r];
      l_reg += sacc; if (FAST) gmax = __builtin_fmaxf(gmax, sacc);
      pw0 = (v4u){PKW(pB0, 0), PKW(pB0, 2), PKW(pB0, 4), PKW(pB0, 6)}; pw1 = (v4u){PKW(pB0, 8), PKW(pB0, 10), PKW(pB0, 12), PKW(pB0, 14)};
      pw2 = (v4u){PKW(pB1, 0), PKW(pB1, 2), PKW(pB1, 4), PKW(pB1, 6)}; pw3 = (v4u){PKW(pB1, 8), PKW(pB1, 10), PKW(pB1, 12), PKW(pB1, 14)};
      const lds_cptr vp_ = vp0 + s_prev * VSL;
#pragma unroll
      for (int i = 0; i < 8; ++i) VRD(i);
      o[0] = MFMA(PAF(0), VFR(0), o[0]); o[1] = MFMA(PAF(0), VFR(4), o[1]); o[0] = MFMA(PAF(1), VFR(1), o[0]); o[1] = MFMA(PAF(1), VFR(5), o[1]);
      o[0] = MFMA(PAF(2), VFR(2), o[0]); o[1] = MFMA(PAF(2), VFR(6), o[1]); o[0] = MFMA(PAF(3), VFR(3), o[0]); o[1] = MFMA(PAF(3), VFR(7), o[1]); }
    { auto rr = __builtin_amdgcn_permlane32_swap(__float_as_uint(l_reg), __float_as_uint(l_reg), false, false); l_reg = __uint_as_float(rr[0]) + __uint_as_float(rr[1]); }
    if (hi == 0) wsf[32 + r32] = l_reg; asm volatile("s_waitcnt lgkmcnt(0)" ::: "memory");
    float rli[16];
#pragma unroll
    for (int r = 0; r < 16; ++r) rli[r] = __builtin_amdgcn_rcpf(wsf[32 + crow(r, hi)]);
    bf16* Yw = Y + (size_t)(q0 + wid * 32) * D + h * 64; bf16* stg = (bf16*)(shm + LDS_OST) + wid * 2048;
#pragma unroll
    for (int r = 0; r < 16; ++r) { const int orow = crow(r, hi);
#pragma unroll
        for (int d0 = 0; d0 < 2; ++d0) stg[orow * 64 + d0 * 32 + r32] = (bf16)f2bf(o[d0][r] * rli[r]); }
    asm volatile("s_waitcnt lgkmcnt(0)" ::: "memory");
#pragma unroll
    for (int i = 0; i < 4; ++i) { const int row = i * 8 + (lane >> 3), ch = lane & 7; *(v4u*)(Yw + (size_t)row * D + ch * 8) = *(const v4u*)(stg + row * 64 + ch * 8); }
    if (FAST) { if (__any(!(gmax < 1.0995116e12f)) && lane == 0) *(LAS int*)((LAS char*)shm + LDS_FLAG) = 1; }
    asm volatile("s_waitcnt vmcnt(0) lgkmcnt(0)\n\ts_barrier" ::: "memory");
#undef DMA_K
#undef DMA_V
#undef ROT
#undef RESC
#undef PKW
#undef PAF
#undef VFR
#undef VRD
#undef KRD
#undef GAPA
#undef GAPM
#undef GAPB
#undef EX
#undef STEP
}
#undef SBAR
#undef PIN
#undef MFMA
#undef WAIT_BAR
}

namespace toep {
typedef short bf16x8 __attribute__((ext_vector_type(8)));
typedef float f32x16 __attribute__((ext_vector_type(16)));
typedef LAS const char* lds_cptr;
constexpr int UB = 46080, WIN = 8704, LDS_U = 0, LDS_W = 2 * UB, LDS_S = LDS_W + 4 * WIN, NCH = 34;
__device__ __forceinline__ v4u funnel(v4u a, v4u b, int cq) {
    unsigned v[8] = {a.x, a.y, a.z, a.w, b.x, b.y, b.z, b.w}; const int c2 = cq >> 1;
    if (c2 & 1) {
#pragma unroll
        for (int k = 0; k < 7; ++k) v[k] = v[k + 1]; }
    if (c2 & 2) {
#pragma unroll
        for (int k = 0; k < 6; ++k) v[k] = v[k + 2]; }
    v4u o;
    if (cq & 1) { o.x = __builtin_amdgcn_alignbit(v[1], v[0], 16); o.y = __builtin_amdgcn_alignbit(v[2], v[1], 16); o.z = __builtin_amdgcn_alignbit(v[3], v[2], 16); o.w = __builtin_amdgcn_alignbit(v[4], v[3], 16); }
    else { o.x = v[0]; o.y = v[1]; o.z = v[2]; o.w = v[3]; }
    return o;
}
struct Stg { v4u a[2], e[2]; };
__device__ __forceinline__ void stage_load(Stg& s, int g, const bf16* GrX, const bf16* GrY, int lane) {
    const int sw = g >= NCH ? 1 : 0, q = g - sw * NCH; const int baseU = L + 1024 - 512 * q, baseL = baseU + 17376;
    const bf16* up = (sw ? GrY : GrX) + baseU; const bf16* lo = (sw ? GrX : GrY) + baseL; const int pe = 64 + (lane % 6);
    s.a[0] = *(const v4u*)(up + 8 * lane); s.e[0] = *(const v4u*)(up + 8 * pe);
    s.a[1] = *(const v4u*)(lo + 8 * lane); s.e[1] = *(const v4u*)(lo + 8 * pe);
}
__device__ __forceinline__ v4u shfl_dn1(v4u x) { return (v4u){(unsigned)__shfl_down((int)x.x, 1), (unsigned)__shfl_down((int)x.y, 1), (unsigned)__shfl_down((int)x.z, 1), (unsigned)__shfl_down((int)x.w, 1)}; }
__device__ __forceinline__ void stage_write(const Stg& s, char* shm, int bq, int cq, int lane) {
#pragma unroll
    for (int w = 0; w < 2; ++w) { char* img = shm + LDS_W + (bq * 2 + w) * WIN + cq * 1088;
        v4u nb = shfl_dn1(s.a[w]); const v4u ne = shfl_dn1(s.e[w]);
        const v4u e0 = (v4u){(unsigned)__builtin_amdgcn_readfirstlane((int)s.e[w].x), (unsigned)__builtin_amdgcn_readfirstlane((int)s.e[w].y), (unsigned)__builtin_amdgcn_readfirstlane((int)s.e[w].z), (unsigned)__builtin_amdgcn_readfirstlane((int)s.e[w].w)};
        if (lane == 63) nb = e0;
        *(v4u*)(img + 16 * lane) = funnel(s.a[w], nb, cq);
        if (lane < 4) *(v4u*)(img + 16 * (64 + lane)) = funnel(s.e[w], ne, cq); }
}
#define TMF(A, B, C) __builtin_amdgcn_mfma_f32_32x32x16_bf16(A, B, C, 0, 0, 0)
#define TSB() __builtin_amdgcn_sched_barrier(0)
template <int NS> __device__ __forceinline__ void chunk_fast(f32x16& a0, f32x16& a1, lds_cptr win, lds_cptr b0) {
    bf16x8 fr[3][6];
#define TLD(s, k) do { const int ao_ = 64 * (15 - (s)), bo_ = -80 * (s); fr[k][0] = *(const LAS bf16x8*)(win + ao_); fr[k][1] = *(const LAS bf16x8*)(win + ao_ + 32); \
        fr[k][2] = *(const LAS bf16x8*)(b0 + bo_); fr[k][3] = *(const LAS bf16x8*)(b0 + bo_ + 32); fr[k][4] = *(const LAS bf16x8*)(b0 + 2560 + bo_); fr[k][5] = *(const LAS bf16x8*)(b0 + 2560 + bo_ + 32); } while (0)
    TLD(0, 0); TLD(1, 1); TSB();
#pragma unroll
    for (int s = 0; s < NS; ++s) { const int k = s % 3;
        if (s + 2 < NS) TLD(s + 2, (s + 2) % 3);
        TSB();
        a0 = TMF(fr[k][0], fr[k][2], a0); a1 = TMF(fr[k][0], fr[k][4], a1); a0 = TMF(fr[k][1], fr[k][3], a0); a1 = TMF(fr[k][1], fr[k][5], a1);
        TSB(); }
#undef TLD
}
__device__ __forceinline__ void chunk_mixed(f32x16& aL, lds_cptr winL, lds_cptr bL, f32x16& aU, lds_cptr winU, lds_cptr bU) {
    bf16x8 fr[2][8];
#define TLD(s, k) do { const int ao_ = 64 * (15 - (s)), bo_ = -80 * (s); fr[k][0] = *(const LAS bf16x8*)(winL + ao_); fr[k][1] = *(const LAS bf16x8*)(winL + ao_ + 32); fr[k][2] = *(const LAS bf16x8*)(winU + ao_); fr[k][3] = *(const LAS bf16x8*)(winU + ao_ + 32); \
        fr[k][4] = *(const LAS bf16x8*)(bL + bo_); fr[k][5] = *(const LAS bf16x8*)(bL + bo_ + 32); fr[k][6] = *(const LAS bf16x8*)(bU + bo_); fr[k][7] = *(const LAS bf16x8*)(bU + bo_ + 32); } while (0)
    TLD(0, 0); TSB();
#pragma unroll
    for (int s = 0; s < 16; ++s) { const int k = s & 1;
        if (s + 1 < 16) TLD(s + 1, k ^ 1);
        TSB();
        aL = TMF(fr[k][0], fr[k][4], aL); aU = TMF(fr[k][2], fr[k][6], aU); aL = TMF(fr[k][1], fr[k][5], aL); aU = TMF(fr[k][3], fr[k][7], aU);
        TSB(); }
#undef TLD
}
#undef TSB
__device__ __forceinline__ void toep_unit(int pair, const bf16* Gr, const bf16* uT, const float* fsum, const float* hbias, bf16* zT, char* shm) {
    const int tid = threadIdx.x, lane = tid & 63, r = lane & 31, h = lane >> 5; const int wid = __builtin_amdgcn_readfirstlane(tid >> 6);
    const int cX = 2 * pair; const bf16* GrX = Gr + (size_t)cX * NG; const bf16* GrY = GrX + NG;
    if (wid < 2) { const int c = cX + wid; float s = 0.f; for (int b = lane; b < 256; b += 64) s += fsum[b * 1024 + c] + fsum[b * 1024 + 512 + c]; s = wave_sum(s); if (lane == 0) ((float*)(shm + LDS_S))[wid] = 1.0f / s; }
#pragma unroll
    for (int ch = 0; ch < 2; ++ch) { const bf16* us = uT + (size_t)(cX + ch) * L; char* ub = shm + LDS_U + ch * UB;
        for (int p = tid; p < 2048; p += 512) *(v4u*)(ub + ((p >> 2) + 32) * 80 + (p & 3) * 16) = *(const v4u*)(us + p * 8);
        if (tid < 320) { const int blk = tid / 5, sub = tid % 5, bi = blk < 32 ? blk : 512 + blk; *(v4u*)(ub + bi * 80 + sub * 16) = (v4u){0u, 0u, 0u, 0u}; } }
    Stg st; stage_load(st, 0, GrX, GrY, lane); stage_write(st, shm, 0, wid, lane);
    asm volatile("s_waitcnt vmcnt(0) lgkmcnt(0)\n\ts_barrier" ::: "memory");
    f32x16 aX0 = f32x16{}, aX1 = f32x16{}, aY0 = f32x16{}, aY1 = f32x16{};
    const lds_cptr shm3 = (lds_cptr)shm; const int ap = 31 - r; const int laneA = (ap & 7) * 1088 + 16 * (ap >> 3) + 16 * h; const int I0 = 2 * wid;
#define CHUNK_ITER(SW, COMPUTE) do { const int g = (SW) * NCH + q, bq = g & 1, dcu = -16 + 16 * q; \
        if (g + 1 < 2 * NCH) stage_load(st, g + 1, GrX, GrY, lane); \
        const lds_cptr winU = shm3 + LDS_W + (bq * 2) * WIN + laneA, winL = winU + WIN; \
        const lds_cptr bU0 = shm3 + LDS_U + ((SW) ? UB : 0) + (32 * I0 + r - dcu + 32) * 80 + 16 * h; \
        const lds_cptr bL0 = shm3 + LDS_U + ((SW) ? 0 : UB) + (32 * I0 + r - (dcu - 543) + 32) * 80 + 16 * h; \
        (void)winU; (void)winL; (void)bU0; (void)bL0; \
        COMPUTE; \
        if (g + 1 < 2 * NCH) { asm volatile("s_waitcnt vmcnt(0)" ::: "memory"); stage_write(st, shm, bq ^ 1, wid, lane); } \
        asm volatile("s_waitcnt lgkmcnt(0)\n\ts_barrier" ::: "memory"); } while (0)
#define SWEEP(SW, U0, U1, L0, L1) do { int q = 0; const int qa = 2 * I0 + 3, qb = 2 * I0 + 5; \
        _Pragma("nounroll") for (; q < qa; ++q) CHUNK_ITER(SW, chunk_fast<16>(U0, U1, winU, bU0)); \
        _Pragma("nounroll") for (; q < qb; ++q) CHUNK_ITER(SW, chunk_mixed(L0, winL, bL0, U1, winU, bU0 + 2560)); \
        _Pragma("nounroll") for (; q < NCH - 1; ++q) CHUNK_ITER(SW, chunk_fast<16>(L0, L1, winL, bL0)); \
        _Pragma("nounroll") for (; q < NCH; ++q) CHUNK_ITER(SW, chunk_fast<15>(L0, L1, winL, bL0)); } while (0)
    SWEEP(0, aX0, aX1, aY0, aY1);
    SWEEP(1, aY0, aY1, aX0, aX1);
#undef SWEEP
#undef CHUNK_ITER
#pragma unroll
    for (int ch = 0; ch < 2; ++ch) { const float invS = ((const float*)(shm + LDS_S))[ch], bias = hbias[cX + ch]; bf16* zrow = zT + (size_t)(cX + ch) * L;
#pragma unroll
        for (int ii = 0; ii < 2; ++ii) { const f32x16& a = ch == 0 ? (ii == 0 ? aX0 : aX1) : (ii == 0 ? aY0 : aY1); const int blk = 32 * (I0 + ii) + r;
#pragma unroll
            for (int g4 = 0; g4 < 4; ++g4) { const v2u uw = *(const v2u*)(shm + LDS_U + ch * UB + (blk + 32) * 80 + 16 * g4 + 8 * h);
                const float z0 = a[4 * g4] * invS + bias * bflo(uw.x), z1 = a[4 * g4 + 1] * invS + bias * bfhi(uw.x), z2 = a[4 * g4 + 2] * invS + bias * bflo(uw.y), z3 = a[4 * g4 + 3] * invS + bias * bfhi(uw.y);
                *(v2u*)(zrow + 32 * blk + 8 * g4 + 4 * h) = (v2u){pk2(z0, z1), pk2(z2, z3)}; } } }
    asm volatile("s_waitcnt lgkmcnt(0)\n\ts_barrier" ::: "memory");
}
#undef TMF
}


namespace hfft {
constexpr int FN = 32768, EX1S = 513;
constexpr size_t LDS_SC = 131584;
__host__ __device__ constexpr float twc(int j) { switch (j) { case 0: return 1.000000000e+00f; case 1: return 9.951847267e-01f; case 2: return 9.807852804e-01f; case 3: return 9.569403357e-01f; case 4: return 9.238795325e-01f; case 5: return 8.819212643e-01f; case 6: return 8.314696123e-01f; case 7: return 7.730104534e-01f; case 8: return 7.071067812e-01f; case 9: return 6.343932842e-01f; case 10: return 5.555702330e-01f; case 11: return 4.713967368e-01f; case 12: return 3.826834324e-01f; case 13: return 2.902846773e-01f; case 14: return 1.950903220e-01f; case 15: return 9.801714033e-02f; case 16: return 6.123233996e-17f; case 17: return -9.801714033e-02f; case 18: return -1.950903220e-01f; case 19: return -2.902846773e-01f; case 20: return -3.826834324e-01f; case 21: return -4.713967368e-01f; case 22: return -5.555702330e-01f; case 23: return -6.343932842e-01f; case 24: return -7.071067812e-01f; case 25: return -7.730104534e-01f; case 26: return -8.314696123e-01f; case 27: return -8.819212643e-01f; case 28: return -9.238795325e-01f; case 29: return -9.569403357e-01f; case 30: return -9.807852804e-01f; case 31: return -9.951847267e-01f; default: return 0.f; } }
__host__ __device__ constexpr float tws(int j) { switch (j) { case 0: return -0.000000000e+00f; case 1: return -9.801714033e-02f; case 2: return -1.950903220e-01f; case 3: return -2.902846773e-01f; case 4: return -3.826834324e-01f; case 5: return -4.713967368e-01f; case 6: return -5.555702330e-01f; case 7: return -6.343932842e-01f; case 8: return -7.071067812e-01f; case 9: return -7.730104534e-01f; case 10: return -8.314696123e-01f; case 11: return -8.819212643e-01f; case 12: return -9.238795325e-01f; case 13: return -9.569403357e-01f; case 14: return -9.807852804e-01f; case 15: return -9.951847267e-01f; case 16: return -1.000000000e+00f; case 17: return -9.951847267e-01f; case 18: return -9.807852804e-01f; case 19: return -9.569403357e-01f; case 20: return -9.238795325e-01f; case 21: return -8.819212643e-01f; case 22: return -8.314696123e-01f; case 23: return -7.730104534e-01f; case 24: return -7.071067812e-01f; case 25: return -6.343932842e-01f; case 26: return -5.555702330e-01f; case 27: return -4.713967368e-01f; case 28: return -3.826834324e-01f; case 29: return -2.902846773e-01f; case 30: return -1.950903220e-01f; case 31: return -9.801714033e-02f; default: return 0.f; } }
__host__ __device__ constexpr int brev(int i, int bits) { return bits == 6 ? (((i & 1) << 5) | ((i & 2) << 3) | ((i & 4) << 1) | ((i & 8) >> 1) | ((i & 16) >> 3) | ((i & 32) >> 5)) : (((i & 1) << 2) | (i & 2) | ((i & 4) >> 2)); }
template <int R, int LOG, int OFF> __device__ __forceinline__ void fft_dif(float (&re)[64], float (&im)[64]) {
#pragma unroll
    for (int s = 0; s < LOG; ++s) { const int half = R >> (s + 1);
#pragma unroll
        for (int b = 0; b < R; b += 2 * half)
#pragma unroll
            for (int j = 0; j < half; ++j) { const int i0 = OFF + b + j, i1 = i0 + half; const int tw = j * (32 / half); const float c = twc(tw), sn = tws(tw);
                const float tr = re[i0] - re[i1], ti = im[i0] - im[i1]; re[i0] += re[i1]; im[i0] += im[i1];
                if (tw == 0) { re[i1] = tr; im[i1] = ti; }
                else if (tw == 16) { re[i1] = ti; im[i1] = -tr; }
                else { re[i1] = tr * c - ti * sn; im[i1] = tr * sn + ti * c; }
                if ((j & 3) == 3 || j == half - 1) __builtin_amdgcn_sched_barrier(0); } }
}
__device__ __forceinline__ void twiddle64(float (&re)[64], float (&im)[64], float wr, float wi) {
    float cr = wr, ci = wi;
#pragma unroll
    for (int k = 1; k < 64; ++k) { const int i = brev(k, 6); const float xr = re[i], xi = im[i]; re[i] = xr * cr - xi * ci; im[i] = xr * ci + xi * cr;
        if (k < 63) { const float nr = cr * wr - ci * wi; ci = cr * wi + ci * wr; cr = nr; } if ((k & 7) == 7) __builtin_amdgcn_sched_barrier(0); }
}
#define XAT(B0, B1, C) (*(((C) < 16384) ? ((B0) + (C)) : ((B1) + ((C) - 16384))))
__device__ __forceinline__ void fft32k(float (&re)[64], float (&im)[64], LAS float* X, const float* twa, int tid_in) {
#define OPQ_TID() int tid = tid_in; asm volatile("" : "+v"(tid)); const int k1 = tid & 63, hi = tid >> 6; (void)k1; (void)hi
    float wr, wi; { OPQ_TID(); wr = twa[2 * tid]; wi = twa[2 * tid + 1]; }
#ifdef FFT_STLOOP
#pragma nounroll
#else
#pragma unroll
#endif
    for (int st = 0; st < 2; ++st) {
    fft_dif<64, 6, 0>(re, im);
    twiddle64(re, im, wr, wi);
    if (st == 0) {
    { OPQ_TID(); LAS float* w0 = X + tid; LAS float* w1 = w0 + 16384; asm volatile("" : "+v"(w1)); LAS float* r0 = X + k1 * EX1S + hi;
#pragma unroll
    for (int i = 0; i < 64; ++i) XAT(w0, w1, brev(i, 6) * EX1S) = re[i];
    __syncthreads();
#pragma unroll
    for (int m1 = 0; m1 < 64; ++m1) re[m1] = r0[8 * m1];
    __syncthreads();
#pragma unroll
    for (int i = 0; i < 64; ++i) XAT(w0, w1, brev(i, 6) * EX1S) = im[i];
    __syncthreads();
#pragma unroll
    for (int m1 = 0; m1 < 64; ++m1) im[m1] = r0[8 * m1];
    __syncthreads(); }
    { OPQ_TID(); wr = twa[2 * 64 * hi]; wi = twa[2 * 64 * hi + 1]; }
    } else {
    { OPQ_TID(); LAS float* w0 = X + hi * 64 + k1; LAS float* w1 = w0 + 16384; asm volatile("" : "+v"(w1)); LAS float* r0 = X + hi * 4096 + k1;
#pragma unroll
    for (int i = 0; i < 64; ++i) XAT(w0, w1, brev(i, 6) * 512) = re[i];
    __syncthreads();
#pragma unroll
    for (int e = 0; e < 8; ++e)
#pragma unroll
        for (int m2 = 0; m2 < 8; ++m2) re[8 * e + m2] = r0[(e * 8 + m2) * 64];
    __syncthreads();
#pragma unroll
    for (int i = 0; i < 64; ++i) XAT(w0, w1, brev(i, 6) * 512) = im[i];
    __syncthreads();
#pragma unroll
    for (int e = 0; e < 8; ++e)
#pragma unroll
        for (int m2 = 0; m2 < 8; ++m2) im[8 * e + m2] = r0[(e * 8 + m2) * 64];
    __syncthreads(); }
    } }
    fft_dif<8, 3, 0>(re, im); fft_dif<8, 3, 8>(re, im); fft_dif<8, 3, 16>(re, im); fft_dif<8, 3, 24>(re, im);
    fft_dif<8, 3, 32>(re, im); fft_dif<8, 3, 40>(re, im); fft_dif<8, 3, 48>(re, im); fft_dif<8, 3, 56>(re, im);
#undef OPQ_TID
}
__device__ __forceinline__ void reg_barrier(float (&re)[64], float (&im)[64]) {
#pragma unroll
    for (int i = 0; i < 64; i += 8) { asm volatile("" : "+v"(re[i]), "+v"(re[i + 1]), "+v"(re[i + 2]), "+v"(re[i + 3]), "+v"(re[i + 4]), "+v"(re[i + 5]), "+v"(re[i + 6]), "+v"(re[i + 7]));
        asm volatile("" : "+v"(im[i]), "+v"(im[i + 1]), "+v"(im[i + 2]), "+v"(im[i + 3]), "+v"(im[i + 4]), "+v"(im[i + 5]), "+v"(im[i + 6]), "+v"(im[i + 7])); }
    asm volatile("" ::: "memory"); __builtin_amdgcn_sched_barrier(0);
}
typedef _Float16 h2_t __attribute__((ext_vector_type(2)));
__device__ __forceinline__ unsigned ldg_off(const unsigned* base, unsigned off) { asm volatile("" : "+v"(off)); return *(const unsigned*)((const char*)base + off); }
__device__ __forceinline__ void stg_off(unsigned* base, unsigned off, unsigned v) { asm volatile("" : "+v"(off)); *(unsigned*)((char*)base + off) = v; }
__device__ __forceinline__ void conv_pair(const bf16* GrA, const bf16* GrB, const bf16* uA, const bf16* uB, bf16* zA, bf16* zB, float invSA, float invSB, float biasA, float biasB,
                                          const float* twa, unsigned* scr, LAS float* X, int tid_in, int p_lo, int p_hi) {
#define OPQ_T() int tid = tid_in; asm volatile("" : "+v"(tid))
#pragma nounroll
    for (int pass = p_lo; pass < p_hi; ++pass) {
    float re[64], im[64];
    if (pass == 0) {
    { OPQ_T(); const unsigned tr = 511u - (unsigned)tid;
#pragma unroll
    for (int n1 = 0; n1 < 64; ++n1) { float va, vb;
        if (n1 < 32) { va = bf2f(NTL((GrA + (LAGMAX - 511 - 512 * n1)) + tr)); vb = bf2f(NTL((GrB + (LAGMAX - 511 - 512 * n1)) + tr)); }
        else { va = bf2f(NTL((GrA + (LAGMAX - 511 + 2 * L - 512 * n1)) + tr)); vb = bf2f(NTL((GrB + (LAGMAX - 511 + 2 * L - 512 * n1)) + tr)); if (n1 == 32 && tid == 0) { va = 0.f; vb = 0.f; } }
        re[n1] = va; im[n1] = vb; } }
    } else if (pass == 1) {
    { OPQ_T();
#pragma unroll
    for (int n1 = 0; n1 < 64; ++n1) { re[n1] = (n1 < 32) ? bf2f((uA + 512 * n1)[tid]) : 0.f; im[n1] = (n1 < 32) ? bf2f((uB + 512 * n1)[tid]) : 0.f; } }
    } else {
    { OPQ_T(); const unsigned bb = (unsigned)((tid & 63) + 512 * ((tid >> 6) & 7)), bq = 3647u - bb, ob = bb << 2, oq = bq << 2;
      const LAS unsigned* o0 = (const LAS unsigned*)X + bb; const LAS unsigned* o1 = o0 + 16384; asm volatile("" : "+v"(o1));
      const LAS unsigned* p0 = (const LAS unsigned*)X + bq; const LAS unsigned* p1 = p0 + 16384; asm volatile("" : "+v"(p1));
#define PW_GLOAD(CH, WK, WP) { _Pragma("unroll") for (int q = 0; q < 8; ++q) { const int c = 64 * (CH) + 4096 * brev(q, 3); \
        if (c == 0) { const unsigned ip = (unsigned)(FN - (int)bb) & (unsigned)(FN - 1); WP[q] = ldg_off(scr, ip << 2); } else { WP[q] = ldg_off(scr, oq + 4u * (unsigned)(FN - 3647 - c)); } \
        WK[q] = ldg_off(scr, ob + 4u * (unsigned)c); } }
    unsigned nk[8], np[8]; PW_GLOAD(0, nk, np)
#pragma unroll
    for (int ch = 0; ch < 8; ++ch) {
        unsigned cz[8], cq[8], ck[8], cp[8];
#pragma unroll
        for (int q = 0; q < 8; ++q) { ck[q] = nk[q]; cp[q] = np[q]; }
        if (ch < 7) PW_GLOAD(ch + 1, nk, np)
#pragma unroll
        for (int q = 0; q < 8; ++q) { const int c = 64 * ch + 4096 * brev(q, 3);
            if (c == 0) { const unsigned ip = (unsigned)(FN - (int)bb) & (unsigned)(FN - 1); cq[q] = ((const LAS unsigned*)X)[ip]; }
            else { cq[q] = XAT(p0, p1, FN - 3647 - c); }
            cz[q] = XAT(o0, o1, c); }
        __builtin_amdgcn_sched_barrier(0);
#pragma unroll
        for (int q = 0; q < 8; ++q) { const int r = 8 * ch + q;
            const h2_t zo = __builtin_bit_cast(h2_t, cz[q]), zp = __builtin_bit_cast(h2_t, cq[q]), wk = __builtin_bit_cast(h2_t, ck[q]), wp = __builtin_bit_cast(h2_t, cp[q]);
            const float zr = (float)zo.y, zi = (float)zo.x, pr = (float)zp.y, pi = (float)zp.x, wr = (float)wk.x, wi = (float)wk.y, qr = (float)wp.x, qi = (float)wp.y;
            const float uar = zr + pr, uai = zi - pi, ubr = zi + pi, ubi = pr - zr;
            const float gar = wr + qr, gai = wi - qi, gbr = wi + qi, gbi = qr - wr;
            re[r] = (uar * gar - uai * gai) - (ubr * gbi + ubi * gbr);
            im[r] = -((uar * gai + uai * gar) + (ubr * gbr - ubi * gbi)); }
        __builtin_amdgcn_sched_barrier(0); } }
#undef PW_GLOAD
    __syncthreads();
    reg_barrier(re, im);
    { OPQ_T(); const int k1 = tid & 63, jg = tid >> 6; LAS float* w0 = X + jg * 512 + k1; LAS float* w1 = w0 + 16384; asm volatile("" : "+v"(w1)); LAS float* r0 = X + tid; LAS float* r1 = r0 + 16384; asm volatile("" : "+v"(r1));
#pragma unroll
    for (int e = 0; e < 8; ++e)
#pragma unroll
        for (int i = 0; i < 8; ++i) XAT(w0, w1, brev(i, 3) * 4096 + 64 * e) = re[8 * e + i];
    __syncthreads();
#pragma unroll
    for (int n1 = 0; n1 < 64; ++n1) re[n1] = XAT(r0, r1, n1 * 512);
    __syncthreads();
#pragma unroll
    for (int e = 0; e < 8; ++e)
#pragma unroll
        for (int i = 0; i < 8; ++i) XAT(w0, w1, brev(i, 3) * 4096 + 64 * e) = im[8 * e + i];
    __syncthreads();
#pragma unroll
    for (int n1 = 0; n1 < 64; ++n1) im[n1] = XAT(r0, r1, n1 * 512);
    __syncthreads(); }
    }
    reg_barrier(re, im);
    fft32k(re, im, X, twa, tid_in);
    reg_barrier(re, im);
    if (pass == 0) {
    { OPQ_T(); const unsigned ob = (unsigned)((tid & 63) + 512 * ((tid >> 6) & 7)) << 2;
#pragma unroll
    for (int e = 0; e < 8; ++e)
#pragma unroll
        for (int i = 0; i < 8; ++i) { const h2_t hv = {(_Float16)(re[8 * e + i] * 0.015625f), (_Float16)(im[8 * e + i] * 0.015625f)}; stg_off(scr, ob + 4u * (unsigned)(64 * e + 4096 * brev(i, 3)), __builtin_bit_cast(unsigned, hv)); } }
    } else if (pass == 1) {
    { OPQ_T(); LAS unsigned* w0 = (LAS unsigned*)X + (tid & 63) + 512 * (tid >> 6); LAS unsigned* w1 = w0 + 16384; asm volatile("" : "+v"(w1));
#pragma unroll
    for (int e = 0; e < 8; ++e)
#pragma unroll
        for (int i = 0; i < 8; ++i) { const h2_t hv = {(_Float16)(im[8 * e + i] * 0.015625f), (_Float16)(re[8 * e + i] * 0.015625f)}; XAT(w0, w1, 64 * e + 4096 * brev(i, 3)) = __builtin_bit_cast(unsigned, hv); } }
    asm volatile("s_waitcnt vmcnt(0)" ::: "memory");
    __syncthreads();
    } else {
    OPQ_T(); const int k1 = tid & 63, jg = tid >> 6;
    const float scA = invSA * (1024.0f / (float)FN), scB = -invSB * (1024.0f / (float)FN);
#pragma unroll
    for (int e = 0; e < 8; ++e)
#pragma unroll
        for (int i = 0; i < 8; i += 2) { const int tc = 64 * e + 4096 * brev(i, 3), tv = k1 + 512 * jg;
            (zA + tc)[tv] = (bf16)f2bf(re[8 * e + i] * scA + biasA * bf2f((uA + tc)[tv])); (zB + tc)[tv] = (bf16)f2bf(im[8 * e + i] * scB + biasB * bf2f((uB + tc)[tv])); }
    }
    asm volatile("" ::: "memory"); __builtin_amdgcn_sched_barrier(0);
    }
#undef OPQ_T
}
__device__ __forceinline__ void conv_unit(int pair, const bf16* Gr, const bf16* uT, const float* fsum, const float* hbias, bf16* zT, const float* twa, unsigned* scr, char* shm, int wid, int p_lo, int p_hi) {
    const int lane = fresh_lane(), tid = wid * 64 + lane; LAS float* X = (LAS float*)shm; LAS float* SC = (LAS float*)(shm + LDS_SC);
    const int cX = 2 * pair;
    if (wid < 2 && p_hi == 3) { const int c = cX + wid; float s = 0.f; for (int b = lane; b < 256; b += 64) s += fsum[b * 1024 + c] + fsum[b * 1024 + 512 + c]; s = wave_sum(s); if (lane == 0) SC[wid] = 1.0f / s; }
    __syncthreads();
    conv_pair(Gr + (size_t)cX * NG, Gr + (size_t)(cX + 1) * NG, uT + (size_t)cX * L, uT + (size_t)(cX + 1) * L, zT + (size_t)cX * L, zT + (size_t)(cX + 1) * L, SC[0], SC[1], hbias[cX], hbias[cX + 1], twa, scr, X, tid, p_lo, p_hi);
    __syncthreads();
}
}

#define XB_TMO      128
#define XB_XCNT(j)  (256  + 64 * (j))
#define XB_XSUB(j)  (1280 + 64 * (j))
#define XB_XGEN(j)  (2304 + 64 * (j))
#define XB_TOP      3328
#define XB_TOPGEN   3392
#define XCD_BAR_WORDS 3456
#define XB_SPIN_CAP (1u << 18)
__device__ __forceinline__ unsigned xb_ld(unsigned* p)              { return __hip_atomic_load(p, __ATOMIC_RELAXED, __HIP_MEMORY_SCOPE_AGENT); }
__device__ __forceinline__ unsigned xb_add(unsigned* p, unsigned v) { return __hip_atomic_fetch_add(p, v, __ATOMIC_RELAXED, __HIP_MEMORY_SCOPE_AGENT); }
__device__ __forceinline__ unsigned xb_xcc_id() { return (unsigned)__builtin_amdgcn_s_getreg((3 << 11) | 20) & 0xFu; }
#define XB_SPIN(cond, bar) do { unsigned _sp = 0; while (cond) { __builtin_amdgcn_s_sleep(1); \
    if ((++_sp & 255u) == 0u) { if (xb_ld(&(bar)[XB_TMO])) break; if (_sp > XB_SPIN_CAP) { atomicAdd(&(bar)[XB_TMO], 1u); break; } } } } while (0)
struct XcdBarrier { unsigned* bar; unsigned x; volatile LAS unsigned* st; };
__device__ __forceinline__ XcdBarrier xcd_barrier_post(unsigned* bar, volatile LAS unsigned* st) {
    XcdBarrier b; b.bar = bar; b.x = xb_xcc_id(); b.st = st;
    if (threadIdx.x == 0) (void)xb_add(&bar[XB_XCNT(b.x)], 1u);
    return b;
}
__device__ __forceinline__ void xcd_barrier_complete(unsigned* bar, unsigned x, unsigned& nloc, unsigned& nx, unsigned& xmask) {
    const unsigned G = gridDim.x * gridDim.y * gridDim.z;
    unsigned sum, cnt, mine, msk, sp = 0u;
    for (;;) {
        sum = 0u; cnt = 0u; mine = 0u; msk = 0u;
#pragma unroll
        for (unsigned j = 0; j < 16; ++j) { const unsigned c = xb_ld(&bar[XB_XCNT(j)]); sum += c; cnt += (c > 0u) ? 1u : 0u; msk |= (c > 0u) ? (1u << j) : 0u; mine = (j == x) ? c : mine; }
        if (sum == G) break;
        __builtin_amdgcn_s_sleep(1);
        if ((++sp & 255u) == 0u) { if (xb_ld(&bar[XB_TMO])) break; if (sp > XB_SPIN_CAP) { atomicAdd(&bar[XB_TMO], 1u); break; } }
    }
    nloc = mine > 0u ? mine : 1u; nx = cnt > 0u ? cnt : 1u; xmask = msk;
}
__device__ __forceinline__ void xcd_barrier(const XcdBarrier& b) {
    asm volatile("s_waitcnt vmcnt(0)" ::: "memory");
    __syncthreads();
    if (threadIdx.x == 0) {
        unsigned* bar = b.bar;
        __builtin_amdgcn_s_waitcnt(0);
        asm volatile("buffer_inv sc1" ::: "memory");
        unsigned nloc = b.st[0], nx = b.st[1];
        if (nloc == 0u) { unsigned xm; xcd_barrier_complete(bar, b.x, nloc, nx, xm); b.st[0] = nloc; b.st[1] = nx; b.st[2] = xm; }
        const unsigned old = xb_add(&bar[XB_XSUB(b.x)], 1u);
        const unsigned gen = old / nloc;
        if (old + 1u == (gen + 1u) * nloc) {
            __builtin_amdgcn_fence(__ATOMIC_RELEASE, "agent");
            asm volatile("s_waitcnt vmcnt(0)" ::: "memory");
            const unsigned og = xb_add(&bar[XB_TOP], 1u);
            const unsigned tg = og / nx;
            if (og + 1u == (tg + 1u) * nx) xb_add(&bar[XB_TOPGEN], 1u);
            else XB_SPIN(xb_ld(&bar[XB_TOPGEN]) == tg, bar);
            xb_add(&bar[XB_XGEN(b.x)], 1u);
            asm volatile("s_waitcnt vmcnt(0)" ::: "memory");
        } else {
            XB_SPIN(xb_ld(&bar[XB_XGEN(b.x)]) == gen, bar);
            asm volatile("s_waitcnt vmcnt(0)" ::: "memory");
        }
    }
    __syncthreads();
}
__device__ __forceinline__ void xcd_arrive(const XcdBarrier& b) {
    asm volatile("s_waitcnt vmcnt(0)" ::: "memory");
    __syncthreads();
    if (threadIdx.x == 0) {
        unsigned* bar = b.bar;
        __builtin_amdgcn_s_waitcnt(0);
        unsigned nloc = b.st[0], nx = b.st[1];
        if (nloc == 0u) { unsigned xm; xcd_barrier_complete(bar, b.x, nloc, nx, xm); b.st[0] = nloc; b.st[1] = nx; b.st[2] = xm; }
        const unsigned old = xb_add(&bar[XB_XSUB(b.x)], 1u);
        const unsigned gen = old / nloc; b.st[3] = gen;
        if (old + 1u == (gen + 1u) * nloc) {
            __builtin_amdgcn_fence(__ATOMIC_RELEASE, "agent");
            asm volatile("s_waitcnt vmcnt(0)" ::: "memory");
            const unsigned og = xb_add(&bar[XB_TOP], 1u);
            const unsigned tg = og / nx;
            if (og + 1u == (tg + 1u) * nx) { const unsigned xm = b.st[2]; (void)xb_add(&bar[XB_TOPGEN], 1u);
#pragma unroll
                for (unsigned j = 0; j < 16; ++j) if ((xm >> j) & 1u) (void)xb_add(&bar[XB_XGEN(j)], 1u); }
        }
    }
    __syncthreads();
}
__device__ __forceinline__ void xcd_wait(const XcdBarrier& b) {
    asm volatile("s_waitcnt vmcnt(0)" ::: "memory");
    __syncthreads();
    if (threadIdx.x == 0) {
        unsigned* bar = b.bar; const unsigned gen = b.st[3];
        __builtin_amdgcn_s_waitcnt(0);
        asm volatile("buffer_inv sc1" ::: "memory");
        XB_SPIN(xb_ld(&bar[XB_XGEN(b.x)]) == gen, bar);
        asm volatile("s_waitcnt vmcnt(0)" ::: "memory");
    }
    __syncthreads();
}

constexpr int LDS_BYTES = 135168;
__global__ void __launch_bounds__(512, 2) mk(Args args) {
    extern __shared__ __attribute__((aligned(16))) unsigned char lds[];
    Frame F; F.ws = args.ws; F.lds = (LAS unsigned char*)lds;
    F.tid = threadIdx.x; F.lane = F.tid & 63; F.wave = __builtin_amdgcn_readfirstlane(F.tid >> 6);
    F.G = gridDim.x; { const int bx = blockIdx.x; F.vcu = (F.G % 8 == 0) ? (bx % 8) * (F.G / 8) + bx / 8 : bx; }
    F.gw = F.vcu * 8 + F.wave; F.NGW = F.G * 8;
    const int lo = args.ph_lo, hi = args.ph_hi;
    { volatile LAS unsigned* mz = (volatile LAS unsigned*)(F.lds + 133120); if (F.tid < 16) mz[F.tid] = 0u; }
    __syncthreads();
    XcdBarrier bar; bar.bar = (unsigned*)(F.ws + WS_CTL) + args.li * 4096; bar.x = 0; bar.st = nullptr;
    if (hi - lo > 1) bar = xcd_barrier_post((unsigned*)(F.ws + WS_CTL) + args.li * 4096, (volatile LAS unsigned*)(F.lds + 133120));
#define SEAM(k) do { if (IN(k) && IN((k) + 1)) xcd_barrier(bar); } while (0)
#define SEAMX(k, j) do { if (IN(k) && IN(j)) xcd_barrier(bar); } while (0)
#ifndef PHMASK
#define PHMASK 0xffffff
#endif
#define IN(k) (((PHMASK >> (k)) & 1) && lo <= (k) && (k) < hi)
    if (IN(0)) { p0_mod(F, args); p0_weights(F, args, 0, P0W_IN, F.gw, F.NGW, false); }
    if (!(IN(0) && IN(1))) { SEAM(0); }
    if (IN(1)) { p0b_h1(F, args); }
    const bool split12 = IN(1) && IN(2);
    if (split12) { xcd_arrive(bar); p0_filter(F, args, (int)blockIdx.x, F.G); xcd_wait(bar); } else { SEAM(1); }
    if (IN(2)) { pg8::InOrder S; S.init((const bf16*)(F.ws + WS_H1), D, (const bf16*)(F.ws + WS_WIN), D, M, F.G, (int)blockIdx.x); pg8::EpiIn E{F.ws};
        pg8::gemm_phase<pg8::EpiIn, pg8::InOrder, false>(F.lds, D, S, E);
        { pg8::InHalfOrder S2; S2.init((const bf16*)(F.ws + WS_H1), D, (const bf16*)(F.ws + WS_WIN), D, M, F.G, (int)blockIdx.x); pg8::gemm_phase<pg8::EpiIn, pg8::InHalfOrder, false>(F.lds, D, S2, E); }
        { const int nlong = (int)(((long)(M / 256) * (pg8::InOrder::NF + 2)) % F.G); const bool all = (nlong == 0);
          if (all || (int)blockIdx.x >= nlong) { const int bi = all ? (int)blockIdx.x : (int)blockIdx.x - nlong, nb = all ? F.G : F.G - nlong;
              __syncthreads();
              p0_weights(F, args, P0W_IN, P0W_ALL, bi * 8 + F.wave, nb * 8, true); if (!split12) p0_filter(F, args, bi, nb); } } }
    SEAM(2);
    if (IN(3)) { p2_prep(F, args, (unsigned char*)args.out); }
    const bool split34 = IN(3) && IN(4); volatile LAS unsigned* wf34 = (volatile LAS unsigned*)(F.lds + 133136);
    if (F.tid == 0) *wf34 = split34 ? 1u : 0u;
    if (split34) xcd_arrive(bar); else __syncthreads();
    if (IN(4)) {
#if !defined(PH4SEL) || PH4SEL == 0
        { pg8::DenseOrder S; S.init((const bf16*)(F.ws + WS_PROJL), PL, (const bf16*)(F.ws + WS_WUQ), QL, M, 768, F.G, (int)blockIdx.x); pg8::EpiQ E{F.ws, (bf16*)((unsigned char*)args.out + DO_Q), &bar, wf34};
          pg8::gemm_phase<pg8::EpiQ, pg8::DenseOrder, false>(F.lds, QL, S, E); }
#endif
#if !defined(PH4SEL) || PH4SEL == 1
        { pg8::DenseOrder S; S.init((const bf16*)(F.ws + WS_PROJL) + 384, PL, (const bf16*)(F.ws + WS_WUKV), KVL, M, 1024, F.G, (int)blockIdx.x); pg8::EpiKV E{F.ws, &bar, wf34};
          pg8::gemm_phase<pg8::EpiKV, pg8::DenseOrder, false>(F.lds, KVL, S, E); }
#endif
        PG8_LATE_WAIT(&bar, wf34);
    }
    if (IN(4)) {
        for (int u = blockIdx.x; u < 256; u += F.G) hfft::conv_unit(u, (const bf16*)(F.ws + WS_GR), (const bf16*)((unsigned char*)args.out + DO_UT), (const float*)(F.ws + WS_FSUM), args.in[I_HBIAS], (2 * u < 256) ? (bf16*)(F.ws + WS_ZT_LO) : (bf16*)((unsigned char*)args.out + DO_ZT_HI) - (size_t)256 * L, (const float*)(F.ws + WS_TWA), (unsigned*)(F.ws + WS_FSCR) + (size_t)u * 32768, (char*)lds, F.wave, 0, 3);
    }
    SEAM(4);
    if (IN(5)) {
        const bf16* Q = (const bf16*)((unsigned char*)args.out + DO_Q); const bf16* Kb = (const bf16*)(F.ws + WS_K); const bf16* Vb = (const bf16*)(F.ws + WS_V); bf16* Y = (bf16*)(F.ws + WS_YCAT) + 512;
        p5_post(F, (unsigned char*)args.out); __syncthreads();
        for (int u = blockIdx.x; u < 512; u += F.G) { att2::attn_unit<8, true>(u & 7, u >> 3, Q, Kb, Vb, Y, (char*)lds);
            const int redo = __builtin_amdgcn_readfirstlane(*(volatile LAS int*)(lds + att2::LDS_FLAG)); __syncthreads();
            if (redo) att2::attn_unit<8, false>(u & 7, u >> 3, Q, Kb, Vb, Y, (char*)lds); }
    }
    SEAMX(5, 7);
    if (IN(7)) { pg8::DenseOrder S; S.init((const bf16*)(F.ws + WS_YCAT), D, (const bf16*)(F.ws + WS_WCAT), D, M, D, F.G, (int)blockIdx.x); pg8::EpiMix E{F.ws};
        pg8::gemm_phase<pg8::EpiMix, pg8::DenseOrder, false, true>(F.lds, D, S, E); }
    SEAMX(7, 9);
    if (IN(9)) { pg8::DenseOrder S; S.init((const bf16*)(F.ws + WS_MIX), D, (const bf16*)(F.ws + WS_WMIX), D, M, D, F.G, (int)blockIdx.x); pg8::EpiX1 E{F.ws, args.in[I_X], (bf16*)(F.ws + WS_X1B)};
        pg8::gemm_phase<pg8::EpiX1, pg8::DenseOrder, false>(F.lds, D, S, E); }
    const bool split910 = IN(9) && IN(10), split1112 = IN(10) && IN(11) && IN(12);
    if (split910) xcd_arrive(bar);
    if (IN(10)) { constexpr int KSH = 2;
        if (split910) { p8_convert(F, args, 0, 0, KSH); xcd_wait(bar); }
        p8_route(F, args, (const bf16*)(F.ws + WS_X1B)); p8_convert(F, args, 0, split910 ? KSH : 0, 1 << 20);
        if (!split1112) p8_convert(F, args, 1, 0, 1 << 20); }
      if (!(IN(10) && IN(11))) { SEAM(10); }
    if (IN(11)) { p8b_slots(F); }
    if (split1112) { xcd_arrive(bar); p8_convert(F, args, 1, 0, 1 << 20); xcd_wait(bar); } else { SEAM(11); }
    if (IN(12)) { LAS int* lo = (LAS int*)(F.lds + 132096); if (F.tid < 224) lo[F.tid] = ((const int*)(F.ws + WS_LOG))[F.tid]; __syncthreads();
        pg8::MoeOrder S{(const bf16*)(F.ws + WS_H2), (const bf16*)(F.ws + WS_WE), (const int*)(F.ws + WS_STOK), lo, D, D, 2, F.G, (int)blockIdx.x, 0}; pg8::EpiAct E{F.ws};
        pg8::gemm_phase<pg8::EpiAct, pg8::MoeOrder, true>(F.lds, D, S, E); }
    SEAM(12);
    if (IN(13)) { LAS int* lo = (LAS int*)(F.lds + 132096); if (F.tid < 224) lo[F.tid] = ((const int*)(F.ws + WS_LOG))[F.tid]; __syncthreads();
        pg8::MoeOrder S{(const bf16*)(F.ws + WS_ACT), (const bf16*)(F.ws + WS_WE), nullptr, lo, DEXP, DEXP, 4, F.G, (int)blockIdx.x, (size_t)512 * 1024}; pg8::EpiY E{F.ws};
        pg8::gemm_phase<pg8::EpiY, pg8::MoeOrder, false>(F.lds, DEXP, S, E); }
    SEAM(13);
    if (IN(14)) { p11_final(F, args, args.out); }
#undef IN
}

enum { E_IN = 0, E_Q, E_KV, E_M1, E_M2, E_X1, E_ACT, E_Y };
struct NG_ { const bf16* A; int lda; const bf16* BT; int ldb; int K; int N; unsigned char* ws; unsigned char* dout; const float* x; };
__device__ __forceinline__ float ndot(const bf16* a, const bf16* b, int K) { float s = 0.f; for (int k = 0; k < K; k += 2) { const unsigned wa = *(const unsigned*)(a + k), wb = *(const unsigned*)(b + k); s += bflo(wa) * bflo(wb) + bfhi(wa) * bfhi(wb); } return s; }
template <int MODE> __global__ void __launch_bounds__(256) k_ngemm(NG_ p) {
    const int col = blockIdx.x * 256 + threadIdx.x, row = blockIdx.y; if (col >= p.N) return;
    unsigned char* ws = p.ws; const float* mod = (const float*)(ws + WS_MOD);
    if (MODE == E_IN) { const float acc = ndot(p.A + (size_t)row * p.lda, p.BT + (size_t)col * p.ldb, p.K);
        if (col < 1536) ((bf16*)(ws + WS_PROJH))[(size_t)row * 1536 + col] = (bf16)f2bf(acc);
        else if (col < 2304) ((bf16*)(ws + WS_PROJL))[(size_t)row * PL + col - 1536] = (bf16)f2bf(acc);
        else ((bf16*)(ws + WS_GATES))[(size_t)row * 2048 + col - 2304] = (bf16)f2bf(sigmoidf_(acc)); }
    if (MODE == E_Q) { const int h = col / 96, d = col % 96; const float sc = C2 * ((const float*)(ws + WS_RSQ))[row]; const float* ct = (const float*)(ws + WS_ROPE); const float* st = ct + L * 16;
        float acc = ndot(p.A + (size_t)row * p.lda, p.BT + (size_t)col * p.ldb, p.K), o = acc;
        if (d >= 64) { const int i = (d - 64) & 15; const int pc = h * 96 + (d < 80 ? d + 16 : d - 16); const float other = ndot(p.A + (size_t)row * p.lda, p.BT + (size_t)pc * p.ldb, p.K);
            const float cs = ct[row * 16 + i], sn = st[row * 16 + i]; o = d < 80 ? acc * cs - other * sn : other * sn + acc * cs; }
        ((bf16*)(p.dout + DO_Q))[(size_t)row * 768 + col] = (bf16)f2bf(o * sc); }
    if (MODE == E_KV) { const float acc = ndot(p.A + (size_t)row * p.lda, p.BT + (size_t)col * p.ldb, p.K) * ((const float*)(ws + WS_RSKV))[row];
        if (col < 512) ((bf16*)(ws + WS_K))[(size_t)row * 768 + (col >> 6) * 96 + (col & 63)] = (bf16)f2bf(acc); else ((bf16*)(ws + WS_V))[(size_t)row * 512 + col - 512] = (bf16)f2bf(acc); }
    if (MODE == E_M1) { const float acc = ndot(p.A + (size_t)row * p.lda, p.BT + (size_t)col * p.ldb, p.K);
        ((float*)p.dout)[(size_t)row * D + col] = acc * bf2f(((const bf16*)(ws + WS_GATES))[(size_t)row * 2048 + col]); }
    if (MODE == E_M2) { const float acc = ndot(p.A + (size_t)row * p.lda, p.BT + (size_t)col * p.ldb, p.K);
        ((bf16*)(ws + WS_MIX))[(size_t)row * D + col] = (bf16)f2bf(((const float*)p.dout)[(size_t)row * D + col] + acc * bf2f(((const bf16*)(ws + WS_GATES))[(size_t)row * 2048 + 1024 + col])); }
    if (MODE == E_X1) { const float acc = ndot(p.A + (size_t)row * p.lda, p.BT + (size_t)col * p.ldb, p.K);
        ((float*)p.dout)[(size_t)row * D + col] = p.x[(size_t)row * D + col] + mod[2048 + col] * acc; }
    if (MODE == E_ACT || MODE == E_Y) {
        __shared__ int lo[33];
        if (threadIdx.x == 0) { const int* bcnt = (const int*)(ws + WS_BCNT); int o = 0; for (int e = 0; e < 32; ++e) { int tot = 0; for (int b = 0; b < 256; ++b) tot += bcnt[b * 32 + e]; lo[e] = o; o += (tot + 255) & ~255; } lo[32] = o; }
        __syncthreads();
        if (row >= lo[32]) return; int e = 0; while (row >= lo[e + 1]) ++e;
        const bf16* WE = (const bf16*)(ws + WS_WE) + (size_t)e * (512 * 1024 + 1024 * 256);
        if (MODE == E_ACT) { const int tok = ((const int*)(ws + WS_STOK))[row]; const bf16* a = (const bf16*)(ws + WS_H2) + (size_t)tok * D; const int gr = 32 * (col >> 4) + (col & 15);
            const float g = ndot(a, WE + (size_t)gr * D, D), u = ndot(a, WE + (size_t)(gr + 16) * D, D);
            ((bf16*)(ws + WS_ACT))[(size_t)row * DEXP + col] = (bf16)f2bf(siluf_(g) * u); }
        else { const float acc = ndot((const bf16*)(ws + WS_ACT) + (size_t)row * DEXP, WE + 512 * 1024 + (size_t)col * DEXP, DEXP);
            ((bf16*)(ws + WS_Y))[(size_t)row * D + col] = (bf16)f2bf(acc * ((const float*)(ws + WS_SW))[row]); }
    }
}

__global__ void __launch_bounds__(256) k_nattn(const bf16* Q, const bf16* K, const bf16* V, bf16* ycat) {
    const int t = blockIdx.x * 256 + threadIdx.x, h = blockIdx.y;
    float q[96]; { const bf16* qp = Q + (size_t)t * 768 + h * 96; for (int d = 0; d < 96; ++d) q[d] = bf2f(qp[d]); }
    float o[64]; for (int d = 0; d < 64; ++d) o[d] = 0.f; float m = -INFINITY, l = 0.f;
    for (int j = 0; j < L; ++j) { const unsigned* kp = (const unsigned*)(K + (size_t)j * 768 + h * 96); float s = 0.f;
#pragma unroll
        for (int d = 0; d < 48; ++d) { const unsigned w = kp[d]; s += q[2 * d] * bflo(w) + q[2 * d + 1] * bfhi(w); }
        const float mn = fmaxf(m, s), al = exp2f(m - mn), p = exp2f(s - mn); l = l * al + p; m = mn;
        const unsigned* vp = (const unsigned*)(V + (size_t)j * 512 + h * 64);
#pragma unroll
        for (int d = 0; d < 32; ++d) { const unsigned w = vp[d]; o[2 * d] = o[2 * d] * al + p * bflo(w); o[2 * d + 1] = o[2 * d + 1] * al + p * bfhi(w); } }
    const float il = 1.f / l; bf16* op = ycat + (size_t)t * D + 512 + h * 64; for (int d = 0; d < 64; ++d) op[d] = (bf16)f2bf(o[d] * il);
}
__global__ void __launch_bounds__(256) k_ntoep(const bf16* Gr, const bf16* uT, const float* fsum, const float* hbias, bf16* zT) {
    const int t = blockIdx.x * 256 + threadIdx.x, c = blockIdx.y; const bf16* g = Gr + (size_t)c * NG; const bf16* u = uT + (size_t)c * L;
    float S = 0.f; for (int b = 0; b < 256; ++b) S += fsum[b * 1024 + c] + fsum[b * 1024 + 512 + c];
    float acc = 0.f; for (int s = 0; s < L; ++s) acc += bf2f(u[s]) * bf2f(g[LAGMAX - (t - s)]);
    zT[(size_t)c * L + t] = (bf16)f2bf(acc / S + hbias[c] * bf2f(u[t]));
}

extern "C" void kernel_launch(void* const* d_in, const int* in_sizes, int n_in, void* d_out, int out_size, void* d_ws, size_t ws_size, hipStream_t stream) {
    static int grid = 0;
    if (grid == 0) {
        if (n_in != 33 || out_size != M * D || ws_size < 256 * MiB) { fprintf(stderr, "kernel_launch: unexpected shapes (n_in %d out %d ws %zu)\n", n_in, out_size, ws_size); grid = -1; return; }
        int dev = 0, cus = 0; hipGetDevice(&dev); hipDeviceGetAttribute(&cus, hipDeviceAttributeMultiprocessorCount, dev);
        hipFuncSetAttribute((const void*)mk, hipFuncAttributeMaxDynamicSharedMemorySize, LDS_BYTES);
        grid = cus > 0 ? cus : 256;
    }
    if (grid < 0) return;
    hipMemsetAsync((char*)d_ws + WS_CTL, 0, 64 * 1024, stream);
    Args a{}; for (int i = 0; i < 33; ++i) a.in[i] = (const float*)d_in[i]; a.out = (float*)d_out; a.ws = (unsigned char*)d_ws;
    int nl = 0; auto run = [&](int lo, int hi) { a.ph_lo = lo; a.ph_hi = hi; a.li = (nl++) & 3; hipLaunchKernelGGL(mk, dim3(grid), dim3(512), LDS_BYTES, stream, a); };
#ifdef MULTI
    for (int p = 0; p < 15; ++p) run(p, p + 1);
#elif defined(PROBE_A)
    run(0, PROBE_B); run(PROBE_A, 15);
#else
    run(0, 15);
#endif
}
```
